# Optimizing an MI355X kernel written in HIP

```python
import math
import jax, jax.numpy as jnp
from jax import lax
import numpy as np

D_MODEL = 2048
BATCH = 1
SEQ = 16384
DEPTH = 1

CHUNK = 64
N_META = 16
HEAD_DIM = 128
SB_HEADS = 8
FOX_HEADS = 8
SB_WIDTH = SB_HEADS * HEAD_DIM
FOX_WIDTH = FOX_HEADS * HEAD_DIM
MIX_WIDTH = SB_WIDTH + FOX_WIDTH
C_IN = 3 * SB_WIDTH + 4 * FOX_WIDTH + FOX_HEADS
Q_BLOCK = 128
PEER_HEADS = 8
PEER_TOPK = 16
N_KEYS = 128
N_EXPERTS = N_KEYS * N_KEYS
D_KEY = 256
PEER_BLOCK = 128
EPS = 1e-6

kernel_name = "hymba_sbfox_peer_block"


def rms_norm(x, gain):
    xf = x.astype(jnp.float32)
    y = xf * lax.rsqrt(jnp.mean(xf * xf, axis=-1, keepdims=True) + EPS)
    return y.astype(x.dtype) * gain


def to_query_blocks(a):
    b, l = a.shape[:2]
    return jnp.moveaxis(a.reshape((b, l // Q_BLOCK, Q_BLOCK) + a.shape[2:]), 1, 0)


def from_query_blocks(a):
    a = jnp.moveaxis(a, 0, 1)
    b, nb, qb = a.shape[:3]
    return a.reshape(b, nb * qb, -1)


def stick_breaking_attention(q, k, v):
    L = k.shape[1]
    k_pos = jnp.arange(L)
    scale = 1.0 / math.sqrt(HEAD_DIM)
    starts = jnp.arange(L // Q_BLOCK, dtype=jnp.int32) * Q_BLOCK

    def block(args):
        qb, start = args
        q_pos = start + jnp.arange(Q_BLOCK)
        z = jnp.einsum('bqhd,bkhd->bhqk', qb, k).astype(jnp.float32) * scale
        visible = k_pos[None, :] < q_pos[:, None]
        log_1mb = jnp.where(visible, jax.nn.log_sigmoid(-z), 0.0)
        after = lax.cumsum(log_1mb, axis=3, reverse=True) - log_1mb
        w = jnp.where(visible, jnp.exp(jax.nn.log_sigmoid(z) + after), 0.0)
        return jnp.einsum('bhqk,bkhd->bqhd', w.astype(v.dtype), v)

    out = lax.map(block, (to_query_blocks(q), starts))
    return from_query_blocks(out)


def forgetting_attention(q, k, v, log_f):
    L = k.shape[1]
    k_pos = jnp.arange(L)
    scale = 1.0 / math.sqrt(HEAD_DIM)
    cum_f = lax.cumsum(log_f, axis=1)
    cum_f_k = jnp.transpose(cum_f, (0, 2, 1))
    starts = jnp.arange(L // Q_BLOCK, dtype=jnp.int32) * Q_BLOCK

    def block(args):
        qb, fq, start = args
        q_pos = start + jnp.arange(Q_BLOCK)
        z = jnp.einsum('bqhd,bkhd->bhqk', qb, k).astype(jnp.float32) * scale
        logits = z + jnp.transpose(fq, (0, 2, 1))[..., None] - cum_f_k[:, :, None, :]
        visible = k_pos[None, :] <= q_pos[:, None]
        p = jax.nn.softmax(jnp.where(visible, logits, -jnp.inf), axis=-1)
        return jnp.einsum('bhqk,bkhd->bqhd', p.astype(v.dtype), v)

    out = lax.map(block, (to_query_blocks(q), to_query_blocks(cum_f), starts))
    return from_query_blocks(out)


def mixer_sublayer(h, w_in, b_forget, fox_q_gain, fox_k_gain, sb_out_gain, fox_out_gain, w_out):
    B, L, _ = h.shape
    proj = h @ w_in
    s3 = 3 * SB_WIDTH
    sb_q, sb_k, sb_v, fq, fk, fv, fgate, flogit = jnp.split(
        proj,
        [SB_WIDTH, 2 * SB_WIDTH, s3, s3 + FOX_WIDTH, s3 + 2 * FOX_WIDTH,
         s3 + 3 * FOX_WIDTH, s3 + 4 * FOX_WIDTH],
        axis=-1)

    def heads(a, n):
        return a.reshape(B, L, n, HEAD_DIM)

    sb = stick_breaking_attention(heads(sb_q, SB_HEADS), heads(sb_k, SB_HEADS), heads(sb_v, SB_HEADS))
    log_f = jax.nn.log_sigmoid((flogit + b_forget).astype(jnp.float32))
    fox = forgetting_attention(rms_norm(heads(fq, FOX_HEADS), fox_q_gain),
                               rms_norm(heads(fk, FOX_HEADS), fox_k_gain),
                               heads(fv, FOX_HEADS), log_f)
    merged = jnp.concatenate(
        [rms_norm(sb, sb_out_gain),
         rms_norm(fox, fox_out_gain) * jax.nn.sigmoid(fgate)], axis=-1)
    return merged @ w_out


def peer_sublayer(h, w_query, sub_keys, u, v):
    B, L, D = h.shape
    blocks = h.reshape(-1, PEER_BLOCK, D)

    def block(hb):
        q = (hb @ w_query).reshape(PEER_BLOCK, PEER_HEADS, 2, D_KEY // 2)
        s = jnp.einsum('thpc,hpnc->thpn', q, sub_keys).astype(jnp.float32)
        top_s, top_i = lax.top_k(s, PEER_TOPK)
        cand_s = (top_s[:, :, 0, :, None] + top_s[:, :, 1, None, :]).reshape(PEER_BLOCK, PEER_HEADS, -1)
        cand_i = (top_i[:, :, 0, :, None] * N_KEYS + top_i[:, :, 1, None, :]).reshape(PEER_BLOCK, PEER_HEADS, -1)
        best_s, best_j = lax.top_k(cand_s, PEER_TOPK)
        idx = jnp.take_along_axis(cand_i, best_j, axis=-1)
        g = jax.nn.softmax(best_s, axis=-1)
        u_sel = jnp.take(u, idx, axis=0)
        a = jax.nn.gelu(jnp.einsum('thkd,td->thk', u_sel, hb), approximate=False)
        v_sel = jnp.take(v, idx, axis=0)
        return jnp.einsum('thk,thkd->td', (g * a).astype(hb.dtype), v_sel)

    return lax.map(block, blocks).reshape(B, L, D)


def setup_inputs(seed: int = 0) -> dict:
    key = jax.random.key(seed)
    ks = jax.random.split(key, 15)
    f32 = jnp.float32
    nrm = lambda k, shape, s: jax.random.normal(k, shape, f32) * s
    gain = lambda k, shape: 1.0 + 0.02 * jax.random.normal(k, shape, f32)
    return {
        "x": nrm(ks[0], (BATCH, SEQ, D_MODEL), 1.0),
        "meta_tokens": nrm(ks[1], (N_META, D_MODEL), 1.0),
        "norm_mix": gain(ks[2], (DEPTH, D_MODEL)),
        "w_in": nrm(ks[3], (DEPTH, D_MODEL, C_IN), D_MODEL ** -0.5),
        "b_forget": jax.random.uniform(ks[4], (DEPTH, FOX_HEADS), f32, 1.0, 4.0),
        "fox_q_gain": gain(ks[5], (DEPTH, HEAD_DIM)),
        "fox_k_gain": gain(ks[6], (DEPTH, HEAD_DIM)),
        "sb_out_gain": gain(ks[7], (DEPTH, SB_WIDTH)),
        "fox_out_gain": gain(ks[8], (DEPTH, FOX_WIDTH)),
        "w_out": nrm(ks[9], (DEPTH, MIX_WIDTH, D_MODEL), MIX_WIDTH ** -0.5),
        "norm_ffn": gain(ks[10], (DEPTH, D_MODEL)),
        "peer_w_query": nrm(ks[11], (DEPTH, D_MODEL, PEER_HEADS * D_KEY), D_MODEL ** -0.5),
        "peer_sub_keys": nrm(ks[12], (DEPTH, PEER_HEADS, 2, N_KEYS, D_KEY // 2), (D_KEY // 2) ** -0.5),
        "peer_u": nrm(ks[13], (DEPTH, N_EXPERTS, D_MODEL), D_MODEL ** -0.5),
        "peer_v": nrm(ks[14], (DEPTH, N_EXPERTS, D_MODEL), PEER_HEADS ** -0.5),
    }


def reference(x, meta_tokens, norm_mix, w_in, b_forget, fox_q_gain, fox_k_gain,
              sb_out_gain, fox_out_gain, w_out, norm_ffn, peer_w_query, peer_sub_keys,
              peer_u, peer_v):
    B, S, D = x.shape
    l_pad = ((S + N_META + Q_BLOCK - 1) // Q_BLOCK) * Q_BLOCK
    meta = jnp.broadcast_to(meta_tokens[None].astype(x.dtype), (B, N_META, D))
    pad = jnp.zeros((B, l_pad - S - N_META, D), x.dtype)
    h = jnp.concatenate([meta, x, pad], axis=1)
    for l in range(DEPTH):
        h = h + mixer_sublayer(rms_norm(h, norm_mix[l]), w_in[l], b_forget[l],
                               fox_q_gain[l], fox_k_gain[l], sb_out_gain[l],
                               fox_out_gain[l], w_out[l])
        h = h + peer_sublayer(rms_norm(h, norm_ffn[l]), peer_w_query[l],
                              peer_sub_keys[l], peer_u[l], peer_v[l])
    return h[:, N_META:N_META + S]
```

```cpp
#include <hip/hip_runtime.h>
#include <cstdio>
#include <cstdint>
#include <cstddef>


typedef short s16x4 __attribute__((ext_vector_type(4)));
typedef float f32x16 __attribute__((ext_vector_type(16)));
typedef unsigned u32x2 __attribute__((ext_vector_type(2)));
#define XB_TMO      128
#define XB_XCNT(j)  (256  + 64 * (j))
#define XB_XSUB(j)  (1280 + 64 * (j))
#define XB_XGEN(j)  (2304 + 64 * (j))
#define XB_TOP      3328
#define XB_TOPGEN   3392
#define XCD_BAR_WORDS 3456
#define XB_SPIN_CAP (1u << 18)
#define LAS __attribute__((address_space(3)))

__device__ __forceinline__ unsigned xb_ld(unsigned* p)              { return __hip_atomic_load(p, __ATOMIC_RELAXED, __HIP_MEMORY_SCOPE_AGENT); }
__device__ __forceinline__ unsigned xb_add(unsigned* p, unsigned v) { return __hip_atomic_fetch_add(p, v, __ATOMIC_RELAXED, __HIP_MEMORY_SCOPE_AGENT); }
__device__ __forceinline__ unsigned xb_xcc_id() { return (unsigned)__builtin_amdgcn_s_getreg((3 << 11) | 20) & 0xFu; }
#define XB_SPIN(cond, bar) do { unsigned _sp = 0; while (cond) { __builtin_amdgcn_s_sleep(1); \
    if ((++_sp & 255u) == 0u) { if (xb_ld(&(bar)[XB_TMO])) break; if (_sp > XB_SPIN_CAP) { atomicAdd(&(bar)[XB_TMO], 1u); break; } } } } while (0)

struct XcdBarrier {
    unsigned* bar; unsigned x;
    volatile LAS unsigned* st;
};

__device__ __forceinline__ XcdBarrier xcd_barrier_post(unsigned* bar, volatile LAS unsigned* st) {
    XcdBarrier b; b.bar = bar; b.x = xb_xcc_id(); b.st = st;
    if (threadIdx.x == 0) (void)xb_add(&bar[XB_XCNT(b.x)], 1u);
    return b;
}
__device__ __forceinline__ void xcd_barrier_complete(unsigned* bar, unsigned x, unsigned& nloc, unsigned& nx) {
    const unsigned G = gridDim.x * gridDim.y * gridDim.z;
    unsigned sum, cnt, mine, sp = 0u;
    for (;;) {
        sum = 0u; cnt = 0u; mine = 0u;
#pragma unroll
        for (unsigned j = 0; j < 16; ++j) { const unsigned c = xb_ld(&bar[XB_XCNT(j)]); sum += c; cnt += (c > 0u) ? 1u : 0u; mine = (j == x) ? c : mine; }
        if (sum == G) break;
        __builtin_amdgcn_s_sleep(1);
        if ((++sp & 255u) == 0u) { if (xb_ld(&bar[XB_TMO])) break; if (sp > XB_SPIN_CAP) { atomicAdd(&bar[XB_TMO], 1u); break; } }
    }
    nloc = mine > 0u ? mine : 1u; nx = cnt > 0u ? cnt : 1u;
}

__device__ __forceinline__ void xcd_barrier(const XcdBarrier& b) {
    asm volatile("s_waitcnt vmcnt(0)" ::: "memory");
    __syncthreads();
    if (threadIdx.x == 0) {
        unsigned* bar = b.bar;
        __builtin_amdgcn_s_waitcnt(0);
        unsigned nloc = b.st[0], nx = b.st[1];
        if (nloc == 0u) { xcd_barrier_complete(bar, b.x, nloc, nx); b.st[0] = nloc; b.st[1] = nx; }
        const unsigned old = xb_add(&bar[XB_XSUB(b.x)], 1u);
        const unsigned gen = old / nloc;
        if (old + 1u == (gen + 1u) * nloc) {
            __builtin_amdgcn_fence(__ATOMIC_RELEASE, "agent");
            asm volatile("s_waitcnt vmcnt(0)" ::: "memory");
            const unsigned og = xb_add(&bar[XB_TOP], 1u);
            const unsigned tg = og / nx;
            if (og + 1u == (tg + 1u) * nx) xb_add(&bar[XB_TOPGEN], 1u);
            else XB_SPIN(xb_ld(&bar[XB_TOPGEN]) == tg, bar);
            __builtin_amdgcn_fence(__ATOMIC_ACQUIRE, "agent");
            xb_add(&bar[XB_XGEN(b.x)], 1u);
            asm volatile("s_waitcnt vmcnt(0)" ::: "memory");
        } else {
            XB_SPIN(xb_ld(&bar[XB_XGEN(b.x)]) == gen, bar);
            __builtin_amdgcn_fence(__ATOMIC_ACQUIRE, "agent");
            asm volatile("s_waitcnt vmcnt(0)" ::: "memory");
        }
    }
    __syncthreads();
}

namespace pg8 {
#define PG8_LAS __attribute__((address_space(3)))
typedef unsigned short bf16_t;
typedef short bf16x8 __attribute__((ext_vector_type(8)));
typedef float f32x4 __attribute__((ext_vector_type(4)));
typedef unsigned u32x4 __attribute__((ext_vector_type(4)));
constexpr int BM = 256, BK = 64, HALF = 128, HTB = HALF * BK * 2  , STAGE_BYTES = 8 * HTB, NXCD = 8, WGM = 8;

__host__ __device__ __forceinline__ int lds_byte(int r, int c) { const int st = (r >> 4) * 2 + (c >> 5), rr = r & 15, cc = c & 31, ob = rr * 64 + cc * 2; return st * 1024 + (ob ^ (((ob >> 9) & 1) << 5)); }
__host__ __device__ __forceinline__ void stage_rc(int b, int& R, int& C) { const int st = b / 1024, sb = b % 1024, swz = sb ^ (((sb >> 9) & 1) << 5); R = (st >> 1) * 16 + swz / 64; C = (st & 1) * 32 + (swz % 64) / 2; }
__host__ __device__ __forceinline__ int perm32(int rho) { const int n = rho >> 4, i = rho & 15; return 8 * (i >> 2) + 4 * n + (i & 3); }

struct Unit { int pm, pn; };
struct Gemm { const bf16_t* A; const bf16_t* Bt; int M, N, K; };

struct StaticOrder {
    int nM, nN, nwg, G, c;
    __host__ __device__ void init(int M, int N, int G_, int c_) { nM = M / BM; nN = N / BM; nwg = nM * nN; G = G_; c = c_; }
    __host__ __device__ bool next(int i, Unit& u) const {
        const long L = (long)i * G + c; if (L >= nwg) return false;
        int wgid = (int)L; { const int q = nwg / NXCD, r = nwg % NXCD, xcd = wgid % NXCD, off = wgid / NXCD; wgid = (xcd < r ? xcd * (q + 1) : r * (q + 1) + (xcd - r) * q) + off; }
        const int nig = WGM * nN, gid = wgid / nig, fm = gid * WGM, gsz = (nM - fm) < WGM ? (nM - fm) : WGM;
        u.pm = fm + ((wgid % nig) % gsz); u.pn = (wgid % nig) / gsz; return true;
    }
    __device__ __forceinline__ void a_ready(const Unit&) const {}
    __device__ __forceinline__ void done(const Unit&) const {}
};

typedef __bf16 bf16x2_t __attribute__((ext_vector_type(2)));
__device__ __forceinline__ unsigned cvt_pk_bf16(float lo, float hi) { bf16x2_t v; v[0] = (__bf16)lo; v[1] = (__bf16)hi; return __builtin_bit_cast(unsigned, v); }
typedef float f32x2 __attribute__((ext_vector_type(2)));
__device__ __forceinline__ f32x2 gelu_pk(f32x2 v) {
    const f32x2 av = __builtin_elementwise_abs(v), d = av * 0.2316418882f + 1.0f;
    f32x2 t; t.x = __builtin_amdgcn_rcpf(d.x); t.y = __builtin_amdgcn_rcpf(d.y);
    f32x2 q = t * 0.5307027145f + (-0.7265760135f); q = q * t + 0.7107068705f; q = q * t + (-0.142248368f); q = q * t + 0.127414796f; q = q * t;
    const f32x2 s = (v * v) * (-0.72134752044f);
    f32x2 e; e.x = __builtin_amdgcn_exp2f(s.x); e.y = __builtin_amdgcn_exp2f(s.y);
    const f32x2 m = v * (q * e), r = v - m;
    f32x2 o; o.x = v.x < 0.f ? m.x : r.x; o.y = v.y < 0.f ? m.y : r.y; return o;
}
template <int ACT  > struct EpiBf16 {
    static constexpr bool PERM = true, AFTER_DRAIN = false;
    bf16_t* O; int ldc; const float* bias; int split_cols; size_t split_stride;
    __device__ __forceinline__ void operator()(const f32x4 (&acc)[2][2][4][2], const Unit& u, int wr, int wc, int fr, int fq) const {
        const int row0 = u.pm * BM + wr * 64 + fr; int colt = u.pn * BM; bf16_t* base = O;
        if (split_cols) { const int t = colt / split_cols; base += (size_t)t * split_stride; colt -= t * split_cols; }
        const int col0 = colt + wc * 32 + 8 * fq, bcol0 = u.pn * BM + wc * 32 + 8 * fq;
        f32x4 bv[2][2];
#pragma unroll
        for (int bj = 0; bj < 2; ++bj)
#pragma unroll
            for (int n = 0; n < 2; ++n) bv[bj][n] = bias ? *(const f32x4*)(bias + bcol0 + bj * HALF + 4 * n) : (f32x4){0.f, 0.f, 0.f, 0.f};
#pragma unroll
        for (int ai = 0; ai < 2; ++ai)
#pragma unroll
            for (int m = 0; m < 4; ++m) { bf16_t* rowp = base + (size_t)(row0 + ai * HALF + m * 16) * ldc + col0;
#pragma unroll
                for (int bj = 0; bj < 2; ++bj) { f32x4 v0 = acc[ai][bj][m][0] + bv[bj][0], v1 = acc[ai][bj][m][1] + bv[bj][1];
                    if (ACT == 1) { f32x2 a = gelu_pk((f32x2){v0[0], v0[1]}), b = gelu_pk((f32x2){v0[2], v0[3]}), c = gelu_pk((f32x2){v1[0], v1[1]}), d = gelu_pk((f32x2){v1[2], v1[3]});
                        v0 = (f32x4){a.x, a.y, b.x, b.y}; v1 = (f32x4){c.x, c.y, d.x, d.y}; }
                    if (ACT == 2) {
#pragma unroll
                        for (int j = 0; j < 4; ++j) { v0[j] = 0.5f * v0[j] * (1.0f + erff(v0[j] * 0.70710678f)); v1[j] = 0.5f * v1[j] * (1.0f + erff(v1[j] * 0.70710678f)); } }
                    u32x4 w; w.x = cvt_pk_bf16(v0[0], v0[1]); w.y = cvt_pk_bf16(v0[2], v0[3]); w.z = cvt_pk_bf16(v1[0], v1[1]); w.w = cvt_pk_bf16(v1[2], v1[3]);
                    *(u32x4*)(rowp + bj * HALF) = w; } }
    }
};

template <class Epi, class Sched, bool STAMP = false>
__device__ __forceinline__ void gemm_phase(PG8_LAS unsigned char* lds, const Gemm g, const Sched& S, const Epi& E, unsigned long long* stamps) {
    const int tid = threadIdx.x, wid = __builtin_amdgcn_readfirstlane(tid >> 6), lane = tid & 63, wr = wid >> 2, wc = wid & 3, fr = lane & 15, fq = lane >> 4;
    const int K = g.K, nt = K / BK;
    int ts_lo = 0, ts_hi = 0, nts = 0; const unsigned long long rt_entry = STAMP ? (unsigned long long)wall_clock64() : 0ull;
#define PG8_STAMP() do { if (STAMP && wid == 0 && nts < 64) { const unsigned long long _c = (unsigned long long)clock64(); \
        ts_lo = (lane == nts) ? (int)(unsigned)_c : ts_lo; ts_hi = (lane == nts) ? (int)(unsigned)(_c >> 32) : ts_hi; ++nts; } } while (0)
    PG8_STAMP();
    unsigned voffA[2], voffB[2];
#pragma unroll
    for (int i = 0; i < 2; ++i) { int R, C; stage_rc(tid * 16 + i * 8192, R, C); const int Rb = Epi::PERM ? ((R & ~31) + perm32(R & 31)) : R;
        voffA[i] = (unsigned)(R * K + C) * 2u; voffB[i] = (unsigned)(Rb * K + C) * 2u; }
    const size_t kstep = (size_t)(BK * 2);
    const size_t hstep = (size_t)HALF * K * 2;
    const size_t tstep = 2 * hstep;
    const unsigned ldsw = (unsigned)wid * 1024u;
    const int aoff = lds_byte(wr * 64 + fr, fq * 8), boff = lds_byte(wc * 32 + fr, fq * 8);
#define PG8_SA(b, h) (((b) * 2 + (h)) * HTB)
#define PG8_SB(b, h) ((4 + (b) * 2 + (h)) * HTB)
#define PG8_STAGE(bufoff, gbase, voff) do { _Pragma("unroll") for (int _i = 0; _i < 2; ++_i) \
        __builtin_amdgcn_global_load_lds((const unsigned*)((const char*)(gbase) + (voff)[_i]), (PG8_LAS unsigned*)(lds + (bufoff) + ldsw + _i * 8192), 16, 0, 0); } while (0)
#define PG8_LDA(dst, b, h) do { _Pragma("unroll") for (int m = 0; m < 4; ++m) _Pragma("unroll") for (int k = 0; k < 2; ++k) dst[m][k] = *(const PG8_LAS bf16x8*)(lds + PG8_SA(b, h) + aoff + m * 2048 + k * 1024); } while (0)
#define PG8_LDB(dst, b, h) do { _Pragma("unroll") for (int n = 0; n < 2; ++n) _Pragma("unroll") for (int k = 0; k < 2; ++k) dst[n][k] = *(const PG8_LAS bf16x8*)(lds + PG8_SB(b, h) + boff + n * 2048 + k * 1024); } while (0)
#define PG8_MMA(ai, bj, At, Bt) do { __builtin_amdgcn_s_setprio(1); _Pragma("unroll") for (int m = 0; m < 4; ++m) _Pragma("unroll") for (int n = 0; n < 2; ++n) _Pragma("unroll") for (int k = 0; k < 2; ++k) \
        acc[ai][bj][m][n] = __builtin_amdgcn_mfma_f32_16x16x32_bf16(Bt[n][k], At[m][k], acc[ai][bj][m][n], 0, 0, 0); __builtin_amdgcn_s_setprio(0); } while (0)
#define PG8_WAIT_V(n) asm volatile("s_waitcnt vmcnt(" #n ")" ::: "memory")
#define PG8_WAIT_L(n) asm volatile("s_waitcnt lgkmcnt(" #n ")" ::: "memory")
#define PG8_BAR __builtin_amdgcn_s_barrier()
#define PG8_SCHED __builtin_amdgcn_sched_barrier(0)
    Unit cur, nxt; int ui = 0;
    if (!S.next(0, cur)) return;
    f32x4 acc[2][2][4][2];
#pragma unroll
    for (int a = 0; a < 2; ++a)
#pragma unroll
        for (int b = 0; b < 2; ++b)
#pragma unroll
            for (int m = 0; m < 4; ++m)
#pragma unroll
                for (int n = 0; n < 2; ++n) acc[a][b][m][n] = (f32x4){0.f, 0.f, 0.f, 0.f};
    bf16x8 At[4][2], B0[2][2], B1[2][2];
    const char* cA = (const char*)g.A + (size_t)cur.pm * tstep; const char* cB = (const char*)g.Bt + (size_t)cur.pn * tstep;
    S.a_ready(cur);
    PG8_STAGE(PG8_SB(0, 0), cB, voffB); PG8_STAGE(PG8_SA(0, 0), cA, voffA); PG8_STAGE(PG8_SB(0, 1), cB + hstep, voffB); PG8_STAGE(PG8_SA(0, 1), cA + hstep, voffA);
    if (wr == 1) PG8_BAR;
    PG8_WAIT_V(4); PG8_BAR;
    PG8_STAGE(PG8_SB(1, 0), cB + kstep, voffB); PG8_STAGE(PG8_SA(1, 0), cA + kstep, voffA); PG8_STAGE(PG8_SB(1, 1), cB + hstep + kstep, voffB);
    PG8_WAIT_V(6); PG8_BAR;
    PG8_STAMP();
    for (;;) {
        const bool has_next = S.next(ui + 1, nxt);
        const char* nA = has_next ? (const char*)g.A + (size_t)nxt.pm * tstep : cA; const char* nB = has_next ? (const char*)g.Bt + (size_t)nxt.pn * tstep : cB;
        for (int t = 0; t < nt; t += 2) {
            const bool last = (t == nt - 2);
            const char* a1 = cA + (size_t)(t + 1) * kstep;
            const char* a2 = last ? nA : cA + (size_t)(t + 2) * kstep; const char* b2 = last ? nB : cB + (size_t)(t + 2) * kstep;
            const char* a3 = a2 + kstep; const char* b3 = b2 + kstep;
            if (last && has_next) S.a_ready(nxt);
            PG8_LDB(B0, 0, 0); PG8_SCHED; PG8_LDA(At, 0, 0); PG8_STAGE(PG8_SA(1, 1), a1 + hstep, voffA);
            PG8_WAIT_L(8); PG8_BAR; PG8_WAIT_L(0); PG8_MMA(0, 0, At, B0); PG8_BAR; PG8_SCHED;
            PG8_LDB(B1, 0, 1); PG8_STAGE(PG8_SB(0, 0), b2, voffB);
            PG8_BAR; PG8_WAIT_L(0); PG8_MMA(0, 1, At, B1); PG8_BAR;
            PG8_LDA(At, 0, 1); PG8_STAGE(PG8_SA(0, 0), a2, voffA);
            PG8_BAR; PG8_WAIT_L(0); PG8_MMA(1, 0, At, B0); PG8_BAR; PG8_SCHED;
            PG8_STAGE(PG8_SB(0, 1), b2 + hstep, voffB);
            PG8_WAIT_V(6); PG8_BAR; PG8_MMA(1, 1, At, B1); PG8_BAR;
            PG8_LDB(B0, 1, 0); PG8_SCHED; PG8_LDA(At, 1, 0); PG8_STAGE(PG8_SA(0, 1), a2 + hstep, voffA);
            PG8_WAIT_L(8); PG8_BAR; PG8_WAIT_L(0); PG8_MMA(0, 0, At, B0); PG8_BAR; PG8_SCHED;
            PG8_LDB(B1, 1, 1); PG8_STAGE(PG8_SB(1, 0), b3, voffB);
            PG8_BAR; PG8_WAIT_L(0); PG8_MMA(0, 1, At, B1); PG8_BAR;
            PG8_LDA(At, 1, 1); PG8_STAGE(PG8_SA(1, 0), a3, voffA);
            PG8_BAR; PG8_WAIT_L(0); PG8_MMA(1, 0, At, B0); PG8_BAR; PG8_SCHED;
            PG8_STAGE(PG8_SB(1, 1), b3 + hstep, voffB);
            PG8_WAIT_V(6); PG8_BAR; PG8_MMA(1, 1, At, B1); PG8_BAR;
        }
        PG8_STAMP();
        if constexpr (!Epi::AFTER_DRAIN) { E(acc, cur, wr, wc, fr, fq); S.done(cur); }
        PG8_STAMP();
        if (!has_next) break;
#pragma unroll
        for (int a = 0; a < 2; ++a)
#pragma unroll
            for (int b = 0; b < 2; ++b)
#pragma unroll
                for (int m = 0; m < 4; ++m)
#pragma unroll
                    for (int n = 0; n < 2; ++n) acc[a][b][m][n] = (f32x4){0.f, 0.f, 0.f, 0.f};
        cur = nxt; cA = nA; cB = nB; ++ui;
    }
    PG8_WAIT_V(0);
    if (wr == 0) PG8_BAR;
    PG8_BAR;
    if constexpr (Epi::AFTER_DRAIN) { E.fused(acc, cur, wr, wc, fr, fq, lds, wid, lane); S.done(cur); }
    PG8_STAMP();
    if (STAMP && wid == 0) { stamps[lane] = lane < nts ? (((unsigned long long)(unsigned)ts_hi << 32) | (unsigned)ts_lo) : 0ull;
        if (lane == 62) stamps[62] = rt_entry; if (lane == 63) stamps[63] = (unsigned long long)wall_clock64(); }
#undef PG8_STAMP
#undef PG8_SA
#undef PG8_SB
#undef PG8_STAGE
#undef PG8_LDA
#undef PG8_LDB
#undef PG8_MMA
#undef PG8_WAIT_V
#undef PG8_WAIT_L
#undef PG8_BAR
#undef PG8_SCHED
}
}
using pg8::bf16_t; using pg8::bf16x8; using pg8::f32x4; using pg8::u32x4;

constexpr int S_ROWS = 16384, NMETA = 16, DM = 2048, WID = 1024, CIN = 7176, NPROJ = 7168;
constexpr int KPAD = 16416;
constexpr float EPS = 1e-6f;
constexpr float LOG2E = 1.4426950408889634f;
constexpr float QSCALE2 = 0.08838834764831845f * 1.4426950408889634f;
constexpr int LDS_BYTES = 147456;
constexpr int NPH = 9;

constexpr size_t al256(size_t x) { return (x + 255) & ~(size_t)255; }
constexpr size_t PROJ_T   = (size_t)S_ROWS * WID * 2;
constexpr size_t WS_CTL   = 0;
constexpr size_t CTL_BYTES = 65536;
constexpr size_t WS_WTIN  = CTL_BYTES;
constexpr size_t WS_WTOUT = WS_WTIN + (size_t)NPROJ * DM * 2;
constexpr size_t WS_WTQ   = WS_WTOUT + (size_t)DM * DM * 2;
constexpr size_t WS_SUBK  = WS_WTQ + (size_t)DM * DM * 2;
constexpr size_t WS_XN    = WS_SUBK + (size_t)16 * 128 * 128 * 2;
constexpr size_t WS_PROJ  = WS_XN + (size_t)KPAD * DM * 2;
constexpr size_t WS_METAKV= WS_PROJ + 7 * PROJ_T;
constexpr size_t WS_LCUM  = WS_METAKV + (size_t)4 * 32 * 1024 * 2;
constexpr size_t WS_CHT   = WS_LCUM + (size_t)KPAD * 8 * 4;
constexpr size_t WS_CK2   = al256(WS_CHT + 257 * 8 * 4);
constexpr size_t WS_AK    = WS_CK2 + (size_t)8 * KPAD * 4;
constexpr size_t WS_ATT   = al256(WS_AK + (size_t)8 * KPAD * 4);
constexpr size_t WS_SQ    = WS_ATT + 2 * PROJ_T;
constexpr size_t WS_ROWSQ = WS_SQ + 2 * (size_t)S_ROWS * 8 * 4;
constexpr size_t WS_END   = WS_ROWSQ + (size_t)S_ROWS * 32 * 4;
constexpr size_t WS_MERGED= WS_XN;
constexpr size_t WS_PQ    = WS_XN;
constexpr size_t WS_H1G   = WS_PROJ;
constexpr size_t WS_IDX   = WS_PROJ + 2 * PROJ_T;
constexpr size_t WS_G     = WS_IDX + (size_t)S_ROWS * 128 * 4;
constexpr int QCTR_WORD = 4096;

struct Args {
    const float *x, *meta, *norm_mix, *w_in, *b_forget, *gq, *gk, *g_sb, *g_fox, *w_out, *norm_ffn, *w_query, *sub_keys, *pu, *pv;
    float* out; unsigned char* ws;
    int ph_lo, ph_hi;
};

__device__ __forceinline__ float bf2f(unsigned short b) { return __uint_as_float((unsigned)b << 16); }
__device__ __forceinline__ float bflo(unsigned w) { return __uint_as_float(w << 16); }
__device__ __forceinline__ float bfhi(unsigned w) { return __uint_as_float(w & 0xffff0000u); }
__device__ __forceinline__ unsigned pk_bf16(float lo, float hi) { return pg8::cvt_pk_bf16(lo, hi); }
__device__ __forceinline__ float wave_sum(float v) {
    v += __shfl_xor(v, 32); v += __shfl_xor(v, 16); v += __shfl_xor(v, 8); v += __shfl_xor(v, 4); v += __shfl_xor(v, 2); v += __shfl_xor(v, 1); return v; }
__device__ __forceinline__ float wave_max(float v) {
    v = fmaxf(v, __shfl_xor(v, 32)); v = fmaxf(v, __shfl_xor(v, 16)); v = fmaxf(v, __shfl_xor(v, 8)); v = fmaxf(v, __shfl_xor(v, 4)); v = fmaxf(v, __shfl_xor(v, 2)); v = fmaxf(v, __shfl_xor(v, 1)); return v; }
__device__ __forceinline__ float ex2(float x) { return __builtin_amdgcn_exp2f(x); }
__device__ __forceinline__ float lg2(float x) { return __builtin_amdgcn_logf(x); }

__device__ __forceinline__ void phase_prep(const Args& a, LAS unsigned char* lds) {
    const int tid = threadIdx.x, wid = tid >> 6, lane = tid & 63;
    LAS float* WF = (LAS float*)lds;
    LAS float* LF = (LAS float*)(lds + 65536);
    LAS float* TT = (LAS float*)(lds + 69632);
    bf16_t* XN = (bf16_t*)(a.ws + WS_XN);
    float* LCUM = (float*)(a.ws + WS_LCUM); float* CHT = (float*)(a.ws + WS_CHT);
    for (int i = tid; i < 2048 * 2; i += 512) {
        const int d = i >> 1, part = i & 1;
        const f32x4 v = *(const f32x4*)(a.w_in + (size_t)d * CIN + NPROJ + part * 4);
        *(LAS f32x4*)(WF + d * 8 + part * 4) = v;
    }
    __syncthreads();
    for (int g = blockIdx.x; g < 257; g += gridDim.x) {
        const int nrows = g < 256 ? 64 : NMETA;
        const int rbase = g < 256 ? g * 64 : S_ROWS;
        for (int r = wid; r < nrows; r += 8) {
            const float* src = g < 256 ? a.x + (size_t)(rbase + r) * DM : a.meta + (size_t)r * DM;
            f32x4 v[8]; float ss = 0.f;
#pragma unroll
            for (int c = 0; c < 8; ++c) { v[c] = *(const f32x4*)(src + c * 256 + lane * 4); ss += v[c][0] * v[c][0] + v[c][1] * v[c][1] + v[c][2] * v[c][2] + v[c][3] * v[c][3]; }
            ss = wave_sum(ss);
            const float rstd = rsqrtf(ss * (1.0f / DM) + EPS);
            float fl[8];
#pragma unroll
            for (int h = 0; h < 8; ++h) fl[h] = 0.f;
#pragma unroll
            for (int c = 0; c < 8; ++c) {
                const f32x4 gn = *(const f32x4*)(a.norm_mix + c * 256 + lane * 4);
                f32x4 y;
#pragma unroll
                for (int e = 0; e < 4; ++e) y[e] = (v[c][e] * rstd) * gn[e];
                u32x2 pk; pk.x = pk_bf16(y[0], y[1]); pk.y = pk_bf16(y[2], y[3]);
                *(u32x2*)(XN + (size_t)(rbase + r) * DM + c * 256 + lane * 4) = pk;
#pragma unroll
                for (int e = 0; e < 4; ++e) {
                    const int d = c * 256 + lane * 4 + e;
                    const f32x4 w0 = *(const LAS f32x4*)(WF + d * 8), w1 = *(const LAS f32x4*)(WF + d * 8 + 4);
                    fl[0] += y[e] * w0[0]; fl[1] += y[e] * w0[1]; fl[2] += y[e] * w0[2]; fl[3] += y[e] * w0[3];
                    fl[4] += y[e] * w1[0]; fl[5] += y[e] * w1[1]; fl[6] += y[e] * w1[2]; fl[7] += y[e] * w1[3];
                }
            }
            float mine = 0.f;
#pragma unroll
            for (int h = 0; h < 8; ++h) { const float t = wave_sum(fl[h]); mine = (lane == h) ? t : mine; }
            if (lane < 8) { const float z = mine + a.b_forget[lane]; LF[r * 8 + lane] = fminf(z, 0.f) - log1pf(expf(-fabsf(z))); }
        }
        __syncthreads();
        if (tid < 8) {
            float run = 0.f;
            for (int r = 0; r < nrows; ++r) { run += LF[r * 8 + tid]; LCUM[(size_t)(rbase + r) * 8 + tid] = run; }
            CHT[g * 8 + tid] = run;
        }
        __syncthreads();
    }
    for (int t = blockIdx.x; t < 3584 + 1024 + 1024; t += gridDim.x) {
        const float* src; bf16_t* dst; int ld, tt;
        if (t < 3584) { src = a.w_in; dst = (bf16_t*)(a.ws + WS_WTIN); ld = CIN; tt = t; }
        else if (t < 4608) { src = a.w_out; dst = (bf16_t*)(a.ws + WS_WTOUT); ld = DM; tt = t - 3584; }
        else { src = a.w_query; dst = (bf16_t*)(a.ws + WS_WTQ); ld = DM; tt = t - 4608; }
        const int kt = tt & 31, nt = tt >> 5;
        {
            const int r = tid >> 4, c4 = tid & 15;
#pragma unroll
            for (int p = 0; p < 2; ++p) {
                const f32x4 v = *(const f32x4*)(src + (size_t)(kt * 64 + r + 32 * p) * ld + nt * 64 + c4 * 4);
#pragma unroll
                for (int e = 0; e < 4; ++e) TT[(r + 32 * p) * 65 + c4 * 4 + e] = v[e];
            }
        }
        __syncthreads();
        {
            const int n = tid >> 3, k8 = (tid & 7) * 8;
            float f[8];
#pragma unroll
            for (int j = 0; j < 8; ++j) f[j] = TT[(k8 + j) * 65 + n];
            u32x4 w; w.x = pk_bf16(f[0], f[1]); w.y = pk_bf16(f[2], f[3]); w.z = pk_bf16(f[4], f[5]); w.w = pk_bf16(f[6], f[7]);
            *(u32x4*)(dst + (size_t)(nt * 64 + n) * DM + kt * 64 + k8) = w;
        }
        __syncthreads();
    }
    const int gt = blockIdx.x * 512 + tid, ngt = gridDim.x * 512;
    bf16_t* SUBK = (bf16_t*)(a.ws + WS_SUBK);
    for (int i = gt; i < 16 * 128 * 128 / 4; i += ngt) {
        const f32x4 v = *(const f32x4*)(a.sub_keys + (size_t)i * 4);
        u32x2 pk; pk.x = pk_bf16(v[0], v[1]); pk.y = pk_bf16(v[2], v[3]);
        *(u32x2*)(SUBK + (size_t)i * 4) = pk;
    }
    bf16_t* MKV = (bf16_t*)(a.ws + WS_METAKV);
    for (int i = gt; i < 4 * 16 * 1024 / 8; i += ngt) {
        const int tsel = i / (16 * 1024 / 8), rem = i % (16 * 1024 / 8);
        *(u32x4*)(MKV + (size_t)tsel * 32 * 1024 + 16 * 1024 + (size_t)rem * 8) = (u32x4){0u, 0u, 0u, 0u};
    }
}

__device__ __forceinline__ void phase_cumf_meta(const Args& a, LAS unsigned char* lds) {
    const int tid = threadIdx.x, wid = tid >> 6, lane = tid & 63;
    const float* LCUM = (const float*)(a.ws + WS_LCUM); const float* CHT = (const float*)(a.ws + WS_CHT);
    float* CK2 = (float*)(a.ws + WS_CK2);
    for (int g = blockIdx.x; g < 256; g += gridDim.x) {
        if (wid == 0) {
            float pre[8];
#pragma unroll
            for (int h = 0; h < 8; ++h) { float p = 0.f; for (int c = lane; c < g; c += 64) p += CHT[c * 8 + h]; pre[h] = wave_sum(p) + CHT[256 * 8 + h]; }
            const int row = g * 64 + lane;
            const f32x4 l0 = *(const f32x4*)(LCUM + (size_t)row * 8), l1 = *(const f32x4*)(LCUM + (size_t)row * 8 + 4);
#pragma unroll
            for (int h = 0; h < 4; ++h) { CK2[(size_t)h * KPAD + row] = (pre[h] + l0[h]) * LOG2E; CK2[(size_t)(h + 4) * KPAD + row] = (pre[h + 4] + l1[h]) * LOG2E; }
        }
    }
    if (blockIdx.x == 0 && wid == 1 && lane < 32) {
#pragma unroll
        for (int h = 0; h < 8; ++h)
            CK2[(size_t)h * KPAD + S_ROWS + lane] = lane < NMETA ? LCUM[(size_t)(S_ROWS + lane) * 8 + h] * LOG2E : 1e30f;
    }
    const bf16_t* XN = (const bf16_t*)(a.ws + WS_XN); const bf16_t* WT = (const bf16_t*)(a.ws + WS_WTIN);
    bf16_t* MKV = (bf16_t*)(a.ws + WS_METAKV);
    LAS float* PART = (LAS float*)lds;
    for (int cg = blockIdx.x; cg < 256; cg += gridDim.x) {
        const int tsel = cg >> 6, col = (cg & 63) * 16;
        const int nsrc = (tsel == 0 ? 1024 : tsel == 1 ? 2048 : tsel == 2 ? 4096 : 5120) + col;
        const int m = lane & 15, kq = lane >> 4;
        f32x4 acc = (f32x4){0.f, 0.f, 0.f, 0.f};
        const bf16_t* ap = XN + (size_t)(S_ROWS + m) * DM + wid * 256 + 8 * kq;
        const bf16_t* bp = WT + (size_t)(nsrc + m) * DM + wid * 256 + 8 * kq;
#pragma unroll
        for (int ks = 0; ks < 8; ++ks) {
            const bf16x8 av = *(const bf16x8*)(ap + 32 * ks), bv = *(const bf16x8*)(bp + 32 * ks);
            acc = __builtin_amdgcn_mfma_f32_16x16x32_bf16(av, bv, acc, 0, 0, 0);
        }
#pragma unroll
        for (int rg = 0; rg < 4; ++rg) PART[wid * 256 + (4 * kq + rg) * 16 + m] = acc[rg];
        __syncthreads();
        if (tid < 256) {
            float s = 0.f;
#pragma unroll
            for (int w = 0; w < 8; ++w) s += PART[w * 256 + tid];
            const int mm = tid >> 4, nn = tid & 15;
            MKV[(size_t)tsel * 32 * 1024 + (size_t)mm * 1024 + col + nn] = (bf16_t)(pk_bf16(s, 0.f) & 0xffffu);
        }
        __syncthreads();
    }
}

__device__ __forceinline__ void phase_ak(const Args& a) {
    const int tid = threadIdx.x, wid = tid >> 6, lane = tid & 63;
    const bf16_t* FK = (const bf16_t*)(a.ws + WS_PROJ + 4 * PROJ_T); const bf16_t* MFK = (const bf16_t*)(a.ws + WS_METAKV) + 2 * 32 * 1024;
    float* AK = (float*)(a.ws + WS_AK);
    for (int row = blockIdx.x * 8 + wid; row < S_ROWS + NMETA; row += gridDim.x * 8) {
        const bf16_t* src = row < S_ROWS ? FK + (size_t)row * WID : MFK + (size_t)(row - S_ROWS) * WID;
        const u32x4 w0 = *(const u32x4*)(src + lane * 16), w1 = *(const u32x4*)(src + lane * 16 + 8);
        float ss = 0.f;
#pragma unroll
        for (int e = 0; e < 4; ++e) { const float p = bflo(w0[e]), q = bfhi(w0[e]), r = bflo(w1[e]), s = bfhi(w1[e]); ss += p * p + q * q + r * r + s * s; }
        ss += __shfl_xor(ss, 1); ss += __shfl_xor(ss, 2); ss += __shfl_xor(ss, 4);
        if ((lane & 7) == 0) AK[(size_t)(lane >> 3) * KPAD + row] = rsqrtf(ss * (1.0f / 128.0f) + EPS) * QSCALE2;
    }
    if (blockIdx.x == 0 && tid < 128) AK[(size_t)(tid >> 4) * KPAD + S_ROWS + NMETA + (tid & 15)] = 0.f;
}

__device__ __forceinline__ unsigned vimg_off(unsigned row, unsigned ch) { return 256u * row + 16u * (ch ^ (((row & 3u) << 2) | ((row >> 2) & 3u))); }

template <bool FOX>
__device__ __forceinline__ void attn_task(const Args& a, const int head, const int qt, LAS unsigned char* vl, const int lane, const float zb2) {
    const int r = lane & 31, hh = lane >> 5;
    const int q0 = qt * 32;
    const bf16_t* Qt = (const bf16_t*)(a.ws + WS_PROJ + (FOX ? 3 : 0) * PROJ_T);
    const bf16_t* Kt = (const bf16_t*)(a.ws + WS_PROJ + (FOX ? 4 : 1) * PROJ_T);
    const bf16_t* Vt = (const bf16_t*)(a.ws + WS_PROJ + (FOX ? 5 : 2) * PROJ_T);
    const bf16_t* MK = (const bf16_t*)(a.ws + WS_METAKV) + (FOX ? 2 : 0) * 32 * 1024;
    const bf16_t* MV = (const bf16_t*)(a.ws + WS_METAKV) + (FOX ? 3 : 1) * 32 * 1024;
    const float* CK2 = (const float*)(a.ws + WS_CK2) + (size_t)head * KPAD;
    const float* AKp = (const float*)(a.ws + WS_AK) + (size_t)head * KPAD;
    bf16x8 qf[8];
    {
        const bf16_t* qp = Qt + (size_t)(q0 + r) * WID + head * 128 + 8 * hh;
        if (FOX) {
            bf16x8 raw[8]; float ss = 0.f;
#pragma unroll
            for (int k = 0; k < 8; ++k) {
                raw[k] = *(const bf16x8*)(qp + 16 * k);
#pragma unroll
                for (int j = 0; j < 8; ++j) { const float f = bf2f((unsigned short)raw[k][j]); ss += f * f; }
            }
            ss += __shfl_xor(ss, 32);
            const float rstd = rsqrtf(ss * (1.0f / 128.0f) + EPS);
#pragma unroll
            for (int k = 0; k < 8; ++k) {
                const f32x4 g0 = *(const f32x4*)(a.gq + 16 * k + 8 * hh), g1 = *(const f32x4*)(a.gq + 16 * k + 8 * hh + 4);
                const f32x4 h0 = *(const f32x4*)(a.gk + 16 * k + 8 * hh), h1 = *(const f32x4*)(a.gk + 16 * k + 8 * hh + 4);
                float y[8];
#pragma unroll
                for (int j = 0; j < 4; ++j) { y[j] = (bf2f((unsigned short)raw[k][j]) * rstd) * g0[j] * h0[j]; y[4 + j] = (bf2f((unsigned short)raw[k][4 + j]) * rstd) * g1[j] * h1[j]; }
                u32x4 w; w.x = pk_bf16(y[0], y[1]); w.y = pk_bf16(y[2], y[3]); w.z = pk_bf16(y[4], y[5]); w.w = pk_bf16(y[6], y[7]);
                qf[k] = __builtin_bit_cast(bf16x8, w);
            }
        } else {
#pragma unroll
            for (int k = 0; k < 8; ++k) {
                const bf16x8 raw = *(const bf16x8*)(qp + 16 * k);
                float y[8];
#pragma unroll
                for (int j = 0; j < 8; ++j) y[j] = bf2f((unsigned short)raw[j]) * QSCALE2;
                u32x4 w; w.x = pk_bf16(y[0], y[1]); w.y = pk_bf16(y[2], y[3]); w.z = pk_bf16(y[4], y[5]); w.w = pk_bf16(y[6], y[7]);
                qf[k] = __builtin_bit_cast(bf16x8, w);
            }
        }
    }
    f32x16 o[4];
#pragma unroll
    for (int dt = 0; dt < 4; ++dt)
#pragma unroll
        for (int i = 0; i < 16; ++i) o[dt][i] = 0.f;
    float m_run = -1e30f, lsum = 0.f, carry = 0.f;
    const float cq2 = FOX ? CK2[q0 + r] : 0.f;
    unsigned trb[2], trx[4];
    {
        const unsigned tq = (lane & 15) >> 2, tp = lane & 3, tblk = (lane >> 4) & 1;
#pragma unroll
        for (int jj = 0; jj < 2; ++jj) trb[jj] = 256u * (8u * jj + 4u * hh + tq) + 16u * ((2u * tblk + (tp >> 1)) ^ (hh + 2u * jj)) + 8u * (tp & 1u);
#pragma unroll
        for (int dt = 0; dt < 4; ++dt) trx[dt] = 64u * ((unsigned)dt ^ tq);
    }

    const unsigned koff = (unsigned)(r * WID + 8 * hh) * 2u;
    const unsigned voff = (unsigned)((lane >> 4) * WID + (lane & 15) * 8) * 2u;
    unsigned vlo4[4];
#pragma unroll
    for (int j = 0; j < 4; ++j) vlo4[j] = vimg_off((unsigned)(4 * j + (lane >> 4)), (unsigned)(lane & 15)) - 1024u * j;
    for (int it = qt; it >= -1; --it) {
        const bool meta = it < 0, diag = it == qt;
        const int kbase = meta ? S_ROWS : it * 32;
        const bf16_t* Kp = meta ? MK + head * 128 : Kt + (size_t)kbase * WID + head * 128;
        const bf16_t* Vp = meta ? MV + head * 128 : Vt + (size_t)kbase * WID + head * 128;
        bf16x8 kf[8];
#pragma unroll
        for (int k = 0; k < 8; ++k) kf[k] = *(const bf16x8*)((const char*)Kp + koff + 32 * k);
        f32x16 st;
#pragma unroll
        for (int i = 0; i < 16; ++i) st[i] = 0.f;
#pragma unroll
        for (int k = 0; k < 8; ++k) st = __builtin_amdgcn_mfma_f32_32x32x16_bf16(kf[k], qf[k], st, 0, 0, 0);
#pragma unroll
        for (int cq = 0; cq < 2; ++cq) {
            u32x4 vst[4];
#pragma unroll
            for (int c = 0; c < 4; ++c) vst[c] = *(const u32x4*)((const char*)(Vp + (size_t)(4 * cq + c) * 4 * WID) + voff);
#pragma unroll
            for (int c = 0; c < 4; ++c) *(LAS u32x4*)(vl + vlo4[c] + 1024u * (4 * cq + c)) = vst[c];
        }
        float p[16];
        if (FOX) {
            float t[16];
#pragma unroll
            for (int aa = 0; aa < 4; ++aa) {
                const f32x4 ak4 = *(const f32x4*)(AKp + kbase + 8 * aa + 4 * hh), ck4 = *(const f32x4*)(CK2 + kbase + 8 * aa + 4 * hh);
#pragma unroll
                for (int e = 0; e < 4; ++e) t[4 * aa + e] = st[4 * aa + e] * ak4[e] - ck4[e];
            }
            if (diag) {
#pragma unroll
                for (int i = 0; i < 16; ++i) { const int kl = (i & 3) + 8 * (i >> 2) + 4 * hh; t[i] = kl > r ? -1e30f : t[i]; }
            }
            if (meta) {
#pragma unroll
                for (int i = 0; i < 16; ++i) { const int kl = (i & 3) + 8 * (i >> 2) + 4 * hh; t[i] = kl >= NMETA ? -1e30f : t[i]; }
            }
            float mx = t[0];
#pragma unroll
            for (int i = 1; i < 16; ++i) mx = fmaxf(mx, t[i]);
            mx = fmaxf(mx, __shfl_xor(mx, 32));
            const float mnew = fmaxf(m_run, mx + cq2);
            const float alpha = ex2(m_run - mnew);
            lsum *= alpha;
#pragma unroll
            for (int dt = 0; dt < 4; ++dt)
#pragma unroll
                for (int i = 0; i < 16; ++i) o[dt][i] *= alpha;
            const float sh = cq2 - mnew;
            float ps = 0.f;
#pragma unroll
            for (int i = 0; i < 16; ++i) { p[i] = ex2(t[i] + sh); ps += p[i]; }
            lsum += ps; m_run = mnew;
        } else {
            float l2[16], lb[16];
#pragma unroll
            for (int i = 0; i < 16; ++i) {
                const float z = st[i];
                const float sp = fmaxf(z, 0.f) + lg2(1.0f + ex2(-fabsf(z)));
                l2[i] = -sp; lb[i] = z - sp;
            }
            if (diag) {
#pragma unroll
                for (int i = 0; i < 16; ++i) { const int kl = (i & 3) + 8 * (i >> 2) + 4 * hh; const bool vis = kl < r; l2[i] = vis ? l2[i] : 0.f; lb[i] = vis ? lb[i] : -1e30f; }
            }
            if (meta) {
#pragma unroll
                for (int i = 0; i < 16; ++i) { const int kl = (i & 3) + 8 * (i >> 2) + 4 * hh; const bool vis = kl < NMETA; l2[i] = vis ? l2[i] : 0.f; lb[i] = vis ? lb[i] : -1e30f; }
            }
            float g[4], pg[4];
#pragma unroll
            for (int aa = 0; aa < 4; ++aa) g[aa] = (l2[4 * aa + 3] + l2[4 * aa + 2]) + (l2[4 * aa + 1] + l2[4 * aa]);
#pragma unroll
            for (int aa = 0; aa < 4; ++aa) pg[aa] = __shfl_xor(g[aa], 32);
            float run = carry;
#pragma unroll
            for (int aa = 3; aa >= 0; --aa) {
                const float gh1 = hh ? g[aa] : pg[aa];
                const float off = hh ? run : run + gh1;
                const float e3 = off, e2 = off + l2[4 * aa + 3], e1 = e2 + l2[4 * aa + 2], e0 = e1 + l2[4 * aa + 1];
                p[4 * aa + 3] = ex2(lb[4 * aa + 3] + e3); p[4 * aa + 2] = ex2(lb[4 * aa + 2] + e2);
                p[4 * aa + 1] = ex2(lb[4 * aa + 1] + e1); p[4 * aa + 0] = ex2(lb[4 * aa + 0] + e0);
                run += g[aa] + pg[aa];
            }
            carry = run;
        }
        bf16x8 pb[2];
#pragma unroll
        for (int s = 0; s < 2; ++s) {
            u32x4 w; w.x = pk_bf16(p[8 * s + 0], p[8 * s + 1]); w.y = pk_bf16(p[8 * s + 2], p[8 * s + 3]); w.z = pk_bf16(p[8 * s + 4], p[8 * s + 5]); w.w = pk_bf16(p[8 * s + 6], p[8 * s + 7]);
            pb[s] = __builtin_bit_cast(bf16x8, w);
        }
#pragma unroll
        for (int dt = 0; dt < 4; ++dt) {
#pragma unroll
            for (int s = 0; s < 2; ++s) {
                const s16x4 t0 = __builtin_amdgcn_ds_read_tr16_b64_v4i16((LAS s16x4*)(vl + (trb[0] + trx[dt]) + 4096u * s));
                const s16x4 t1 = __builtin_amdgcn_ds_read_tr16_b64_v4i16((LAS s16x4*)(vl + (trb[1] + trx[dt]) + 4096u * s));
                bf16x8 vf; vf[0] = t0[0]; vf[1] = t0[1]; vf[2] = t0[2]; vf[3] = t0[3]; vf[4] = t1[0]; vf[5] = t1[1]; vf[6] = t1[2]; vf[7] = t1[3];
                o[dt] = __builtin_amdgcn_mfma_f32_32x32x16_bf16(vf, pb[s], o[dt], 0, 0, 0);
            }
        }
        if (!meta) {
            if (FOX) {
                const int nh = it > 0 ? (it - 1) * 32 + 31 : S_ROWS + NMETA - 1;
                const float cnext = CK2[nh];
                if (__all((zb2 + cq2 - cnext - m_run) < -151.0f)) break;
            } else {
                if (__all(carry < -151.0f)) break;
            }
        }
    }
    if (FOX) {
        lsum += __shfl_xor(lsum, 32);
        const float inv = 1.0f / lsum;
#pragma unroll
        for (int dt = 0; dt < 4; ++dt)
#pragma unroll
            for (int i = 0; i < 16; ++i) o[dt][i] *= inv;
    }
    float sq = 0.f;
#pragma unroll
    for (int dt = 0; dt < 4; ++dt)
#pragma unroll
        for (int i = 0; i < 16; ++i) sq += o[dt][i] * o[dt][i];
    sq += __shfl_xor(sq, 32);
    float* SQ = (float*)(a.ws + WS_SQ) + (FOX ? (size_t)S_ROWS * 8 : 0);
    if (hh == 0) SQ[(size_t)(q0 + r) * 8 + head] = sq;
    bf16_t* Ot = (bf16_t*)(a.ws + WS_ATT + (FOX ? PROJ_T : 0)) + (size_t)(q0 + r) * WID + head * 128 + 4 * hh;
#pragma unroll
    for (int dt = 0; dt < 4; ++dt)
#pragma unroll
        for (int aa = 0; aa < 4; ++aa) {
            u32x2 w; w.x = pk_bf16(o[dt][4 * aa], o[dt][4 * aa + 1]); w.y = pk_bf16(o[dt][4 * aa + 2], o[dt][4 * aa + 3]);
            *(u32x2*)(Ot + 32 * dt + 8 * aa) = w;
        }
}

__device__ __forceinline__ void phase_attn(const Args& a, LAS unsigned char* lds) {
    const int tid = threadIdx.x, wid = tid >> 6, lane = tid & 63;
    LAS unsigned char* vl = lds + wid * 8192;
    unsigned* qctr = (unsigned*)(a.ws + WS_CTL) + QCTR_WORD;
    float gm = fmaxf(fabsf(a.gq[lane] * a.gk[lane]), fabsf(a.gq[lane + 64] * a.gk[lane + 64]));
    gm = wave_max(gm);
    const float zb2 = 11.313708499f * gm * LOG2E * 1.02f;
    for (;;) {
        unsigned T = 0;
        if (lane == 0) T = __hip_atomic_fetch_add(qctr, 1u, __ATOMIC_RELAXED, __HIP_MEMORY_SCOPE_AGENT);
        T = __builtin_amdgcn_readfirstlane(T);
        if (T >= 8192u) break;
        if (T < 4096u) attn_task<true>(a, (int)(T & 7u), 511 - (int)(T >> 3), vl, lane, zb2);
        else { const unsigned U = T - 4096u; attn_task<false>(a, (int)(U & 7u), 511 - (int)(U >> 3), vl, lane, zb2); }
    }
}

__device__ __forceinline__ void phase_merge(const Args& a) {
    const int gt = blockIdx.x * 512 + threadIdx.x, ngt = gridDim.x * 512;
    const bf16_t* SBO = (const bf16_t*)(a.ws + WS_ATT); const bf16_t* FOXO = (const bf16_t*)(a.ws + WS_ATT + PROJ_T);
    const bf16_t* FG = (const bf16_t*)(a.ws + WS_PROJ + 6 * PROJ_T);
    const float* SBSQ = (const float*)(a.ws + WS_SQ); const float* FOXSQ = SBSQ + (size_t)S_ROWS * 8;
    bf16_t* MG = (bf16_t*)(a.ws + WS_MERGED);
    for (int i = gt; i < S_ROWS * 256; i += ngt) {
        const int row = i >> 8, c8 = (i & 255) * 8;
        const bool fox = c8 >= WID; const int c = fox ? c8 - WID : c8;
        const float* sqp = (fox ? FOXSQ : SBSQ) + (size_t)row * 8;
        const f32x4 s0 = *(const f32x4*)sqp, s1 = *(const f32x4*)(sqp + 4);
        const float rstd = rsqrtf(((s0[0] + s0[1]) + (s0[2] + s0[3]) + (s1[0] + s1[1]) + (s1[2] + s1[3])) * (1.0f / WID) + EPS);
        const u32x4 ov = *(const u32x4*)((fox ? FOXO : SBO) + (size_t)row * WID + c);
        const float* gp = (fox ? a.g_fox : a.g_sb) + c;
        const f32x4 g0 = *(const f32x4*)gp, g1 = *(const f32x4*)(gp + 4);
        float y[8];
#pragma unroll
        for (int e = 0; e < 2; ++e) { y[2 * e] = (bflo(ov[e]) * rstd) * g0[2 * e]; y[2 * e + 1] = (bfhi(ov[e]) * rstd) * g0[2 * e + 1];
                                      y[4 + 2 * e] = (bflo(ov[2 + e]) * rstd) * g1[2 * e]; y[5 + 2 * e] = (bfhi(ov[2 + e]) * rstd) * g1[2 * e + 1]; }
        if (fox) {
            const u32x4 gv = *(const u32x4*)(FG + (size_t)row * WID + c);
#pragma unroll
            for (int e = 0; e < 4; ++e) { y[2 * e] *= 1.0f / (1.0f + __expf(-bflo(gv[e]))); y[2 * e + 1] *= 1.0f / (1.0f + __expf(-bfhi(gv[e]))); }
        }
        u32x4 w; w.x = pk_bf16(y[0], y[1]); w.y = pk_bf16(y[2], y[3]); w.z = pk_bf16(y[4], y[5]); w.w = pk_bf16(y[6], y[7]);
        *(u32x4*)(MG + (size_t)row * DM + c8) = w;
    }
}

struct EpiOut {
    static constexpr bool PERM = true, AFTER_DRAIN = false;
    const float* X; float* H1; bf16_t* H1G; const float* gffn; float* rowsq;
    __device__ __forceinline__ void operator()(const f32x4 (&acc)[2][2][4][2], const pg8::Unit& u, int wr, int wc, int fr, int fq) const {
        const int row0 = u.pm * 256 + wr * 64 + fr, col0 = u.pn * 256 + wc * 32 + 8 * fq;
#pragma unroll
        for (int ai = 0; ai < 2; ++ai)
#pragma unroll
            for (int m = 0; m < 4; ++m) {
                const int row = row0 + ai * 128 + m * 16; float ss = 0.f;
#pragma unroll
                for (int bj = 0; bj < 2; ++bj) {
                    const int c = col0 + bj * 128;
                    const f32x4 x0 = *(const f32x4*)(X + (size_t)row * DM + c), x1 = *(const f32x4*)(X + (size_t)row * DM + c + 4);
                    const f32x4 g0 = *(const f32x4*)(gffn + c), g1 = *(const f32x4*)(gffn + c + 4);
                    const f32x4 h0 = acc[ai][bj][m][0] + x0, h1 = acc[ai][bj][m][1] + x1;
                    *(f32x4*)(H1 + (size_t)row * DM + c) = h0; *(f32x4*)(H1 + (size_t)row * DM + c + 4) = h1;
                    ss += (h0[0] * h0[0] + h0[1] * h0[1]) + (h0[2] * h0[2] + h0[3] * h0[3]) + (h1[0] * h1[0] + h1[1] * h1[1]) + (h1[2] * h1[2] + h1[3] * h1[3]);
                    u32x4 w; w.x = pk_bf16(h0[0] * g0[0], h0[1] * g0[1]); w.y = pk_bf16(h0[2] * g0[2], h0[3] * g0[3]);
                    w.z = pk_bf16(h1[0] * g1[0], h1[1] * g1[1]); w.w = pk_bf16(h1[2] * g1[2], h1[3] * g1[3]);
                    *(u32x4*)(H1G + (size_t)row * DM + c) = w;
                }
                ss += __shfl_xor(ss, 16); ss += __shfl_xor(ss, 32);
                if (fq == 0) rowsq[(size_t)row * 32 + u.pn * 4 + wc] = ss;
            }
    }
};

__device__ __forceinline__ float row_rstd2(const float* ROWSQ, int row) {
    const float* p = ROWSQ + (size_t)row * 32; float s = 0.f;
#pragma unroll
    for (int j = 0; j < 8; ++j) { const f32x4 v = *(const f32x4*)(p + 4 * j); s += (v[0] + v[1]) + (v[2] + v[3]); }
    return rsqrtf(s * (1.0f / DM) + EPS);
}

__device__ __forceinline__ unsigned fkey(float s) { const unsigned u = __float_as_uint(s); return (u & 0x80000000u) ? ~u : (u | 0x80000000u); }
__device__ __forceinline__ float fval(unsigned k) { const unsigned u = (k & 0x80000000u) ? (k & 0x7fffffffu) : ~k; return __uint_as_float(u); }
__device__ __forceinline__ void insert16(unsigned (&L)[16], unsigned x) {
#pragma unroll
    for (int j = 0; j < 16; ++j) { const unsigned hi = L[j] > x ? L[j] : x; x = L[j] > x ? x : L[j]; L[j] = hi; }
}

__device__ __forceinline__ void phase_topk(const Args& a, LAS unsigned char* lds) {
    const int tid = threadIdx.x, wid = tid >> 6, lane = tid & 63, r = lane & 31, hh = lane >> 5;
    const bf16_t* PQ = (const bf16_t*)(a.ws + WS_PQ); const bf16_t* SUBK = (const bf16_t*)(a.ws + WS_SUBK);
    const float* ROWSQ = (const float*)(a.ws + WS_ROWSQ);
    int* IDX = (int*)(a.ws + WS_IDX); float* G = (float*)(a.ws + WS_G);
    LAS unsigned* ib = (LAS unsigned*)(lds + wid * 2048 + lane * 32);
    for (int task = blockIdx.x * 8 + wid; task < 512 * 8; task += gridDim.x * 8) {
        const int tt = task >> 3, hd = task & 7, token = tt * 32 + r;
        unsigned LA[16], LB[16];
#pragma unroll
        for (int j = 0; j < 16; ++j) { LA[j] = 0u; LB[j] = 0u; }
#pragma unroll 1
        for (int p = 0; p < 2; ++p) {
            bf16x8 bq[8];
            const bf16_t* qp = PQ + (size_t)token * DM + hd * 256 + p * 128 + 8 * hh;
#pragma unroll
            for (int k = 0; k < 8; ++k) bq[k] = *(const bf16x8*)(qp + 16 * k);
            unsigned L[16];
#pragma unroll
            for (int j = 0; j < 16; ++j) L[j] = 0u;
#pragma unroll 1
            for (int mt = 0; mt < 4; ++mt) {
                f32x16 acc;
#pragma unroll
                for (int i = 0; i < 16; ++i) acc[i] = 0.f;
                const bf16_t* sp = SUBK + ((size_t)(hd * 2 + p) * 128 + 32 * mt + r) * 128 + 8 * hh;
#pragma unroll
                for (int k = 0; k < 8; ++k) { const bf16x8 ak = *(const bf16x8*)(sp + 16 * k); acc = __builtin_amdgcn_mfma_f32_32x32x16_bf16(ak, bq[k], acc, 0, 0, 0); }
#pragma unroll
                for (int i = 0; i < 16; ++i) { const unsigned n = 32u * mt + (i & 3) + 8u * (i >> 2) + 4u * hh; insert16(L, (fkey(acc[i]) & ~127u) | n); }
            }
            unsigned P[16];
#pragma unroll
            for (int j = 0; j < 16; ++j) P[j] = (unsigned)__shfl_xor((int)L[j], 32);
#pragma unroll
            for (int j = 0; j < 16; ++j) insert16(L, P[j]);
#pragma unroll
            for (int j = 0; j < 16; ++j) { if (p == 0) LA[j] = L[j]; else LB[j] = L[j]; }
        }
#pragma unroll
        for (int w = 0; w < 4; ++w) {
            ib[w] = (LA[4 * w] & 127u) | ((LA[4 * w + 1] & 127u) << 8) | ((LA[4 * w + 2] & 127u) << 16) | ((LA[4 * w + 3] & 127u) << 24);
            ib[4 + w] = (LB[4 * w] & 127u) | ((LB[4 * w + 1] & 127u) << 8) | ((LB[4 * w + 2] & 127u) << 16) | ((LB[4 * w + 3] & 127u) << 24);
        }
        float va[16], vb[16];
#pragma unroll
        for (int j = 0; j < 16; ++j) { va[j] = fval(LA[j] & ~127u); vb[j] = fval(LB[j] & ~127u); }
        unsigned C[16];
#pragma unroll
        for (int j = 0; j < 16; ++j) C[j] = 0u;
#pragma unroll
        for (int i = 0; i < 16; ++i)
#pragma unroll
            for (int j = 0; j < 16; ++j)
                if ((i + 1) * (j + 1) <= 16) insert16(C, (fkey(va[i] + vb[j]) & ~255u) | (unsigned)(i * 16 + j));
        const float rstd = row_rstd2(ROWSQ, token);
        const float s0 = fval(C[0] & ~255u);
        float ex[16], den = 0.f; int eid[16];
        const LAS unsigned char* ibb = (const LAS unsigned char*)ib;
#pragma unroll
        for (int k = 0; k < 16; ++k) {
            const unsigned cid = C[k] & 255u;
            const unsigned ia = ibb[cid >> 4], ibv = ibb[16 + (cid & 15u)];
            eid[k] = (int)(ia * 128u + ibv);
            ex[k] = __expf((fval(C[k] & ~255u) - s0) * rstd); den += ex[k];
        }
        const float inv = 1.0f / den;
        if (hh == 0) {
#pragma unroll
            for (int k = 0; k < 16; k += 4) { int4 v; v.x = eid[k]; v.y = eid[k + 1]; v.z = eid[k + 2]; v.w = eid[k + 3]; *(int4*)(IDX + (size_t)token * 128 + hd * 16 + k) = v; }
        } else {
#pragma unroll
            for (int k = 0; k < 16; k += 4) { f32x4 v; v[0] = ex[k] * inv; v[1] = ex[k + 1] * inv; v[2] = ex[k + 2] * inv; v[3] = ex[k + 3] * inv; *(f32x4*)(G + (size_t)token * 128 + hd * 16 + k) = v; }
        }
    }
}

__device__ __forceinline__ void phase_gather(const Args& a) {
    const int tid = threadIdx.x, wid = tid >> 6, lane = tid & 63;
    const bf16_t* H1G = (const bf16_t*)(a.ws + WS_H1G); const float* ROWSQ = (const float*)(a.ws + WS_ROWSQ);
    const int* IDX = (const int*)(a.ws + WS_IDX); const float* G = (const float*)(a.ws + WS_G);
    for (int tok = blockIdx.x * 8 + wid; tok < S_ROWS; tok += gridDim.x * 8) {
        f32x4 hv[8];
#pragma unroll
        for (int c = 0; c < 8; ++c) { const u32x2 raw = *(const u32x2*)(H1G + (size_t)tok * DM + c * 256 + lane * 4); hv[c][0] = bflo(raw.x); hv[c][1] = bfhi(raw.x); hv[c][2] = bflo(raw.y); hv[c][3] = bfhi(raw.y); }
        const float rstd = row_rstd2(ROWSQ, tok);
        f32x4 acc[8];
#pragma unroll
        for (int c = 0; c < 8; ++c) acc[c] = (f32x4){0.f, 0.f, 0.f, 0.f};
        for (int half = 0; half < 2; ++half) {
            const int idxv = IDX[(size_t)tok * 128 + half * 64 + lane]; const float gv = G[(size_t)tok * 128 + half * 64 + lane];
#pragma unroll 2
            for (int k = 0; k < 64; ++k) {
                const int e = __builtin_amdgcn_readlane(idxv, k); const float gk = __uint_as_float((unsigned)__builtin_amdgcn_readlane((int)__float_as_uint(gv), k));
                const float* ur = a.pu + (size_t)e * DM + lane * 4; const float* vr = a.pv + (size_t)e * DM + lane * 4;
                f32x4 uu[8], vv[8];
#pragma unroll
                for (int c = 0; c < 8; ++c) uu[c] = *(const f32x4*)(ur + c * 256);
#pragma unroll
                for (int c = 0; c < 8; ++c) vv[c] = *(const f32x4*)(vr + c * 256);
                float d = 0.f;
#pragma unroll
                for (int c = 0; c < 8; ++c) d += (uu[c][0] * hv[c][0] + uu[c][1] * hv[c][1]) + (uu[c][2] * hv[c][2] + uu[c][3] * hv[c][3]);
                d = wave_sum(d);
                const float xk = d * rstd;
                const float w = gk * (0.5f * xk * (1.0f + erff(xk * 0.70710678118f)));
#pragma unroll
                for (int c = 0; c < 8; ++c) acc[c] += vv[c] * w;
            }
        }
#pragma unroll
        for (int c = 0; c < 8; ++c) { float* op = a.out + (size_t)tok * DM + c * 256 + lane * 4; const f32x4 h = *(const f32x4*)op; *(f32x4*)op = h + acc[c]; }
    }
}

__global__ void __launch_bounds__(512, 2) hymba_fwd(Args a) {
    extern __shared__ __attribute__((aligned(16))) unsigned char shm[];
    LAS unsigned char* lds = (LAS unsigned char*)shm;
    volatile LAS unsigned* xbw = (volatile LAS unsigned*)(lds + LDS_BYTES - 16);
    if (threadIdx.x == 0) { xbw[0] = 0u; xbw[1] = 0u; xbw[2] = 0u; xbw[3] = 0u; }
    __syncthreads();
    XcdBarrier bar = xcd_barrier_post((unsigned*)(a.ws + WS_CTL), xbw);
#ifndef PHMASK
#define PHMASK 0x1ff
#endif
#define RUN(p) ((((PHMASK) >> (p)) & 1) && a.ph_lo <= (p) && (p) < a.ph_hi)
#define SEAM(p) do { if (a.ph_lo <= (p) && (p) + 1 < a.ph_hi) xcd_barrier(bar); } while (0)
    if (RUN(0)) phase_prep(a, lds);
    SEAM(0);
    if (RUN(1)) {
        phase_cumf_meta(a, lds);
        pg8::Gemm g; g.A = (const bf16_t*)(a.ws + WS_XN); g.Bt = (const bf16_t*)(a.ws + WS_WTIN); g.M = S_ROWS; g.N = NPROJ; g.K = DM;
        pg8::StaticOrder so; so.init(g.M, g.N, (int)gridDim.x, (int)blockIdx.x);
        pg8::EpiBf16<0> ep; ep.O = (bf16_t*)(a.ws + WS_PROJ); ep.ldc = WID; ep.bias = nullptr; ep.split_cols = WID; ep.split_stride = (size_t)S_ROWS * WID;
        pg8::gemm_phase<pg8::EpiBf16<0>, pg8::StaticOrder, false>(lds, g, so, ep, nullptr);
    }
    SEAM(1);
    if (RUN(2)) phase_ak(a);
    SEAM(2);
    if (RUN(3)) phase_attn(a, lds);
    SEAM(3);
    if (RUN(4)) phase_merge(a);
    SEAM(4);
    if (RUN(5)) {
        pg8::Gemm g; g.A = (const bf16_t*)(a.ws + WS_MERGED); g.Bt = (const bf16_t*)(a.ws + WS_WTOUT); g.M = S_ROWS; g.N = DM; g.K = DM;
        pg8::StaticOrder so; so.init(g.M, g.N, (int)gridDim.x, (int)blockIdx.x);
        EpiOut ep; ep.X = a.x; ep.H1 = a.out; ep.H1G = (bf16_t*)(a.ws + WS_H1G); ep.gffn = a.norm_ffn; ep.rowsq = (float*)(a.ws + WS_ROWSQ);
        pg8::gemm_phase<EpiOut, pg8::StaticOrder, false>(lds, g, so, ep, nullptr);
    }
    SEAM(5);
    if (RUN(6)) {
        pg8::Gemm g; g.A = (const bf16_t*)(a.ws + WS_H1G); g.Bt = (const bf16_t*)(a.ws + WS_WTQ); g.M = S_ROWS; g.N = DM; g.K = DM;
        pg8::StaticOrder so; so.init(g.M, g.N, (int)gridDim.x, (int)blockIdx.x);
        pg8::EpiBf16<0> ep; ep.O = (bf16_t*)(a.ws + WS_PQ); ep.ldc = DM; ep.bias = nullptr; ep.split_cols = 0; ep.split_stride = 0;
        pg8::gemm_phase<pg8::EpiBf16<0>, pg8::StaticOrder, false>(lds, g, so, ep, nullptr);
    }
    SEAM(6);
    if (RUN(7)) phase_topk(a, lds);
    SEAM(7);
    if (RUN(8)) phase_gather(a);
#undef RUN
#undef SEAM
}

#ifndef N_LAUNCHES
#define N_LAUNCHES 1
#endif
extern "C" void kernel_launch(void* const* d_in, const int* in_sizes, int n_in, void* d_out, int out_size, void* d_ws, size_t ws_size, hipStream_t stream) {
    static int grid = 0;
    if (grid == 0) {
        if (n_in != 15 || in_sizes[0] != S_ROWS * DM || out_size != S_ROWS * DM || ws_size < WS_END) {
            fprintf(stderr, "kernel_launch: unexpected shapes (n_in %d, in0 %d, out %d, ws %zu, need %zu)\n", n_in, n_in > 0 ? in_sizes[0] : -1, out_size, ws_size, (size_t)WS_END); grid = -1; return; }
        int dev = 0, cus = 0, per_cu = 0;
        if (hipGetDevice(&dev) != hipSuccess || hipDeviceGetAttribute(&cus, hipDeviceAttributeMultiprocessorCount, dev) != hipSuccess) { grid = -1; return; }
        if (hipFuncSetAttribute((const void*)hymba_fwd, hipFuncAttributeMaxDynamicSharedMemorySize, LDS_BYTES) != hipSuccess) { fprintf(stderr, "kernel_launch: hipFuncSetAttribute failed\n"); grid = -1; return; }
        if (hipOccupancyMaxActiveBlocksPerMultiprocessor(&per_cu, (const void*)hymba_fwd, 512, LDS_BYTES) != hipSuccess || per_cu < 1) { fprintf(stderr, "kernel_launch: occupancy query says %d\n", per_cu); }
        (void)hipGetLastError();
        grid = cus;
    }
    if (grid < 0) return;
    Args a{};
    a.x = (const float*)d_in[0]; a.meta = (const float*)d_in[1]; a.norm_mix = (const float*)d_in[2]; a.w_in = (const float*)d_in[3]; a.b_forget = (const float*)d_in[4];
    a.gq = (const float*)d_in[5]; a.gk = (const float*)d_in[6]; a.g_sb = (const float*)d_in[7]; a.g_fox = (const float*)d_in[8]; a.w_out = (const float*)d_in[9];
    a.norm_ffn = (const float*)d_in[10]; a.w_query = (const float*)d_in[11]; a.sub_keys = (const float*)d_in[12]; a.pu = (const float*)d_in[13]; a.pv = (const float*)d_in[14];
    a.out = (float*)d_out; a.ws = (unsigned char*)d_ws;
    for (int li = 0; li < N_LAUNCHES; ++li) {
        if (N_LAUNCHES == 1) { a.ph_lo = 0; a.ph_hi = NPH; } else { a.ph_lo = li * NPH / N_LAUNCHES; a.ph_hi = (li + 1) * NPH / N_LAUNCHES; }
        if (li == 0 || true) (void)hipMemsetAsync((char*)d_ws + WS_CTL, 0, li == 0 ? CTL_BYTES : (size_t)XCD_BAR_WORDS * 4, stream);
        hipLaunchKernelGGL(hymba_fwd, dim3(grid), dim3(512), LDS_BYTES, stream, a);
    }
}
```

```cpp
#include <hip/hip_runtime.h>
#include <cstdio>
#include <cstdint>
#include <cstddef>


typedef short s16x4 __attribute__((ext_vector_type(4)));
typedef float f32x16 __attribute__((ext_vector_type(16)));
typedef unsigned u32x2 __attribute__((ext_vector_type(2)));
#define XB_TMO      128
#define XB_XCNT(j)  (256  + 64 * (j))
#define XB_XSUB(j)  (1280 + 64 * (j))
#define XB_XGEN(j)  (2304 + 64 * (j))
#define XB_TOP      3328
#define XB_TOPGEN   3392
#define XCD_BAR_WORDS 3456
#define XB_SPIN_CAP (1u << 18)
#define LAS __attribute__((address_space(3)))

__device__ __forceinline__ unsigned xb_ld(unsigned* p)              { return __hip_atomic_load(p, __ATOMIC_RELAXED, __HIP_MEMORY_SCOPE_AGENT); }
__device__ __forceinline__ unsigned xb_add(unsigned* p, unsigned v) { return __hip_atomic_fetch_add(p, v, __ATOMIC_RELAXED, __HIP_MEMORY_SCOPE_AGENT); }
__device__ __forceinline__ unsigned xb_xcc_id() { return (unsigned)__builtin_amdgcn_s_getreg((3 << 11) | 20) & 0xFu; }
#define XB_SPIN(cond, bar) do { unsigned _sp = 0; while (cond) { __builtin_amdgcn_s_sleep(1); \
    if ((++_sp & 255u) == 0u) { if (xb_ld(&(bar)[XB_TMO])) break; if (_sp > XB_SPIN_CAP) { atomicAdd(&(bar)[XB_TMO], 1u); break; } } } } while (0)

struct XcdBarrier {
    unsigned* bar; unsigned x;
    volatile LAS unsigned* st;
};

__device__ __forceinline__ XcdBarrier xcd_barrier_post(unsigned* bar, volatile LAS unsigned* st) {
    XcdBarrier b; b.bar = bar; b.x = xb_xcc_id(); b.st = st;
    if (threadIdx.x == 0) (void)xb_add(&bar[XB_XCNT(b.x)], 1u);
    return b;
}
__device__ __forceinline__ void xcd_barrier_complete(unsigned* bar, unsigned x, unsigned& nloc, unsigned& nx) {
    const unsigned G = gridDim.x * gridDim.y * gridDim.z;
    unsigned sum, cnt, mine, sp = 0u;
    for (;;) {
        sum = 0u; cnt = 0u; mine = 0u;
#pragma unroll
        for (unsigned j = 0; j < 16; ++j) { const unsigned c = xb_ld(&bar[XB_XCNT(j)]); sum += c; cnt += (c > 0u) ? 1u : 0u; mine = (j == x) ? c : mine; }
        if (sum == G) break;
        __builtin_amdgcn_s_sleep(1);
        if ((++sp & 255u) == 0u) { if (xb_ld(&bar[XB_TMO])) break; if (sp > XB_SPIN_CAP) { atomicAdd(&bar[XB_TMO], 1u); break; } }
    }
    nloc = mine > 0u ? mine : 1u; nx = cnt > 0u ? cnt : 1u;
}

__device__ __forceinline__ void xcd_barrier(const XcdBarrier& b) {
    asm volatile("s_waitcnt vmcnt(0)" ::: "memory");
    __syncthreads();
    if (threadIdx.x == 0) {
        unsigned* bar = b.bar;
        __builtin_amdgcn_s_waitcnt(0);
        unsigned nloc = b.st[0], nx = b.st[1];
        if (nloc == 0u) { xcd_barrier_complete(bar, b.x, nloc, nx); b.st[0] = nloc; b.st[1] = nx; }
        const unsigned old = xb_add(&bar[XB_XSUB(b.x)], 1u);
        const unsigned gen = old / nloc;
        if (old + 1u == (gen + 1u) * nloc) {
            __builtin_amdgcn_fence(__ATOMIC_RELEASE, "agent");
            asm volatile("s_waitcnt vmcnt(0)" ::: "memory");
            const unsigned og = xb_add(&bar[XB_TOP], 1u);
            const unsigned tg = og / nx;
            if (og + 1u == (tg + 1u) * nx) xb_add(&bar[XB_TOPGEN], 1u);
            else XB_SPIN(xb_ld(&bar[XB_TOPGEN]) == tg, bar);
            __builtin_amdgcn_fence(__ATOMIC_ACQUIRE, "agent");
            xb_add(&bar[XB_XGEN(b.x)], 1u);
            asm volatile("s_waitcnt vmcnt(0)" ::: "memory");
        } else {
            XB_SPIN(xb_ld(&bar[XB_XGEN(b.x)]) == gen, bar);
            __builtin_amdgcn_fence(__ATOMIC_ACQUIRE, "agent");
            asm volatile("s_waitcnt vmcnt(0)" ::: "memory");
        }
    }
    __syncthreads();
}

namespace pg8 {
#define PG8_LAS __attribute__((address_space(3)))
typedef unsigned short bf16_t;
typedef short bf16x8 __attribute__((ext_vector_type(8)));
typedef float f32x4 __attribute__((ext_vector_type(4)));
typedef unsigned u32x4 __attribute__((ext_vector_type(4)));
constexpr int BM = 256, BK = 64, HALF = 128, HTB = HALF * BK * 2  , STAGE_BYTES = 8 * HTB, NXCD = 8, WGM = 8;

__host__ __device__ __forceinline__ int lds_byte(int r, int c) { const int st = (r >> 4) * 2 + (c >> 5), rr = r & 15, cc = c & 31, ob = rr * 64 + cc * 2; return st * 1024 + (ob ^ (((ob >> 9) & 1) << 5)); }
__host__ __device__ __forceinline__ void stage_rc(int b, int& R, int& C) { const int st = b / 1024, sb = b % 1024, swz = sb ^ (((sb >> 9) & 1) << 5); R = (st >> 1) * 16 + swz / 64; C = (st & 1) * 32 + (swz % 64) / 2; }
__host__ __device__ __forceinline__ int perm32(int rho) { const int n = rho >> 4, i = rho & 15; return 8 * (i >> 2) + 4 * n + (i & 3); }

struct Unit { int pm, pn; };
struct Gemm { const bf16_t* A; const bf16_t* Bt; int M, N, K; };

struct StaticOrder {
    int nM, nN, nwg, G, c;
    __host__ __device__ void init(int M, int N, int G_, int c_) { nM = M / BM; nN = N / BM; nwg = nM * nN; G = G_; c = c_; }
    __host__ __device__ bool next(int i, Unit& u) const {
        const long L = (long)i * G + c; if (L >= nwg) return false;
        int wgid = (int)L; { const int q = nwg / NXCD, r = nwg % NXCD, xcd = wgid % NXCD, off = wgid / NXCD; wgid = (xcd < r ? xcd * (q + 1) : r * (q + 1) + (xcd - r) * q) + off; }
        const int nig = WGM * nN, gid = wgid / nig, fm = gid * WGM, gsz = (nM - fm) < WGM ? (nM - fm) : WGM;
        u.pm = fm + ((wgid % nig) % gsz); u.pn = (wgid % nig) / gsz; return true;
    }
    __device__ __forceinline__ void a_ready(const Unit&) const {}
    __device__ __forceinline__ void done(const Unit&) const {}
};

typedef __bf16 bf16x2_t __attribute__((ext_vector_type(2)));
__device__ __forceinline__ unsigned cvt_pk_bf16(float lo, float hi) { bf16x2_t v; v[0] = (__bf16)lo; v[1] = (__bf16)hi; return __builtin_bit_cast(unsigned, v); }
typedef float f32x2 __attribute__((ext_vector_type(2)));
__device__ __forceinline__ f32x2 gelu_pk(f32x2 v) {
    const f32x2 av = __builtin_elementwise_abs(v), d = av * 0.2316418882f + 1.0f;
    f32x2 t; t.x = __builtin_amdgcn_rcpf(d.x); t.y = __builtin_amdgcn_rcpf(d.y);
    f32x2 q = t * 0.5307027145f + (-0.7265760135f); q = q * t + 0.7107068705f; q = q * t + (-0.142248368f); q = q * t + 0.127414796f; q = q * t;
    const f32x2 s = (v * v) * (-0.72134752044f);
    f32x2 e; e.x = __builtin_amdgcn_exp2f(s.x); e.y = __builtin_amdgcn_exp2f(s.y);
    const f32x2 m = v * (q * e), r = v - m;
    f32x2 o; o.x = v.x < 0.f ? m.x : r.x; o.y = v.y < 0.f ? m.y : r.y; return o;
}
template <int ACT  > struct EpiBf16 {
    static constexpr bool PERM = true, AFTER_DRAIN = false; typedef f32x4 AccT;
    bf16_t* O; int ldc; const float* bias; int split_cols; size_t split_stride;
    __device__ __forceinline__ void operator()(const f32x4 (&acc)[2][2][4][2], const Unit& u, int wr, int wc, int fr, int fq) const {
        const int row0 = u.pm * BM + wr * 64 + fr; int colt = u.pn * BM; bf16_t* base = O;
        if (split_cols) { const int t = colt / split_cols; base += (size_t)t * split_stride; colt -= t * split_cols; }
        const int col0 = colt + wc * 32 + 8 * fq, bcol0 = u.pn * BM + wc * 32 + 8 * fq;
        f32x4 bv[2][2];
#pragma unroll
        for (int bj = 0; bj < 2; ++bj)
#pragma unroll
            for (int n = 0; n < 2; ++n) bv[bj][n] = bias ? *(const f32x4*)(bias + bcol0 + bj * HALF + 4 * n) : (f32x4){0.f, 0.f, 0.f, 0.f};
#pragma unroll
        for (int ai = 0; ai < 2; ++ai)
#pragma unroll
            for (int m = 0; m < 4; ++m) { bf16_t* rowp = base + (size_t)(row0 + ai * HALF + m * 16) * ldc + col0;
#pragma unroll
                for (int bj = 0; bj < 2; ++bj) { f32x4 v0 = acc[ai][bj][m][0] + bv[bj][0], v1 = acc[ai][bj][m][1] + bv[bj][1];
                    if (ACT == 1) { f32x2 a = gelu_pk((f32x2){v0[0], v0[1]}), b = gelu_pk((f32x2){v0[2], v0[3]}), c = gelu_pk((f32x2){v1[0], v1[1]}), d = gelu_pk((f32x2){v1[2], v1[3]});
                        v0 = (f32x4){a.x, a.y, b.x, b.y}; v1 = (f32x4){c.x, c.y, d.x, d.y}; }
                    if (ACT == 2) {
#pragma unroll
                        for (int j = 0; j < 4; ++j) { v0[j] = 0.5f * v0[j] * (1.0f + erff(v0[j] * 0.70710678f)); v1[j] = 0.5f * v1[j] * (1.0f + erff(v1[j] * 0.70710678f)); } }
                    u32x4 w; w.x = cvt_pk_bf16(v0[0], v0[1]); w.y = cvt_pk_bf16(v0[2], v0[3]); w.z = cvt_pk_bf16(v1[0], v1[1]); w.w = cvt_pk_bf16(v1[2], v1[3]);
                    *(u32x4*)(rowp + bj * HALF) = w; } }
    }
};

typedef int i32x4 __attribute__((ext_vector_type(4)));
template <class Epi, class Sched, bool STAMP = false, bool I8 = false>
__device__ __forceinline__ void gemm_phase(PG8_LAS unsigned char* lds, const Gemm g, const Sched& S, const Epi& E, unsigned long long* stamps) {
    const int tid = threadIdx.x, wid = __builtin_amdgcn_readfirstlane(tid >> 6), lane = tid & 63, wr = wid >> 2, wc = wid & 3, fr = lane & 15, fq = lane >> 4;
    const int K = g.K, nt = K / BK;
    int ts_lo = 0, ts_hi = 0, nts = 0; const unsigned long long rt_entry = STAMP ? (unsigned long long)wall_clock64() : 0ull;
#define PG8_STAMP() do { if (STAMP && wid == 0 && nts < 64) { const unsigned long long _c = (unsigned long long)clock64(); \
        ts_lo = (lane == nts) ? (int)(unsigned)_c : ts_lo; ts_hi = (lane == nts) ? (int)(unsigned)(_c >> 32) : ts_hi; ++nts; } } while (0)
    PG8_STAMP();
    unsigned voffA[2], voffB[2];
#pragma unroll
    for (int i = 0; i < 2; ++i) { int R, C; stage_rc(tid * 16 + i * 8192, R, C); const int Rb = Epi::PERM ? ((R & ~31) + perm32(R & 31)) : R;
        voffA[i] = (unsigned)(R * K + C) * 2u; voffB[i] = (unsigned)(Rb * K + C) * 2u; }
    const size_t kstep = (size_t)(BK * 2);
    const size_t hstep = (size_t)HALF * K * 2;
    const size_t tstep = 2 * hstep;
    const unsigned ldsw = (unsigned)wid * 1024u;
    const int aoff = lds_byte(wr * 64 + fr, fq * 8), boff = lds_byte(wc * 32 + fr, fq * 8);
#define PG8_SA(b, h) (((b) * 2 + (h)) * HTB)
#define PG8_SB(b, h) ((4 + (b) * 2 + (h)) * HTB)
#define PG8_STAGE(bufoff, gbase, voff) do { _Pragma("unroll") for (int _i = 0; _i < 2; ++_i) \
        __builtin_amdgcn_global_load_lds((const unsigned*)((const char*)(gbase) + (voff)[_i]), (PG8_LAS unsigned*)(lds + (bufoff) + ldsw + _i * 8192), 16, 0, 0); } while (0)
#define PG8_LDA(dst, b, h) do { _Pragma("unroll") for (int m = 0; m < 4; ++m) _Pragma("unroll") for (int k = 0; k < 2; ++k) dst[m][k] = *(const PG8_LAS bf16x8*)(lds + PG8_SA(b, h) + aoff + m * 2048 + k * 1024); } while (0)
#define PG8_LDB(dst, b, h) do { _Pragma("unroll") for (int n = 0; n < 2; ++n) _Pragma("unroll") for (int k = 0; k < 2; ++k) dst[n][k] = *(const PG8_LAS bf16x8*)(lds + PG8_SB(b, h) + boff + n * 2048 + k * 1024); } while (0)
#define PG8_MMA(ai, bj, At, Bt) do { __builtin_amdgcn_s_setprio(1); _Pragma("unroll") for (int m = 0; m < 4; ++m) _Pragma("unroll") for (int n = 0; n < 2; ++n) _Pragma("unroll") for (int k = 0; k < 2; ++k) { \
        if constexpr (I8) acc[ai][bj][m][n] = __builtin_bit_cast(AccT, __builtin_amdgcn_mfma_i32_16x16x64_i8(__builtin_bit_cast(i32x4, Bt[n][k]), __builtin_bit_cast(i32x4, At[m][k]), __builtin_bit_cast(i32x4, acc[ai][bj][m][n]), 0, 0, 0)); \
        else acc[ai][bj][m][n] = __builtin_bit_cast(AccT, __builtin_amdgcn_mfma_f32_16x16x32_bf16(Bt[n][k], At[m][k], __builtin_bit_cast(f32x4, acc[ai][bj][m][n]), 0, 0, 0)); } __builtin_amdgcn_s_setprio(0); } while (0)
#define PG8_WAIT_V(n) asm volatile("s_waitcnt vmcnt(" #n ")" ::: "memory")
#define PG8_WAIT_L(n) asm volatile("s_waitcnt lgkmcnt(" #n ")" ::: "memory")
#define PG8_BAR __builtin_amdgcn_s_barrier()
#define PG8_SCHED __builtin_amdgcn_sched_barrier(0)
    Unit cur, nxt; int ui = 0;
    if (!S.next(0, cur)) return;
    typedef typename Epi::AccT AccT;
    AccT acc[2][2][4][2];
#pragma unroll
    for (int a = 0; a < 2; ++a)
#pragma unroll
        for (int b = 0; b < 2; ++b)
#pragma unroll
            for (int m = 0; m < 4; ++m)
#pragma unroll
                for (int n = 0; n < 2; ++n) acc[a][b][m][n] = (AccT){0, 0, 0, 0};
    bf16x8 At[4][2], B0[2][2], B1[2][2];
    const char* cA = (const char*)g.A + (size_t)cur.pm * tstep; const char* cB = (const char*)g.Bt + (size_t)cur.pn * tstep;
    S.a_ready(cur);
    PG8_STAGE(PG8_SB(0, 0), cB, voffB); PG8_STAGE(PG8_SA(0, 0), cA, voffA); PG8_STAGE(PG8_SB(0, 1), cB + hstep, voffB); PG8_STAGE(PG8_SA(0, 1), cA + hstep, voffA);
    if (wr == 1) PG8_BAR;
    PG8_WAIT_V(4); PG8_BAR;
    PG8_STAGE(PG8_SB(1, 0), cB + kstep, voffB); PG8_STAGE(PG8_SA(1, 0), cA + kstep, voffA); PG8_STAGE(PG8_SB(1, 1), cB + hstep + kstep, voffB);
    PG8_WAIT_V(6); PG8_BAR;
    PG8_STAMP();
    for (;;) {
        const bool has_next = S.next(ui + 1, nxt);
        const char* nA = has_next ? (const char*)g.A + (size_t)nxt.pm * tstep : cA; const char* nB = has_next ? (const char*)g.Bt + (size_t)nxt.pn * tstep : cB;
        for (int t = 0; t < nt; t += 2) {
            const bool last = (t == nt - 2);
            const char* a1 = cA + (size_t)(t + 1) * kstep;
            const char* a2 = last ? nA : cA + (size_t)(t + 2) * kstep; const char* b2 = last ? nB : cB + (size_t)(t + 2) * kstep;
            const char* a3 = a2 + kstep; const char* b3 = b2 + kstep;
            if (last && has_next) S.a_ready(nxt);
            PG8_LDB(B0, 0, 0); PG8_SCHED; PG8_LDA(At, 0, 0); PG8_STAGE(PG8_SA(1, 1), a1 + hstep, voffA);
            PG8_WAIT_L(8); PG8_BAR; PG8_WAIT_L(0); PG8_MMA(0, 0, At, B0); PG8_BAR; PG8_SCHED;
            PG8_LDB(B1, 0, 1); PG8_STAGE(PG8_SB(0, 0), b2, voffB);
            PG8_BAR; PG8_WAIT_L(0); PG8_MMA(0, 1, At, B1); PG8_BAR;
            PG8_LDA(At, 0, 1); PG8_STAGE(PG8_SA(0, 0), a2, voffA);
            PG8_BAR; PG8_WAIT_L(0); PG8_MMA(1, 0, At, B0); PG8_BAR; PG8_SCHED;
            PG8_STAGE(PG8_SB(0, 1), b2 + hstep, voffB);
            PG8_WAIT_V(6); PG8_BAR; PG8_MMA(1, 1, At, B1); PG8_BAR;
            PG8_LDB(B0, 1, 0); PG8_SCHED; PG8_LDA(At, 1, 0); PG8_STAGE(PG8_SA(0, 1), a2 + hstep, voffA);
            PG8_WAIT_L(8); PG8_BAR; PG8_WAIT_L(0); PG8_MMA(0, 0, At, B0); PG8_BAR; PG8_SCHED;
            PG8_LDB(B1, 1, 1); PG8_STAGE(PG8_SB(1, 0), b3, voffB);
            PG8_BAR; PG8_WAIT_L(0); PG8_MMA(0, 1, At, B1); PG8_BAR;
            PG8_LDA(At, 1, 1); PG8_STAGE(PG8_SA(1, 0), a3, voffA);
            PG8_BAR; PG8_WAIT_L(0); PG8_MMA(1, 0, At, B0); PG8_BAR; PG8_SCHED;
            PG8_STAGE(PG8_SB(1, 1), b3 + hstep, voffB);
            PG8_WAIT_V(6); PG8_BAR; PG8_MMA(1, 1, At, B1); PG8_BAR;
        }
        PG8_STAMP();
        if constexpr (!Epi::AFTER_DRAIN) { E(acc, cur, wr, wc, fr, fq); S.done(cur); }
        PG8_STAMP();
        if (!has_next) break;
#pragma unroll
        for (int a = 0; a < 2; ++a)
#pragma unroll
            for (int b = 0; b < 2; ++b)
#pragma unroll
                for (int m = 0; m < 4; ++m)
#pragma unroll
                    for (int n = 0; n < 2; ++n) acc[a][b][m][n] = (AccT){0, 0, 0, 0};
        cur = nxt; cA = nA; cB = nB; ++ui;
    }
    PG8_WAIT_V(0);
    if (wr == 0) PG8_BAR;
    PG8_BAR;
    if constexpr (Epi::AFTER_DRAIN) { E.fused(acc, cur, wr, wc, fr, fq, lds, wid, lane); S.done(cur); }
    PG8_STAMP();
    if (STAMP && wid == 0) { stamps[lane] = lane < nts ? (((unsigned long long)(unsigned)ts_hi << 32) | (unsigned)ts_lo) : 0ull;
        if (lane == 62) stamps[62] = rt_entry; if (lane == 63) stamps[63] = (unsigned long long)wall_clock64(); }
#undef PG8_STAMP
#undef PG8_SA
#undef PG8_SB
#undef PG8_STAGE
#undef PG8_LDA
#undef PG8_LDB
#undef PG8_MMA
#undef PG8_WAIT_V
#undef PG8_WAIT_L
#undef PG8_BAR
#undef PG8_SCHED
}
}
using pg8::bf16_t; using pg8::bf16x8; using pg8::f32x4; using pg8::u32x4;

constexpr int S_ROWS = 16384, NMETA = 16, DM = 2048, WID = 1024, CIN = 7176, NPROJ = 7168;
constexpr int KPAD = 16416;
constexpr float EPS = 1e-6f;
constexpr float LOG2E = 1.4426950408889634f;
constexpr float QSCALE2 = 0.08838834764831845f * 1.4426950408889634f;
constexpr int LDS_BYTES = 155648;
constexpr int NPH = 10;
constexpr float PRUNE_LOG2 = -64.0f;

constexpr size_t al256(size_t x) { return (x + 255) & ~(size_t)255; }
constexpr size_t PROJ_T   = (size_t)S_ROWS * WID * 2;
constexpr size_t WS_CTL   = 0;
constexpr size_t CTL_BYTES = 65536;
constexpr size_t WS_WTIN  = CTL_BYTES;
constexpr size_t WS_WTOUT = WS_WTIN + (size_t)NPROJ * DM * 2;
constexpr size_t WS_WTQ   = WS_WTOUT + (size_t)DM * DM * 2;
constexpr size_t WS_SUBK  = WS_WTQ + (size_t)DM * DM * 2;
constexpr size_t WS_XN    = WS_SUBK + (size_t)16 * 128 * 128 * 2;
constexpr size_t WS_PROJ  = WS_XN + (size_t)KPAD * DM * 2;
constexpr size_t WS_METAKV= WS_PROJ + 7 * PROJ_T;
constexpr size_t WS_LCUM  = WS_METAKV + (size_t)4 * 32 * 1024 * 2;
constexpr size_t WS_CHT   = WS_LCUM + (size_t)KPAD * 8 * 4;
constexpr size_t WS_CK2   = al256(WS_CHT + 257 * 8 * 4);
constexpr size_t WS_AK    = WS_CK2 + (size_t)8 * KPAD * 4;
constexpr size_t WS_ATT   = al256(WS_AK + (size_t)8 * KPAD * 4);
constexpr size_t WS_SQ    = WS_ATT + 2 * PROJ_T;
constexpr size_t WS_ROWSQ = WS_SQ + 2 * (size_t)S_ROWS * 8 * 4;
constexpr size_t WS_U8    = WS_ROWSQ + (size_t)S_ROWS * 32 * 4;
constexpr size_t WS_SU4   = WS_U8 + (size_t)16384 * 1024;
constexpr size_t WS_V8    = WS_U8 + (size_t)16384 * DM;
constexpr size_t WS_SU    = WS_V8 + (size_t)16384 * DM;
constexpr size_t WS_SV    = WS_SU + (size_t)16384 * 4;
constexpr size_t WS_SA    = WS_SV + (size_t)16384 * 4;
constexpr size_t WS_SBIN  = WS_SA + (size_t)KPAD * 4;
constexpr size_t WS_SBOUT = WS_SBIN + (size_t)NPROJ * 4;
constexpr size_t WS_SM    = WS_SBOUT + (size_t)DM * 4;
constexpr size_t WS_END   = WS_SM + (size_t)S_ROWS * 4;
constexpr size_t WS_MERGED= WS_XN;
constexpr size_t WS_PQ    = WS_XN;
constexpr size_t WS_H1G   = WS_PROJ;
constexpr size_t WS_IDX   = WS_PROJ + 2 * PROJ_T;
constexpr size_t WS_G     = WS_IDX + (size_t)S_ROWS * 128 * 4;
constexpr size_t WS_HN8   = WS_PROJ + 3 * PROJ_T;
constexpr size_t WS_COEF  = WS_PROJ + 4 * PROJ_T;
constexpr size_t WS_XS    = WS_COEF + (size_t)S_ROWS * 128 * 4;
constexpr int QCTR_WORD = 4096;
constexpr int UQ_WORD = 4096 + 64;
constexpr int VQ_WORD = 4096 + 64 * 17;
static_assert((VQ_WORD + 64 * 16) * 4 <= (int)CTL_BYTES, "control words");
static_assert(WS_END <= ((size_t)512 << 20), "workspace");

struct Args {
    const float *x, *meta, *norm_mix, *w_in, *b_forget, *gq, *gk, *g_sb, *g_fox, *w_out, *norm_ffn, *w_query, *sub_keys, *pu, *pv;
    float* out; unsigned char* ws;
    int ph_lo, ph_hi;
    int sub, pad_;
};

__device__ __forceinline__ float bf2f(unsigned short b) { return __uint_as_float((unsigned)b << 16); }
__device__ __forceinline__ float bflo(unsigned w) { return __uint_as_float(w << 16); }
__device__ __forceinline__ float bfhi(unsigned w) { return __uint_as_float(w & 0xffff0000u); }
__device__ __forceinline__ unsigned pk_bf16(float lo, float hi) { return pg8::cvt_pk_bf16(lo, hi); }
__device__ __forceinline__ float wave_sum(float v) {
    v += __uint_as_float((unsigned)__builtin_amdgcn_update_dpp(0, (int)__float_as_uint(v), 0xB1, 0xF, 0xF, true));
    v += __uint_as_float((unsigned)__builtin_amdgcn_update_dpp(0, (int)__float_as_uint(v), 0x4E, 0xF, 0xF, true));
    v += __uint_as_float((unsigned)__builtin_amdgcn_update_dpp(0, (int)__float_as_uint(v), 0x141, 0xF, 0xF, true));
    v += __uint_as_float((unsigned)__builtin_amdgcn_update_dpp(0, (int)__float_as_uint(v), 0x140, 0xF, 0xF, true));
    v += __uint_as_float((unsigned)__builtin_amdgcn_update_dpp(0, (int)__float_as_uint(v), 0x142, 0xA, 0xF, true));
    v += __uint_as_float((unsigned)__builtin_amdgcn_update_dpp(0, (int)__float_as_uint(v), 0x143, 0xC, 0xF, true));
    return __uint_as_float((unsigned)__builtin_amdgcn_readlane((int)__float_as_uint(v), 63));
}
__device__ __forceinline__ float wave_max(float v) {
    v = fmaxf(v, __uint_as_float((unsigned)__builtin_amdgcn_update_dpp((int)__float_as_uint(v), (int)__float_as_uint(v), 0xB1, 0xF, 0xF, false)));
    v = fmaxf(v, __uint_as_float((unsigned)__builtin_amdgcn_update_dpp((int)__float_as_uint(v), (int)__float_as_uint(v), 0x4E, 0xF, 0xF, false)));
    v = fmaxf(v, __uint_as_float((unsigned)__builtin_amdgcn_update_dpp((int)__float_as_uint(v), (int)__float_as_uint(v), 0x141, 0xF, 0xF, false)));
    v = fmaxf(v, __uint_as_float((unsigned)__builtin_amdgcn_update_dpp((int)__float_as_uint(v), (int)__float_as_uint(v), 0x140, 0xF, 0xF, false)));
    v = fmaxf(v, __uint_as_float((unsigned)__builtin_amdgcn_update_dpp((int)__float_as_uint(v), (int)__float_as_uint(v), 0x142, 0xA, 0xF, false)));
    v = fmaxf(v, __uint_as_float((unsigned)__builtin_amdgcn_update_dpp((int)__float_as_uint(v), (int)__float_as_uint(v), 0x143, 0xC, 0xF, false)));
    return __uint_as_float((unsigned)__builtin_amdgcn_readlane((int)__float_as_uint(v), 63));
}
__device__ __forceinline__ int wave_isum(int v) {
    v += __builtin_amdgcn_update_dpp(0, v, 0xB1, 0xF, 0xF, true);
    v += __builtin_amdgcn_update_dpp(0, v, 0x4E, 0xF, 0xF, true);
    v += __builtin_amdgcn_update_dpp(0, v, 0x141, 0xF, 0xF, true);
    v += __builtin_amdgcn_update_dpp(0, v, 0x140, 0xF, 0xF, true);
    v += __builtin_amdgcn_update_dpp(0, v, 0x142, 0xA, 0xF, true);
    v += __builtin_amdgcn_update_dpp(0, v, 0x143, 0xC, 0xF, true);
    return __builtin_amdgcn_readlane(v, 63);
}
__device__ __forceinline__ float xhalf(float v) { const auto rr = __builtin_amdgcn_permlane32_swap(__float_as_uint(v), __float_as_uint(v), false, false); return (threadIdx.x & 32) ? __uint_as_float(rr[0]) : __uint_as_float(rr[1]); }
__device__ __forceinline__ float pair_max(float v) { const auto rr = __builtin_amdgcn_permlane32_swap(__float_as_uint(v), __float_as_uint(v), false, false); return fmaxf(__uint_as_float(rr[0]), __uint_as_float(rr[1])); }
__device__ __forceinline__ float pair_sum(float v) { const auto rr = __builtin_amdgcn_permlane32_swap(__float_as_uint(v), __float_as_uint(v), false, false); return __uint_as_float(rr[0]) + __uint_as_float(rr[1]); }
__device__ __forceinline__ float ex2(float x) { return __builtin_amdgcn_exp2f(x); }
__device__ __forceinline__ float lg2(float x) { return __builtin_amdgcn_logf(x); }

__device__ __forceinline__ void quant_rows(const Args& a, const int row_lo, const int row_hi) {
    const int tid = threadIdx.x, wid = tid >> 6, lane = tid & 63;
    {
        signed char* U8 = (signed char*)(a.ws + WS_U8); unsigned char* V8 = (unsigned char*)(a.ws + WS_V8);
        float* SU = (float*)(a.ws + WS_SU); float* SV = (float*)(a.ws + WS_SV);
        f32x4 qn[8];
        const int rstep = 8, rr0 = row_lo + wid;
        if (rr0 < row_hi) {
            const float* s0 = (rr0 >= 16384 ? a.pv + (size_t)(rr0 - 16384) * DM : a.pu + (size_t)rr0 * DM);
#pragma unroll
            for (int k = 0; k < 8; ++k) qn[k] = *(const f32x4*)(s0 + k * 256 + lane * 4);
        }
        for (int rr = rr0; rr < row_hi; rr += rstep) {
            const bool isv = rr >= 16384; const int e = isv ? rr - 16384 : rr;
            f32x4 v[8]; float am = 0.f;
#pragma unroll
            for (int k = 0; k < 8; ++k) v[k] = qn[k];
            if (rr + rstep < row_hi) {
                const int r1 = rr + rstep;
                const float* s1 = (r1 >= 16384 ? a.pv + (size_t)(r1 - 16384) * DM : a.pu + (size_t)r1 * DM);
#pragma unroll
                for (int k = 0; k < 8; ++k) qn[k] = *(const f32x4*)(s1 + k * 256 + lane * 4);
            }
#pragma unroll
            for (int k = 0; k < 8; ++k) am = fmaxf(fmaxf(am, fmaxf(fabsf(v[k][0]), fabsf(v[k][1]))), fmaxf(fabsf(v[k][2]), fabsf(v[k][3])));
            if (!isv) {
                unsigned char* U4 = (unsigned char*)(a.ws + WS_U8); unsigned char* SUE = (unsigned char*)(a.ws + WS_SU4);
#pragma unroll
                for (int k = 0; k < 8; ++k) {
                    float gm = fmaxf(fmaxf(fabsf(v[k][0]), fabsf(v[k][1])), fmaxf(fabsf(v[k][2]), fabsf(v[k][3])));
                    gm = fmaxf(gm, __shfl_xor(gm, 1)); gm = fmaxf(gm, __shfl_xor(gm, 2)); gm = fmaxf(gm, __shfl_xor(gm, 4));
                    const unsigned gb = __float_as_uint(gm);
                    int sbyte = (int)((gb >> 23) & 255u) - 2 + (((gb & 0x7fffffu) > 0x600000u) ? 1 : 0);
                    sbyte = gm > 0.f ? (sbyte < 1 ? 1 : sbyte) : 127;
                    const float gs = __uint_as_float((unsigned)sbyte << 23);
                    unsigned w = 0u;
                    w = (unsigned)__builtin_amdgcn_cvt_scalef32_pk_fp4_f32(w, v[k][0], v[k][1], gs, 0);
                    w = (unsigned)__builtin_amdgcn_cvt_scalef32_pk_fp4_f32(w, v[k][2], v[k][3], gs, 1);
                    *(unsigned short*)(U4 + (size_t)e * 1024 + 128 * k + 2 * lane) = (unsigned short)w;
                    if ((lane & 7) == 0) SUE[(size_t)e * 64 + ((((2 * k + (lane >> 5)) & 3) * 4 + ((lane >> 3) & 3)) * 4) + (k >> 1)] = (unsigned char)sbyte;
                }
                continue;
            }
            am = wave_max(am);
            float ssq = 0.f;
#pragma unroll
            for (int k = 0; k < 8; ++k) ssq += (v[k][0] * v[k][0] + v[k][1] * v[k][1]) + (v[k][2] * v[k][2] + v[k][3] * v[k][3]);
            ssq = wave_sum(ssq);
            const float sc4 = fminf(am, 2.5f * sqrtf(ssq * (1.0f / DM))) * (1.0f / 7.0f);
            const float inv = sc4 > 0.f ? 1.0f / sc4 : 0.f;
#pragma unroll
            for (int k = 0; k < 8; ++k) {
                unsigned w = 0u;
#pragma unroll
                for (int b = 0; b < 4; ++b) { int q = (int)rintf(v[k][b] * inv); q = q > 7 ? 7 : (q < -7 ? -7 : q); w |= (unsigned)((b & 1) ? (q & 15) : (q + 8)) << (4 * b); }
                *(unsigned short*)((unsigned char*)V8 + ((size_t)k * 16384 + e) * 128 + lane * 2) = (unsigned short)w;
            }
            if (lane == 0) SV[e] = sc4;
        }
    }
}

__device__ __forceinline__ void phase_prep(const Args& a, LAS unsigned char* lds) {
    const int tid = threadIdx.x, wid = tid >> 6, lane = tid & 63;
    LAS float* WF = (LAS float*)lds;
    LAS float* LF = (LAS float*)(lds + 65536);
    LAS float* TT = (LAS float*)(lds + 69632);
    unsigned char* XN8 = (unsigned char*)(a.ws + WS_XN); float* SA = (float*)(a.ws + WS_SA);
    float* LCUM = (float*)(a.ws + WS_LCUM); float* CHT = (float*)(a.ws + WS_CHT);
    for (int i = tid; i < 2048 * 2; i += 512) {
        const int d = i >> 1, part = i & 1;
        const f32x4 v = *(const f32x4*)(a.w_in + (size_t)d * CIN + NPROJ + part * 4);
        *(LAS f32x4*)(WF + ((((d & 3) * 2 + part) * 512) + (d >> 2)) * 4) = v;
    }
    __syncthreads();
    if (a.sub & 1)
    for (int g = blockIdx.x; g < 257; g += gridDim.x) {
        const int nrows = g < 256 ? 64 : NMETA;
        const int rbase = g < 256 ? g * 64 : S_ROWS;
        f32x4 vn[8];
        if (wid < nrows) {
            const float* src0 = g < 256 ? a.x + (size_t)(rbase + wid) * DM : a.meta + (size_t)wid * DM;
#pragma unroll
            for (int c = 0; c < 8; ++c) vn[c] = *(const f32x4*)(src0 + c * 256 + lane * 4);
        }
        for (int r = wid; r < nrows; r += 8) {
            f32x4 v[8]; float ss = 0.f;
#pragma unroll
            for (int c = 0; c < 8; ++c) v[c] = vn[c];
            if (r + 8 < nrows) {
                const float* src1 = g < 256 ? a.x + (size_t)(rbase + r + 8) * DM : a.meta + (size_t)(r + 8) * DM;
#pragma unroll
                for (int c = 0; c < 8; ++c) vn[c] = *(const f32x4*)(src1 + c * 256 + lane * 4);
            }
            float amx = 0.f;
#pragma unroll
            for (int c = 0; c < 8; ++c) {
                const f32x4 gn = *(const f32x4*)(a.norm_mix + c * 256 + lane * 4);
                ss += v[c][0] * v[c][0] + v[c][1] * v[c][1] + v[c][2] * v[c][2] + v[c][3] * v[c][3];
                amx = fmaxf(fmaxf(amx, fmaxf(fabsf(v[c][0] * gn[0]), fabsf(v[c][1] * gn[1]))), fmaxf(fabsf(v[c][2] * gn[2]), fabsf(v[c][3] * gn[3])));
            }
            ss = wave_sum(ss); amx = wave_max(amx);
            const float rstd = rsqrtf(ss * (1.0f / DM) + EPS);
            const float am = amx * rstd * 1.000001f;
            const float qi = am > 0.f ? 127.0f / am : 0.f;
            if (lane == 0) SA[rbase + r] = am * (1.0f / 127.0f);
            float fl[8];
#pragma unroll
            for (int h = 0; h < 8; ++h) fl[h] = 0.f;
#pragma unroll
            for (int c = 0; c < 8; ++c) {
                const f32x4 gn = *(const f32x4*)(a.norm_mix + c * 256 + lane * 4);
                f32x4 y;
#pragma unroll
                for (int e = 0; e < 4; ++e) y[e] = (v[c][e] * rstd) * gn[e];
                unsigned w = 0u;
#pragma unroll
                for (int e = 0; e < 4; ++e) w |= ((unsigned)(int)rintf(y[e] * qi) & 0xffu) << (8 * e);
                *(unsigned*)(XN8 + (size_t)(rbase + r) * DM + c * 256 + lane * 4) = w;
                f32x4 wq[8];
#pragma unroll
                for (int q = 0; q < 8; ++q) wq[q] = *(const LAS f32x4*)(WF + ((q * 512) + c * 64 + lane) * 4);
#pragma unroll
                for (int e = 0; e < 4; ++e) {
                    const f32x4 w0 = wq[2 * e], w1 = wq[2 * e + 1];
                    fl[0] += y[e] * w0[0]; fl[1] += y[e] * w0[1]; fl[2] += y[e] * w0[2]; fl[3] += y[e] * w0[3];
                    fl[4] += y[e] * w1[0]; fl[5] += y[e] * w1[1]; fl[6] += y[e] * w1[2]; fl[7] += y[e] * w1[3];
                }
            }
#pragma unroll
            for (int o = 32; o >= 1; o >>= 1) {
                float t8[8];
#pragma unroll
                for (int h = 0; h < 8; ++h) t8[h] = __shfl_xor(fl[h], o);
#pragma unroll
                for (int h = 0; h < 8; ++h) fl[h] += t8[h];
            }
            float mine = 0.f;
#pragma unroll
            for (int h = 0; h < 8; ++h) mine = (lane == h) ? fl[h] : mine;
            if (lane < 8) { const float z = mine + a.b_forget[lane]; LF[r * 8 + lane] = fminf(z, 0.f) - log1pf(expf(-fabsf(z))); }
        }
        __syncthreads();
        if (tid < 8) {
            float run = 0.f;
            for (int r = 0; r < nrows; ++r) { run += LF[r * 8 + tid]; LCUM[(size_t)(rbase + r) * 8 + tid] = run; }
            CHT[g * 8 + tid] = run;
        }
        __syncthreads();
    }
    if (a.sub & 2) {
        LAS float* CM = (LAS float*)(lds + 69632);
        LAS unsigned char* TB = lds + 69632 + 8192 + 256;
        const int kr = tid >> 3, c4 = tid & 7;
        for (int u = blockIdx.x; u < 224 + 64; u += gridDim.x) {
            const bool isin = u < 224;
            const float* src = isin ? a.w_in : a.w_out; const int ld = isin ? CIN : DM; const int n0 = (isin ? u : u - 224) * 32;
            unsigned char* dst = (unsigned char*)(a.ws + (isin ? WS_WTIN : WS_WTOUT)); float* SB = (float*)(a.ws + (isin ? WS_SBIN : WS_SBOUT));
            f32x4 w[32]; f32x4 m4 = (f32x4){0.f, 0.f, 0.f, 0.f};
            const unsigned loffb = (unsigned)(4 * kr * ld + c4 * 4) * 4u;
#pragma unroll
            for (int q = 0; q < 32; ++q) {
                const float* sq = src + (size_t)((q >> 2) * 256 + (q & 3)) * ld + n0;
                w[q] = *(const f32x4*)((const char*)sq + loffb);
            }
#pragma unroll
            for (int q = 0; q < 32; ++q)
#pragma unroll
                for (int e = 0; e < 4; ++e) m4[e] = fmaxf(m4[e], fabsf(w[q][e]));
            *(LAS f32x4*)(CM + kr * 32 + c4 * 4) = m4;
            __syncthreads();
            if (tid < 32) { float m = 0.f; for (int i = 0; i < 64; ++i) m = fmaxf(m, CM[i * 32 + tid]); CM[2048 + tid] = m; SB[n0 + tid] = m * (1.0f / 127.0f); }
            __syncthreads();
            const f32x4 cm4 = *(const LAS f32x4*)(CM + 2048 + c4 * 4);
            f32x4 qi;
#pragma unroll
            for (int e = 0; e < 4; ++e) qi[e] = cm4[e] > 0.f ? 127.0f / cm4[e] : 0.f;
#pragma unroll
            for (int bb = 0; bb < 8; ++bb) {
#pragma unroll
                for (int e = 0; e < 4; ++e) {
                    unsigned pk = 0u;
#pragma unroll
                    for (int q = 0; q < 4; ++q) pk |= ((unsigned)(int)rintf(w[4 * bb + q][e] * qi[e]) & 0xffu) << (8 * q);
                    *(LAS unsigned*)(TB + (c4 * 4 + e) * 272 + 4 * kr) = pk;
                }
                __syncthreads();
                {
                    const int n = tid >> 4, k16 = (tid & 15) * 16;
                    const u32x4 o = *(const LAS u32x4*)(TB + n * 272 + k16);
                    *(u32x4*)(dst + (size_t)(n0 + n) * DM + bb * 256 + k16) = o;
                }
                __syncthreads();
            }
        }
    }
    if (a.sub & 4) {
        const int r = tid >> 4, c4 = tid & 15;
        f32x4 pv0, pv1;
        bf16_t* dst = (bf16_t*)(a.ws + WS_WTQ);
#define TR_LOAD(t_) do { const int kt_ = (t_) & 31, nt_ = (t_) >> 5; \
            pv0 = *(const f32x4*)(a.w_query + (size_t)(kt_ * 64 + r) * DM + nt_ * 64 + c4 * 4); pv1 = *(const f32x4*)(a.w_query + (size_t)(kt_ * 64 + r + 32) * DM + nt_ * 64 + c4 * 4); } while (0)
        const int NTILE = 1024;
        if ((int)blockIdx.x < NTILE) TR_LOAD((int)blockIdx.x);
        for (int t = blockIdx.x; t < NTILE; t += gridDim.x) {
            const int kt = t & 31, nt = t >> 5;
#pragma unroll
            for (int e = 0; e < 4; ++e) { TT[r * 65 + c4 * 4 + e] = pv0[e]; TT[(r + 32) * 65 + c4 * 4 + e] = pv1[e]; }
            __syncthreads();
            if (t + (int)gridDim.x < NTILE) TR_LOAD(t + (int)gridDim.x);
            {
                const int n = tid >> 3, k8 = (tid & 7) * 8;
                float f[8];
#pragma unroll
                for (int j = 0; j < 8; ++j) f[j] = TT[(k8 + j) * 65 + n];
                u32x4 w; w.x = pk_bf16(f[0], f[1]); w.y = pk_bf16(f[2], f[3]); w.z = pk_bf16(f[4], f[5]); w.w = pk_bf16(f[6], f[7]);
                *(u32x4*)(dst + (size_t)(nt * 64 + n) * DM + kt * 64 + k8) = w;
            }
            __syncthreads();
        }
#undef TR_LOAD
    }
    const int gt = blockIdx.x * 512 + tid, ngt = gridDim.x * 512;
    bf16_t* SUBK = (bf16_t*)(a.ws + WS_SUBK);
    for (int i = gt; i < 16 * 128 * 128 / 4; i += ngt) {
        const f32x4 v = *(const f32x4*)(a.sub_keys + (size_t)i * 4);
        u32x2 pk; pk.x = pk_bf16(v[0], v[1]); pk.y = pk_bf16(v[2], v[3]);
        const int c = (i * 4) & 127, n = ((i * 4) >> 7) & 127, hp = (i * 4) >> 14;
        *(u32x2*)(SUBK + ((size_t)(((hp * 4 + (n >> 5)) * 8 + (c >> 4)) * 64 + (n & 31) + 32 * ((c >> 3) & 1))) * 8 + (c & 7)) = pk;
    }
    bf16_t* MKV = (bf16_t*)(a.ws + WS_METAKV);
    for (int i = gt; i < 4 * 16 * 1024 / 8; i += ngt) {
        const int tsel = i / (16 * 1024 / 8), rem = i % (16 * 1024 / 8);
        *(u32x4*)(MKV + (size_t)tsel * 32 * 1024 + 16 * 1024 + (size_t)rem * 8) = (u32x4){0u, 0u, 0u, 0u};
    }
}

__device__ __forceinline__ void phase_cumf_meta(const Args& a, LAS unsigned char* lds) {
    const int tid = threadIdx.x, wid = tid >> 6, lane = tid & 63;
    const float* LCUM = (const float*)(a.ws + WS_LCUM); const float* CHT = (const float*)(a.ws + WS_CHT);
    float* CK2 = (float*)(a.ws + WS_CK2);
    for (int g = blockIdx.x; g < 256; g += gridDim.x) {
        if (wid == 0) {
            float pre[8];
#pragma unroll
            for (int h = 0; h < 8; ++h) { float p = 0.f; for (int c = lane; c < g; c += 64) p += CHT[c * 8 + h]; pre[h] = wave_sum(p) + CHT[256 * 8 + h]; }
            const int row = g * 64 + lane;
            const f32x4 l0 = *(const f32x4*)(LCUM + (size_t)row * 8), l1 = *(const f32x4*)(LCUM + (size_t)row * 8 + 4);
#pragma unroll
            for (int h = 0; h < 4; ++h) { CK2[(size_t)h * KPAD + row] = (pre[h] + l0[h]) * LOG2E; CK2[(size_t)(h + 4) * KPAD + row] = (pre[h + 4] + l1[h]) * LOG2E; }
        }
    }
    if (blockIdx.x == 0 && wid == 1 && lane < 32) {
#pragma unroll
        for (int h = 0; h < 8; ++h)
            CK2[(size_t)h * KPAD + S_ROWS + lane] = lane < NMETA ? LCUM[(size_t)(S_ROWS + lane) * 8 + h] * LOG2E : 1e30f;
    }
    const unsigned char* XN8 = (const unsigned char*)(a.ws + WS_XN); const unsigned char* WT8 = (const unsigned char*)(a.ws + WS_WTIN);
    const float* SA = (const float*)(a.ws + WS_SA); const float* SBI = (const float*)(a.ws + WS_SBIN);
    bf16_t* MKV = (bf16_t*)(a.ws + WS_METAKV);
    LAS int* PART = (LAS int*)lds;
    for (int cg = blockIdx.x; cg < 256; cg += gridDim.x) {
        const int tsel = cg >> 6, col = (cg & 63) * 16;
        const int nsrc = (tsel == 0 ? 1024 : tsel == 1 ? 2048 : tsel == 2 ? 4096 : 5120) + col;
        const int m = lane & 15, kq = lane >> 4;
        pg8::i32x4 acc = (pg8::i32x4){0, 0, 0, 0};
        const unsigned char* ap = XN8 + (size_t)(S_ROWS + m) * DM + wid * 256 + 16 * kq;
        const unsigned char* bp = WT8 + (size_t)(nsrc + m) * DM + wid * 256 + 16 * kq;
#pragma unroll
        for (int ks = 0; ks < 4; ++ks) {
            const pg8::i32x4 av = *(const pg8::i32x4*)(ap + 64 * ks), bv = *(const pg8::i32x4*)(bp + 64 * ks);
            acc = __builtin_amdgcn_mfma_i32_16x16x64_i8(av, bv, acc, 0, 0, 0);
        }
#pragma unroll
        for (int rg = 0; rg < 4; ++rg) PART[wid * 256 + (4 * kq + rg) * 16 + m] = acc[rg];
        __syncthreads();
        if (tid < 256) {
            int sI = 0;
#pragma unroll
            for (int w = 0; w < 8; ++w) sI += PART[w * 256 + tid];
            const int mm = tid >> 4, nn = tid & 15;
            const float val = (float)sI * SA[S_ROWS + mm] * SBI[nsrc + nn];
            MKV[(size_t)tsel * 32 * 1024 + (size_t)mm * 1024 + col + nn] = (bf16_t)(pk_bf16(val, 0.f) & 0xffffu);
        }
        __syncthreads();
    }
}

__device__ __forceinline__ void phase_ak(const Args& a) {
    const int tid = threadIdx.x, wid = tid >> 6, lane = tid & 63;
    bf16_t* FK = (bf16_t*)(a.ws + WS_PROJ + 4 * PROJ_T); bf16_t* MFK = (bf16_t*)(a.ws + WS_METAKV) + 2 * 32 * 1024;
    const int dcol = (lane & 7) * 16;
    f32x4 gk4[4];
#pragma unroll
    for (int q = 0; q < 4; ++q) gk4[q] = *(const f32x4*)(a.gk + dcol + 4 * q);
    for (int row = blockIdx.x * 8 + wid; row < S_ROWS + NMETA; row += gridDim.x * 8) {
        bf16_t* src = row < S_ROWS ? FK + (size_t)row * WID : MFK + (size_t)(row - S_ROWS) * WID;
        const u32x4 w0 = *(const u32x4*)(src + lane * 16), w1 = *(const u32x4*)(src + lane * 16 + 8);
        float f[16]; float ss = 0.f;
#pragma unroll
        for (int e = 0; e < 4; ++e) { f[2 * e] = bflo(w0[e]); f[2 * e + 1] = bfhi(w0[e]); f[8 + 2 * e] = bflo(w1[e]); f[9 + 2 * e] = bfhi(w1[e]); }
#pragma unroll
        for (int j = 0; j < 16; ++j) ss += f[j] * f[j];
        ss += __shfl_xor(ss, 1); ss += __shfl_xor(ss, 2); ss += __shfl_xor(ss, 4);
        const float rstd = rsqrtf(ss * (1.0f / 128.0f) + EPS);
        u32x4 o0, o1;
#pragma unroll
        for (int e = 0; e < 4; ++e) {
            o0[e] = pk_bf16((f[2 * e] * rstd) * gk4[e >> 1][(2 * e) & 3], (f[2 * e + 1] * rstd) * gk4[e >> 1][(2 * e + 1) & 3]);
            o1[e] = pk_bf16((f[8 + 2 * e] * rstd) * gk4[2 + (e >> 1)][(2 * e) & 3], (f[9 + 2 * e] * rstd) * gk4[2 + (e >> 1)][(2 * e + 1) & 3]);
        }
        *(u32x4*)(src + lane * 16) = o0; *(u32x4*)(src + lane * 16 + 8) = o1;
    }
}

__device__ __forceinline__ unsigned vimg_off(unsigned row, unsigned ch) { return 256u * row + 16u * (ch ^ (((row & 3u) << 2) | ((row >> 2) & 3u))); }
constexpr int AT_TILE = 16384 + 256;
constexpr int AT_STAGE = 2 * AT_TILE;
constexpr int AT_FLAGS = 2 * AT_STAGE;
constexpr int AT_TASK  = AT_FLAGS + 64;
constexpr int AT_RANK  = AT_TASK + 64;

template <bool FOX>
__device__ __forceinline__ void attn_unit(const Args& a, const int head, const int qb, LAS unsigned char* lds, const float zb2) {
    const int tid = threadIdx.x, wid = tid >> 6, lane = tid & 63;
    const int r = lane & 31, hh = lane >> 5;
    const int qt = 8 * qb + wid, q0 = qt * 32;
    const bf16_t* Qt = (const bf16_t*)(a.ws + WS_PROJ + (FOX ? 3 : 0) * PROJ_T);
    const bf16_t* Kt = (const bf16_t*)(a.ws + WS_PROJ + (FOX ? 4 : 1) * PROJ_T) + head * 128;
    const bf16_t* Vt = (const bf16_t*)(a.ws + WS_PROJ + (FOX ? 5 : 2) * PROJ_T) + head * 128;
    const bf16_t* MK = (const bf16_t*)(a.ws + WS_METAKV) + (FOX ? 2 : 0) * 32 * 1024 + head * 128;
    const bf16_t* MV = (const bf16_t*)(a.ws + WS_METAKV) + (FOX ? 3 : 1) * 32 * 1024 + head * 128;
    const float* CK2 = (const float*)(a.ws + WS_CK2) + (size_t)head * KPAD;
    volatile LAS int* flags = (volatile LAS int*)(lds + AT_FLAGS);
    bf16x8 qf[8];
    {
        const bf16_t* qp = Qt + (size_t)(q0 + r) * WID + head * 128 + 8 * hh;
        if (FOX) {
            bf16x8 raw[8]; float ss = 0.f;
#pragma unroll
            for (int k = 0; k < 8; ++k) {
                raw[k] = *(const bf16x8*)(qp + 16 * k);
#pragma unroll
                for (int j = 0; j < 8; ++j) { const float f = bf2f((unsigned short)raw[k][j]); ss += f * f; }
            }
            ss = pair_sum(ss);
            const float rstd = rsqrtf(ss * (1.0f / 128.0f) + EPS);
#pragma unroll
            for (int k = 0; k < 8; ++k) {
                const f32x4 g0 = *(const f32x4*)(a.gq + 16 * k + 8 * hh), g1 = *(const f32x4*)(a.gq + 16 * k + 8 * hh + 4);
                float y[8];
#pragma unroll
                for (int j = 0; j < 4; ++j) { y[j] = ((bf2f((unsigned short)raw[k][j]) * rstd) * g0[j]) * QSCALE2; y[4 + j] = ((bf2f((unsigned short)raw[k][4 + j]) * rstd) * g1[j]) * QSCALE2; }
                u32x4 w; w.x = pk_bf16(y[0], y[1]); w.y = pk_bf16(y[2], y[3]); w.z = pk_bf16(y[4], y[5]); w.w = pk_bf16(y[6], y[7]);
                qf[k] = __builtin_bit_cast(bf16x8, w);
            }
        } else {
#pragma unroll
            for (int k = 0; k < 8; ++k) {
                const bf16x8 raw = *(const bf16x8*)(qp + 16 * k);
                float y[8];
#pragma unroll
                for (int j = 0; j < 8; ++j) y[j] = bf2f((unsigned short)raw[j]) * QSCALE2;
                u32x4 w; w.x = pk_bf16(y[0], y[1]); w.y = pk_bf16(y[2], y[3]); w.z = pk_bf16(y[4], y[5]); w.w = pk_bf16(y[6], y[7]);
                qf[k] = __builtin_bit_cast(bf16x8, w);
            }
        }
    }
    f32x16 o[4];
#pragma unroll
    for (int dt = 0; dt < 4; ++dt)
#pragma unroll
        for (int i = 0; i < 16; ++i) o[dt][i] = 0.f;
    float lsum = 0.f, carry = FOX ? 0.f : 1.0f, mxrun = -1e30f;
    const float cq2 = FOX ? CK2[q0 + r] : 0.f;
    float sh = cq2;
    unsigned kra[8], trb[2], trx[4];
#pragma unroll
    for (int k = 0; k < 8; ++k) kra[k] = vimg_off((unsigned)r, (unsigned)(2 * k + hh));
    {
        const unsigned tq = (lane & 15) >> 2, tp = lane & 3, tblk = (lane >> 4) & 1;
#pragma unroll
        for (int jj = 0; jj < 2; ++jj) trb[jj] = 8192u + 256u * (8u * jj + 4u * hh + tq) + 16u * ((2u * tblk + (tp >> 1)) ^ (hh + 2u * jj)) + 8u * (tp & 1u);
#pragma unroll
        for (int dt = 0; dt < 4; ++dt) trx[dt] = 64u * ((unsigned)dt ^ tq);
    }
    const int lrow = 4 * wid + (lane >> 4);
    const unsigned goff = (unsigned)(lrow * WID + (lane & 15) * 8) * 2u;
    const unsigned soff = vimg_off((unsigned)lrow, (unsigned)(lane & 15));
    const int it_top = 8 * qb + 7;
    u32x4 rk0, rv0, rk1, rv1; float rc0 = 0.f, rc1 = 0.f;
#define AT_LOAD(pp_) do { const int pp__ = (pp_); \
        const bf16_t* kp_ = pp__ >= 0 ? Kt + (size_t)(2 * pp__ + 1) * 32 * WID : MK; const bf16_t* vp_ = pp__ >= 0 ? Vt + (size_t)(2 * pp__ + 1) * 32 * WID : MV; \
        rk0 = *(const u32x4*)((const char*)kp_ + goff); rv0 = *(const u32x4*)((const char*)vp_ + goff); \
        if (pp__ >= 0) { rk1 = *(const u32x4*)((const char*)(Kt + (size_t)(2 * pp__) * 32 * WID) + goff); rv1 = *(const u32x4*)((const char*)(Vt + (size_t)(2 * pp__) * 32 * WID) + goff); } \
        if (FOX && tid < 33) {     \
            const int i0_ = pp__ >= 0 ? (2 * pp__ + 1) * 32 : S_ROWS, i1_ = 2 * pp__ * 32; \
            rc0 = tid < 32 ? CK2[i0_ + tid] : (pp__ >= 0 ? CK2[i0_ - 1] : 0.f); \
            if (pp__ >= 0) rc1 = tid < 32 ? CK2[i1_ + tid] : (pp__ >= 1 ? CK2[i1_ - 1] : CK2[S_ROWS + NMETA - 1]); } } while (0)
#define AT_STORE(st_) do { LAS unsigned char* b_ = lds + (st_) * AT_STAGE + soff; \
        *(LAS u32x4*)b_ = rk0; *(LAS u32x4*)(b_ + 8192) = rv0; *(LAS u32x4*)(b_ + AT_TILE) = rk1; *(LAS u32x4*)(b_ + AT_TILE + 8192) = rv1; \
        if (FOX && tid < 33) { LAS float* c_ = (LAS float*)(lds + (st_) * AT_STAGE + 16384) + tid; c_[0] = rc0; c_[AT_TILE / 4] = rc1; } } while (0)
    if (lane == 0) flags[wid] = 0x7fffffff;
    const int pp_top = (it_top - 1) >> 1;
    rk1 = (u32x4){0u, 0u, 0u, 0u}; rv1 = rk1;
    AT_LOAD(pp_top); AT_STORE(0);
    AT_LOAD(pp_top - 1);
    bool done = false;
    int iter = 0;
    for (int pp = pp_top; pp >= -1; --pp, ++iter) {
        __syncthreads();
        {
            const int f0 = flags[0], f1 = flags[1], f2 = flags[2], f3 = flags[3], f4 = flags[4], f5 = flags[5], f6 = flags[6], f7 = flags[7];
            const int fm = max(max(max(f0, f1), max(f2, f3)), max(max(f4, f5), max(f6, f7)));
            if (fm < iter) break;
        }
        if (pp >= 0) AT_STORE((iter + 1) & 1);
        if (pp >= 1) AT_LOAD(pp - 2);
      if (FOX && !done && pp >= 0 && (2 * pp + 1) < qt) {
          LAS unsigned char* sb0 = lds + (iter & 1) * AT_STAGE; LAS unsigned char* sb1 = sb0 + AT_TILE;
          f32x16 st0, st1;
          {
              bf16x8 kf[8];
#pragma unroll
              for (int k = 0; k < 8; ++k) kf[k] = *(const LAS bf16x8*)(sb0 + kra[k]);
#pragma unroll
              for (int aa = 0; aa < 4; ++aa) { const f32x4 ck4 = *(const LAS f32x4*)(sb0 + 16384 + (8 * aa + 4 * hh) * 4);
#pragma unroll
                  for (int e = 0; e < 4; ++e) st0[4 * aa + e] = sh - ck4[e]; }
#pragma unroll
              for (int k = 0; k < 8; ++k) st0 = __builtin_amdgcn_mfma_f32_32x32x16_bf16(kf[k], qf[k], st0, 0, 0, 0);
          }
          {
              bf16x8 kg[8];
#pragma unroll
              for (int k = 0; k < 8; ++k) kg[k] = *(const LAS bf16x8*)(sb1 + kra[k]);
#pragma unroll
              for (int aa = 0; aa < 4; ++aa) { const f32x4 ck4 = *(const LAS f32x4*)(sb1 + 16384 + (8 * aa + 4 * hh) * 4);
#pragma unroll
                  for (int e = 0; e < 4; ++e) st1[4 * aa + e] = sh - ck4[e]; }
#pragma unroll
              for (int k = 0; k < 8; ++k) st1 = __builtin_amdgcn_mfma_f32_32x32x16_bf16(kg[k], qf[k], st1, 0, 0, 0);
          }
          __builtin_amdgcn_sched_barrier(0);
#pragma unroll
          for (int tl = 0; tl < 2; ++tl) {
              LAS unsigned char* sb = tl ? sb1 : sb0;
              float t[16];
#pragma unroll
              for (int i = 0; i < 16; ++i) t[i] = tl ? st1[i] : st0[i];
              float mx = t[0];
#pragma unroll
              for (int i = 1; i < 16; ++i) mx = fmaxf(mx, t[i]);
              mx = pair_max(mx);
              if (__any(mx > 8.0f)) {
                  const float shift = mx > 8.0f ? mx : 0.f;
                  const float alpha = ex2(-shift);
                  lsum *= alpha; sh -= shift; mxrun -= shift; mx -= shift;
#pragma unroll
                  for (int dt = 0; dt < 4; ++dt)
#pragma unroll
                      for (int i = 0; i < 16; ++i) o[dt][i] *= alpha;
#pragma unroll
                  for (int i = 0; i < 16; ++i) t[i] -= shift;
                  if (tl == 0) {
#pragma unroll
                      for (int i = 0; i < 16; ++i) st1[i] -= shift;
                  }
              }
              mxrun = fmaxf(mxrun, mx);
              float p[16]; float ps = 0.f;
#pragma unroll
              for (int i = 0; i < 16; ++i) { p[i] = ex2(t[i]); ps += p[i]; }
              lsum += ps;
              bf16x8 pb[2];
#pragma unroll
              for (int s2 = 0; s2 < 2; ++s2) {
                  u32x4 w; w.x = pk_bf16(p[8 * s2 + 0], p[8 * s2 + 1]); w.y = pk_bf16(p[8 * s2 + 2], p[8 * s2 + 3]); w.z = pk_bf16(p[8 * s2 + 4], p[8 * s2 + 5]); w.w = pk_bf16(p[8 * s2 + 6], p[8 * s2 + 7]);
                  pb[s2] = __builtin_bit_cast(bf16x8, w);
              }
              s16x4 tv[4][2][2];
#pragma unroll
              for (int dt = 0; dt < 4; ++dt)
#pragma unroll
                  for (int s2 = 0; s2 < 2; ++s2) {
                      tv[dt][s2][0] = __builtin_amdgcn_ds_read_tr16_b64_v4i16((LAS s16x4*)(sb + (trb[0] + trx[dt]) + 4096u * s2));
                      tv[dt][s2][1] = __builtin_amdgcn_ds_read_tr16_b64_v4i16((LAS s16x4*)(sb + (trb[1] + trx[dt]) + 4096u * s2));
                  }
#pragma unroll
              for (int dt = 0; dt < 4; ++dt)
#pragma unroll
                  for (int s2 = 0; s2 < 2; ++s2) {
                      const s16x4 t0 = tv[dt][s2][0], t1 = tv[dt][s2][1];
                      bf16x8 vf; vf[0] = t0[0]; vf[1] = t0[1]; vf[2] = t0[2]; vf[3] = t0[3]; vf[4] = t1[0]; vf[5] = t1[1]; vf[6] = t1[2]; vf[7] = t1[3];
                      o[dt] = __builtin_amdgcn_mfma_f32_32x32x16_bf16(vf, pb[s2], o[dt], 0, 0, 0);
                  }
          }
          {
              const float cnext = *(const LAS float*)(sb1 + 16384 + 128);
              if (__all((zb2 + sh - cnext - mxrun) < PRUNE_LOG2)) { done = true; if (lane == 0) flags[wid] = iter; }
          }
          continue;
      }
      for (int sub = 0; sub < 2; ++sub) {
        const int it = pp >= 0 ? 2 * pp + 1 - sub : -1;
        if (pp < 0 && sub == 1) break;
        const bool meta = it < 0, diag = it == qt;
        if (!done && (meta || it <= qt)) {
            LAS unsigned char* sb = lds + (iter & 1) * AT_STAGE + sub * AT_TILE;
            bf16x8 kf[8];
#pragma unroll
            for (int k = 0; k < 8; ++k) kf[k] = *(const LAS bf16x8*)(sb + kra[k]);
            f32x16 st;
            if (FOX) {
#pragma unroll
                for (int aa = 0; aa < 4; ++aa) {
                    const f32x4 ck4 = *(const LAS f32x4*)(sb + 16384 + (8 * aa + 4 * hh) * 4);
#pragma unroll
                    for (int e = 0; e < 4; ++e) st[4 * aa + e] = sh - ck4[e];
                }
            } else {
#pragma unroll
                for (int i = 0; i < 16; ++i) st[i] = 0.f;
            }
#pragma unroll
            for (int k = 0; k < 8; ++k) st = __builtin_amdgcn_mfma_f32_32x32x16_bf16(kf[k], qf[k], st, 0, 0, 0);
            float p[16];
            if (FOX) {
                float t[16];
#pragma unroll
                for (int i = 0; i < 16; ++i) t[i] = st[i];
                if (diag) {
#pragma unroll
                    for (int i = 0; i < 16; ++i) { const int kl = (i & 3) + 8 * (i >> 2) + 4 * hh; t[i] = kl > r ? -1e30f : t[i]; }
                }
                if (meta) {
#pragma unroll
                    for (int i = 0; i < 16; ++i) { const int kl = (i & 3) + 8 * (i >> 2) + 4 * hh; t[i] = kl >= NMETA ? -1e30f : t[i]; }
                }
                float mx = t[0];
#pragma unroll
                for (int i = 1; i < 16; ++i) mx = fmaxf(mx, t[i]);
                mx = pair_max(mx);
                if (__any(mx > 8.0f)) {
                    const float shift = mx > 8.0f ? mx : 0.f;
                    const float alpha = ex2(-shift);
                    lsum *= alpha; sh -= shift; mxrun -= shift; mx -= shift;
#pragma unroll
                    for (int dt = 0; dt < 4; ++dt)
#pragma unroll
                        for (int i = 0; i < 16; ++i) o[dt][i] *= alpha;
#pragma unroll
                    for (int i = 0; i < 16; ++i) t[i] -= shift;
                }
                mxrun = fmaxf(mxrun, mx);
                float ps = 0.f;
#pragma unroll
                for (int i = 0; i < 16; ++i) { p[i] = ex2(t[i]); ps += p[i]; }
                lsum += ps;
            } else {
                float be[16], om[16];
#pragma unroll
                for (int i = 0; i < 16; ++i) {
                    const float z = st[i];
                    const float u = ex2(-fabsf(z)), inv = __builtin_amdgcn_rcpf(1.0f + u), ui = u * inv;
                    be[i] = z >= 0.f ? inv : ui; om[i] = z >= 0.f ? ui : inv;
                }
                if (diag) {
#pragma unroll
                    for (int i = 0; i < 16; ++i) { const int kl = (i & 3) + 8 * (i >> 2) + 4 * hh; const bool vis = kl < r; be[i] = vis ? be[i] : 0.f; om[i] = vis ? om[i] : 1.0f; }
                }
                if (meta) {
#pragma unroll
                    for (int i = 0; i < 16; ++i) { const int kl = (i & 3) + 8 * (i >> 2) + 4 * hh; const bool vis = kl < NMETA; be[i] = vis ? be[i] : 0.f; om[i] = vis ? om[i] : 1.0f; }
                }
                float g[4], pg[4];
#pragma unroll
                for (int aa = 0; aa < 4; ++aa) g[aa] = (om[4 * aa + 3] * om[4 * aa + 2]) * (om[4 * aa + 1] * om[4 * aa]);
#pragma unroll
                for (int aa = 0; aa < 4; ++aa) pg[aa] = xhalf(g[aa]);
                float run = carry;
#pragma unroll
                for (int aa = 3; aa >= 0; --aa) {
                    const float gh1 = hh ? g[aa] : pg[aa];
                    const float off = hh ? run : run * gh1;
                    const float e3 = off, e2 = off * om[4 * aa + 3], e1 = e2 * om[4 * aa + 2], e0 = e1 * om[4 * aa + 1];
                    p[4 * aa + 3] = be[4 * aa + 3] * e3; p[4 * aa + 2] = be[4 * aa + 2] * e2;
                    p[4 * aa + 1] = be[4 * aa + 1] * e1; p[4 * aa + 0] = be[4 * aa + 0] * e0;
                    run *= g[aa] * pg[aa];
                }
                carry = run;
            }
            bf16x8 pb[2];
#pragma unroll
            for (int s = 0; s < 2; ++s) {
                u32x4 w; w.x = pk_bf16(p[8 * s + 0], p[8 * s + 1]); w.y = pk_bf16(p[8 * s + 2], p[8 * s + 3]); w.z = pk_bf16(p[8 * s + 4], p[8 * s + 5]); w.w = pk_bf16(p[8 * s + 6], p[8 * s + 7]);
                pb[s] = __builtin_bit_cast(bf16x8, w);
            }
            s16x4 tv[4][2][2];
#pragma unroll
            for (int dt = 0; dt < 4; ++dt)
#pragma unroll
                for (int s = 0; s < 2; ++s) {
                    tv[dt][s][0] = __builtin_amdgcn_ds_read_tr16_b64_v4i16((LAS s16x4*)(sb + (trb[0] + trx[dt]) + 4096u * s));
                    tv[dt][s][1] = __builtin_amdgcn_ds_read_tr16_b64_v4i16((LAS s16x4*)(sb + (trb[1] + trx[dt]) + 4096u * s));
                }
#pragma unroll
            for (int dt = 0; dt < 4; ++dt) {
#pragma unroll
                for (int s = 0; s < 2; ++s) {
                    const s16x4 t0 = tv[dt][s][0], t1 = tv[dt][s][1];
                    bf16x8 vf; vf[0] = t0[0]; vf[1] = t0[1]; vf[2] = t0[2]; vf[3] = t0[3]; vf[4] = t1[0]; vf[5] = t1[1]; vf[6] = t1[2]; vf[7] = t1[3];
                    o[dt] = __builtin_amdgcn_mfma_f32_32x32x16_bf16(vf, pb[s], o[dt], 0, 0, 0);
                }
            }
            bool fin = meta;
            if (!meta) {
                if (FOX) {
                    const float cnext = *(const LAS float*)(sb + 16384 + 128);
                    fin = __all((zb2 + sh - cnext - mxrun) < PRUNE_LOG2);
                } else {
                    fin = __all(carry < 5.421010862427522e-20f);
                }
            }
            if (fin) { done = true; if (lane == 0) flags[wid] = iter; }
        }
      }
    }
#undef AT_LOAD
#undef AT_STORE
    if (FOX) {
        lsum = pair_sum(lsum);
        const float inv = 1.0f / lsum;
#pragma unroll
        for (int dt = 0; dt < 4; ++dt)
#pragma unroll
            for (int i = 0; i < 16; ++i) o[dt][i] *= inv;
    }
    float sq = 0.f;
#pragma unroll
    for (int dt = 0; dt < 4; ++dt)
#pragma unroll
        for (int i = 0; i < 16; ++i) sq += o[dt][i] * o[dt][i];
    sq = pair_sum(sq);
    float* SQ = (float*)(a.ws + WS_SQ) + (FOX ? (size_t)S_ROWS * 8 : 0);
    if (hh == 0) SQ[(size_t)(q0 + r) * 8 + head] = sq;
    bf16_t* Ot = (bf16_t*)(a.ws + WS_ATT + (FOX ? PROJ_T : 0)) + (size_t)(q0 + r) * WID + head * 128 + 4 * hh;
#pragma unroll
    for (int dt = 0; dt < 4; ++dt)
#pragma unroll
        for (int aa = 0; aa < 4; ++aa) {
            u32x2 w; w.x = pk_bf16(o[dt][4 * aa], o[dt][4 * aa + 1]); w.y = pk_bf16(o[dt][4 * aa + 2], o[dt][4 * aa + 3]);
            *(u32x2*)(Ot + 32 * dt + 8 * aa) = w;
        }
    __syncthreads();
}

__device__ __forceinline__ void phase_attn(const Args& a, LAS unsigned char* lds) {
    const int tid = threadIdx.x, lane = tid & 63;
    unsigned* qctr = (unsigned*)(a.ws + WS_CTL) + QCTR_WORD;
    volatile LAS int* taskw = (volatile LAS int*)(lds + AT_TASK);
    volatile LAS int* rankw = (volatile LAS int*)(lds + AT_RANK);
    float gmq = wave_max(fmaxf(fabsf(a.gq[lane]), fabsf(a.gq[lane + 64])));
    float gmk = wave_max(fmaxf(fabsf(a.gk[lane]), fabsf(a.gk[lane + 64])));
    const float zb2 = 128.0f * gmq * gmk * QSCALE2 * 1.02f;
    if (tid < 8) {
        const float bh = a.b_forget[tid]; int rank = 0;
#pragma unroll
        for (int j = 0; j < 8; ++j) { const float bj = a.b_forget[j]; rank += (bj > bh || (bj == bh && j < tid)) ? 1 : 0; }
        rankw[rank] = tid;
    }
    for (;;) {
        __syncthreads();
        if (tid == 0) taskw[0] = (int)__hip_atomic_fetch_add(qctr, 1u, __ATOMIC_RELAXED, __HIP_MEMORY_SCOPE_AGENT);
        __syncthreads();
        const int T = taskw[0];
        if (T >= 1024) break;
        if (T < 512) attn_unit<true>(a, rankw[T >> 6], 63 - (T & 63), lds, zb2);
        else { const int U = T - 512; attn_unit<false>(a, U & 7, 63 - (U >> 3), lds, zb2); }
        if ((T & 1) == 0) quant_rows(a, (T >> 1) * 64, (T >> 1) * 64 + 64);
    }
}

__device__ __forceinline__ void phase_merge(const Args& a) {
    const int tid = threadIdx.x, wid = tid >> 6, lane = tid & 63;
    const bf16_t* SBO = (const bf16_t*)(a.ws + WS_ATT); const bf16_t* FOXO = (const bf16_t*)(a.ws + WS_ATT + PROJ_T);
    const bf16_t* FG = (const bf16_t*)(a.ws + WS_PROJ + 6 * PROJ_T);
    const float* SBSQ = (const float*)(a.ws + WS_SQ); const float* FOXSQ = SBSQ + (size_t)S_ROWS * 8;
    unsigned char* MG8 = (unsigned char*)(a.ws + WS_MERGED); float* SM = (float*)(a.ws + WS_SM);
    const bool fox = lane >= 32; const int c0 = (lane & 31) * 32;
    f32x4 gn[8];
#pragma unroll
    for (int q = 0; q < 8; ++q) gn[q] = *(const f32x4*)((fox ? a.g_fox : a.g_sb) + c0 + 4 * q);
    for (int row = blockIdx.x * 8 + wid; row < S_ROWS; row += gridDim.x * 8) {
        const float* sqp = (fox ? FOXSQ : SBSQ) + (size_t)row * 8;
        const f32x4 s0 = *(const f32x4*)sqp, s1 = *(const f32x4*)(sqp + 4);
        const float rstd = rsqrtf(((s0[0] + s0[1]) + (s0[2] + s0[3]) + (s1[0] + s1[1]) + (s1[2] + s1[3])) * (1.0f / WID) + EPS);
        const bf16_t* op = (fox ? FOXO : SBO) + (size_t)row * WID + c0;
        u32x4 ov[4], gv[4];
#pragma unroll
        for (int q = 0; q < 4; ++q) ov[q] = *(const u32x4*)(op + 8 * q);
        if (fox) {
#pragma unroll
            for (int q = 0; q < 4; ++q) gv[q] = *(const u32x4*)(FG + (size_t)row * WID + c0 + 8 * q);
        }
        float y[32]; float am = 0.f;
#pragma unroll
        for (int q = 0; q < 4; ++q)
#pragma unroll
            for (int e = 0; e < 4; ++e) {
                const int j = 8 * q + 2 * e;
                y[j] = (bflo(ov[q][e]) * rstd) * gn[j >> 2][j & 3]; y[j + 1] = (bfhi(ov[q][e]) * rstd) * gn[(j + 1) >> 2][(j + 1) & 3];
                if (fox) { y[j] *= 1.0f / (1.0f + __expf(-bflo(gv[q][e]))); y[j + 1] *= 1.0f / (1.0f + __expf(-bfhi(gv[q][e]))); }
                am = fmaxf(am, fmaxf(fabsf(y[j]), fabsf(y[j + 1])));
            }
        am = wave_max(am);
        const float qi = am > 0.f ? 127.0f / am : 0.f;
        u32x4 o0, o1;
#pragma unroll
        for (int w = 0; w < 4; ++w) {
            unsigned p0 = 0u, p1 = 0u;
#pragma unroll
            for (int b = 0; b < 4; ++b) { p0 |= ((unsigned)(int)rintf(y[4 * w + b] * qi) & 0xffu) << (8 * b); p1 |= ((unsigned)(int)rintf(y[16 + 4 * w + b] * qi) & 0xffu) << (8 * b); }
            o0[w] = p0; o1[w] = p1;
        }
        unsigned char* dp = MG8 + (size_t)row * DM + (fox ? WID : 0) + c0;
        *(u32x4*)dp = o0; *(u32x4*)(dp + 16) = o1;
        if (lane == 0) SM[row] = am * (1.0f / 127.0f);
    }
}

struct EpiInI8 {
    static constexpr bool PERM = true, AFTER_DRAIN = false; typedef pg8::i32x4 AccT;
    bf16_t* O; const float* sa; const float* sb;
    __device__ __forceinline__ void operator()(const pg8::i32x4 (&acc)[2][2][4][2], const pg8::Unit& u, int wr, int wc, int fr, int fq) const {
        const int row0 = u.pm * 256 + wr * 64 + fr; const int ctile = u.pn * 256;
        const int t = ctile >> 10; bf16_t* base = O + (size_t)t * S_ROWS * WID; const int colt = ctile - (t << 10);
        const int col0 = colt + wc * 32 + 8 * fq, gcol0 = ctile + wc * 32 + 8 * fq;
        f32x4 sb0[2], sb1[2];
#pragma unroll
        for (int bj = 0; bj < 2; ++bj) { sb0[bj] = *(const f32x4*)(sb + gcol0 + bj * 128); sb1[bj] = *(const f32x4*)(sb + gcol0 + bj * 128 + 4); }
#pragma unroll
        for (int ai = 0; ai < 2; ++ai)
#pragma unroll
            for (int m = 0; m < 4; ++m) {
                const int row = row0 + ai * 128 + m * 16; const float rs = sa[row];
                bf16_t* rowp = base + (size_t)row * WID + col0;
#pragma unroll
                for (int bj = 0; bj < 2; ++bj) {
                    const pg8::i32x4 v0 = acc[ai][bj][m][0], v1 = acc[ai][bj][m][1];
                    u32x4 w;
                    w.x = pk_bf16((float)v0[0] * rs * sb0[bj][0], (float)v0[1] * rs * sb0[bj][1]); w.y = pk_bf16((float)v0[2] * rs * sb0[bj][2], (float)v0[3] * rs * sb0[bj][3]);
                    w.z = pk_bf16((float)v1[0] * rs * sb1[bj][0], (float)v1[1] * rs * sb1[bj][1]); w.w = pk_bf16((float)v1[2] * rs * sb1[bj][2], (float)v1[3] * rs * sb1[bj][3]);
                    *(u32x4*)(rowp + bj * 128) = w;
                }
            }
    }
};
constexpr int EPI_LDS = pg8::STAGE_BYTES, EPI_WAVE = 16 * 144;
struct EpiOut {
    static constexpr bool PERM = true, AFTER_DRAIN = false; typedef pg8::i32x4 AccT;
    const float* X; bf16_t* H1G; const float* gffn; float* rowsq; const float* sm; const float* sb; LAS unsigned char* eb;
    __device__ __forceinline__ void operator()(const pg8::i32x4 (&acc)[2][2][4][2], const pg8::Unit& u, int wr, int wc, int fr, int fq) const {
        const int lane = threadIdx.x & 63; LAS unsigned char* ws_ = eb + (threadIdx.x >> 6) * EPI_WAVE;
        const int row0 = u.pm * 256 + wr * 64 + fr, col0 = u.pn * 256 + wc * 32 + 8 * fq;
        const float* xq = X + (size_t)(u.pm * 256 + wr * 64 + (lane >> 2)) * DM + u.pn * 256 + wc * 32 + (lane & 3) * 4;
        LAS unsigned char* wp_ = ws_ + (lane >> 2) * 144 + (lane & 3) * 16; const LAS unsigned char* rp_ = ws_ + fr * 144 + fq * 32;
        f32x4 xa[4];
#pragma unroll
        for (int q = 0; q < 4; ++q) xa[q] = *(const f32x4*)(xq + (q >> 1) * 128 + (q & 1) * 16);
#pragma unroll
        for (int ai = 0; ai < 2; ++ai)
#pragma unroll
            for (int m = 0; m < 4; ++m) {
                const int row = row0 + ai * 128 + m * 16; float ss = 0.f; const float rs = sm[row];
                f32x4 xc[4];
#pragma unroll
                for (int q = 0; q < 4; ++q) xc[q] = xa[q];
                if (ai * 4 + m < 7) { const int nx = ai * 4 + m + 1; const float* xn = xq + (size_t)((nx >> 2) * 128 + (nx & 3) * 16) * DM;
#pragma unroll
                    for (int q = 0; q < 4; ++q) xa[q] = *(const f32x4*)(xn + (q >> 1) * 128 + (q & 1) * 16); }
#pragma unroll
                for (int bj = 0; bj < 2; ++bj) {
                    const int c = col0 + bj * 128;
                    *(LAS f32x4*)(wp_) = xc[2 * bj]; *(LAS f32x4*)(wp_ + 64) = xc[2 * bj + 1];
                    const f32x4 x0 = *(const LAS f32x4*)(rp_), x1 = *(const LAS f32x4*)(rp_ + 16);
                    const f32x4 g0 = *(const f32x4*)(gffn + c), g1 = *(const f32x4*)(gffn + c + 4);
                    const f32x4 b0 = *(const f32x4*)(sb + c), b1 = *(const f32x4*)(sb + c + 4);
                    const pg8::i32x4 a0 = acc[ai][bj][m][0], a1 = acc[ai][bj][m][1];
                    f32x4 h0, h1;
#pragma unroll
                    for (int e = 0; e < 4; ++e) { h0[e] = (float)a0[e] * rs * b0[e] + x0[e]; h1[e] = (float)a1[e] * rs * b1[e] + x1[e]; }
                    ss += (h0[0] * h0[0] + h0[1] * h0[1]) + (h0[2] * h0[2] + h0[3] * h0[3]) + (h1[0] * h1[0] + h1[1] * h1[1]) + (h1[2] * h1[2] + h1[3] * h1[3]);
                    u32x4 w; w.x = pk_bf16(h0[0] * g0[0], h0[1] * g0[1]); w.y = pk_bf16(h0[2] * g0[2], h0[3] * g0[3]);
                    w.z = pk_bf16(h1[0] * g1[0], h1[1] * g1[1]); w.w = pk_bf16(h1[2] * g1[2], h1[3] * g1[3]);
                    *(u32x4*)(H1G + (size_t)row * DM + c) = w;
                }
                ss += __shfl_xor(ss, 16); ss += __shfl_xor(ss, 32);
                if (fq == 0) rowsq[(size_t)row * 32 + u.pn * 4 + wc] = ss;
            }
    }
};

__device__ __forceinline__ float row_rstd2(const float* ROWSQ, int row) {
    const float* p = ROWSQ + (size_t)row * 32; float s = 0.f;
#pragma unroll
    for (int j = 0; j < 8; ++j) { const f32x4 v = *(const f32x4*)(p + 4 * j); s += (v[0] + v[1]) + (v[2] + v[3]); }
    return rsqrtf(s * (1.0f / DM) + EPS);
}

__device__ __forceinline__ float gelu1(float v) {
    const float av = fabsf(v), t = __builtin_amdgcn_rcpf(av * 0.2316418882f + 1.0f);
    float q = t * 0.5307027145f + (-0.7265760135f); q = q * t + 0.7107068705f; q = q * t + (-0.142248368f); q = q * t + 0.127414796f; q = q * t;
    const float m = v * (q * __builtin_amdgcn_exp2f((v * v) * (-0.72134752044f)));
    return v < 0.f ? m : v - m;
}
__device__ __forceinline__ float wave_fsum(float v) {
    v += __uint_as_float((unsigned)__builtin_amdgcn_update_dpp(0, (int)__float_as_uint(v), 0xB1, 0xF, 0xF, true));
    v += __uint_as_float((unsigned)__builtin_amdgcn_update_dpp(0, (int)__float_as_uint(v), 0x4E, 0xF, 0xF, true));
    v += __uint_as_float((unsigned)__builtin_amdgcn_update_dpp(0, (int)__float_as_uint(v), 0x141, 0xF, 0xF, true));
    v += __uint_as_float((unsigned)__builtin_amdgcn_update_dpp(0, (int)__float_as_uint(v), 0x140, 0xF, 0xF, true));
    v += __uint_as_float((unsigned)__builtin_amdgcn_update_dpp(0, (int)__float_as_uint(v), 0x142, 0xA, 0xF, true));
    v += __uint_as_float((unsigned)__builtin_amdgcn_update_dpp(0, (int)__float_as_uint(v), 0x143, 0xC, 0xF, true));
    return __uint_as_float((unsigned)__builtin_amdgcn_readlane((int)__float_as_uint(v), 63));
}
constexpr int UP_RSH = 10, UP_NR = 16384 >> UP_RSH;
#ifndef UP_AUX
#define UP_AUX 0
#endif
constexpr int UP_HQW = 8448;
constexpr int L7_IB = 0, L7_EID = 16384, L7_GL = L7_EID + 8192, L7_HQ = L7_GL + 16384, L7_LIST = L7_HQ + 8 * UP_HQW, L7_HIST = L7_LIST + 16384, L7_BASE = L7_HIST + 2048, L7_XS = L7_BASE + 2048, L7_END = L7_XS + 128;
static_assert(L7_END <= LDS_BYTES - 16 && UP_NR <= 64, "phase 7 LDS map");
static_assert(EPI_LDS + 8 * EPI_WAVE <= LDS_BYTES - 16, "epilogue scratch");
typedef int i32x8 __attribute__((ext_vector_type(8)));
#define WFENCE() asm volatile("s_waitcnt lgkmcnt(0)" ::: "memory")
__device__ __forceinline__ int up_tokoff(int t) { return t * 2048 + (t & 1) * 16 + (t >> 1) * 128; }
template <int OPS> __device__ __forceinline__ f32x4 mx_step(const u32x4 av4, const u32x4 b0, const u32x4 b1, const f32x4 c, const unsigned sc) {
    const i32x8 av = {(int)av4[0], (int)av4[1], (int)av4[2], (int)av4[3], 0, 0, 0, 0};
    const i32x8 bv = {(int)b0[0], (int)b0[1], (int)b0[2], (int)b0[3], (int)b1[0], (int)b1[1], (int)b1[2], (int)b1[3]};
    return __builtin_amdgcn_mfma_scale_f32_16x16x128_f8f6f4(av, bv, c, 4, 0, OPS, (int)sc, 0, 0x7f7f7f7f);
}
__device__ __forceinline__ float quad_sum(float v) {
    v += __uint_as_float((unsigned)__builtin_amdgcn_update_dpp(0, (int)__float_as_uint(v), 0xB1, 0xF, 0xF, true));
    v += __uint_as_float((unsigned)__builtin_amdgcn_update_dpp(0, (int)__float_as_uint(v), 0x4E, 0xF, 0xF, true));
    return v;
}
__device__ __forceinline__ void gather_u_tile(const Args& a, LAS unsigned char* lds, const int tok0) {
    const int tid = threadIdx.x, wid = __builtin_amdgcn_readfirstlane(tid >> 6), lane = tid & 63;
    const int li = lane & 15, lb = lane >> 4;
    const bf16_t* H1G = (const bf16_t*)(a.ws + WS_H1G); const float* ROWSQ = (const float*)(a.ws + WS_ROWSQ);
    const unsigned char* U4 = (const unsigned char*)(a.ws + WS_U8); const unsigned char* SUE = (const unsigned char*)(a.ws + WS_SU4);
    const float* SV = (const float*)(a.ws + WS_SV);
    float* COEF = (float*)(a.ws + WS_COEF); float* CSUMP = (float*)(a.ws + WS_XS);
    LAS unsigned char* hqw = lds + L7_HQ + wid * UP_HQW;
    LAS float* glw = (LAS float*)(lds + L7_GL + wid * 2048);
    LAS const unsigned short* eidw = (LAS const unsigned short*)(lds + L7_EID + wid * 1024);
    LAS unsigned* listw = (LAS unsigned*)(lds + L7_LIST + wid * 2048);
    LAS unsigned* histw = (LAS unsigned*)(lds + L7_HIST + wid * 256);
    LAS unsigned* basew = (LAS unsigned*)(lds + L7_BASE + wid * 256);
    LAS float* xsw = (LAS float*)(lds + L7_XS + wid * 16);
    {
        u32x4 hr[4][4];
#pragma unroll
        for (int tl = 0; tl < 4; ++tl)
#pragma unroll
            for (int q = 0; q < 4; ++q) hr[tl][q] = *(const u32x4*)(H1G + (size_t)(tok0 + 4 * wid + tl) * DM + lane * 32 + 8 * q);
#pragma unroll
        for (int tl = 0; tl < 4; ++tl) {
            const int tok = tok0 + 4 * wid + tl;
            float f[32]; float am = 0.f;
#pragma unroll
            for (int q = 0; q < 4; ++q)
#pragma unroll
                for (int e = 0; e < 4; ++e) { f[8 * q + 2 * e] = bflo(hr[tl][q][e]); f[8 * q + 2 * e + 1] = bfhi(hr[tl][q][e]); }
#pragma unroll
            for (int j = 0; j < 32; ++j) am = fmaxf(am, fabsf(f[j]));
            am = wave_max(am);
            const float inv = am > 0.f ? 256.0f / am : 0.f;
            u32x4 h0, h1;
#pragma unroll
            for (int w = 0; w < 8; ++w) {
                int pk = 0;
                pk = __builtin_amdgcn_cvt_pk_fp8_f32(f[4 * w] * inv, f[4 * w + 1] * inv, pk, false);
                pk = __builtin_amdgcn_cvt_pk_fp8_f32(f[4 * w + 2] * inv, f[4 * w + 3] * inv, pk, true);
                if (w < 4) h0[w] = (unsigned)pk; else h1[w - 4] = (unsigned)pk;
            }
            *(LAS u32x4*)(hqw + up_tokoff(tl) + lane * 32) = h0; *(LAS u32x4*)(hqw + up_tokoff(tl) + lane * 32 + 16) = h1;
            const float xs = row_rstd2(ROWSQ, tok) * (am * (1.0f / 256.0f));
            if (lane == 0) xsw[tl] = xs;
        }
    }
    if (lane < UP_NR) histw[lane] = 0u;
    WFENCE();
    {
        const int tl_l = lane >> 4, s0 = 8 * (lane & 15);
        const u32x4 ev = *(LAS const u32x4*)(eidw + tl_l * 128 + s0);
        unsigned it[8], pos[8];
#pragma unroll
        for (int i = 0; i < 8; ++i) {
            const unsigned e = (ev[i >> 1] >> (16 * (i & 1))) & 0xffffu;
            it[i] = e | ((unsigned)tl_l << 14) | ((unsigned)(s0 + i) << 16);
            pos[i] = __hip_atomic_fetch_add(histw + (e >> UP_RSH), 1u, __ATOMIC_RELAXED, __HIP_MEMORY_SCOPE_WORKGROUP);
        }
        WFENCE();
        const unsigned c = lane < UP_NR ? histw[lane] : 0u; unsigned inc = c;
#pragma unroll
        for (int d = 1; d < UP_NR; d <<= 1) { const unsigned t = (unsigned)__shfl_up((int)inc, d); inc += (lane >= d) ? t : 0u; }
        if (lane < UP_NR) basew[lane] = inc - c;
        WFENCE();
#pragma unroll
        for (int i = 0; i < 8; ++i) listw[basew[(it[i] & 0x3fffu) >> UP_RSH] + pos[i]] = it[i];
        WFENCE();
    }
    {
        LAS const unsigned char* hb = hqw + up_tokoff(li >> 2) + (lb >> 1) * 128 + (li & 3) * 32 + (lb & 1) * 16;
        LAS float* zbuf = (LAS float*)basew;
        LAS float* dummyw = (LAS float*)histw + lane;
        const int emask = (a.sub & 512) ? 1023 : 0x3fff;
        const unsigned rowoff = (unsigned)lb * 64u + (unsigned)(li & 3) * 16u;
        const unsigned scoff = ((unsigned)lb * 4u + (unsigned)(li & 3)) * 4u;
        const int gq = li >> 2;
        const bool wlane = (lane & 3) == 0; const int rtok = (lane >> 2) & 3;
        const __amdgpu_buffer_rsrc_t urs = __builtin_amdgcn_make_buffer_rsrc((void*)U4, 0, 16384 * 1024, 0x00020000);
        u32x4 aA[16], aB[16]; unsigned scA[4], scB[4];
#define PU_LOAD(AA, SC, t_) do { \
            _Pragma("unroll") for (int T = 0; T < 4; ++T) { const int e_ = (int)(listw[16 * (t_) + 4 * T + gq] & 0x3fffu) & emask; \
                const unsigned ro_ = (unsigned)e_ * 1024u + rowoff; \
                SC[T] = *(const unsigned*)(SUE + (size_t)e_ * 64 + scoff); \
                _Pragma("unroll") for (int m = 0; m < 4; ++m) AA[4 * T + m] = __builtin_amdgcn_raw_buffer_load_b128(urs, ro_ + m * 256, 0, UP_AUX); } } while (0)
#define PU_STEP(m_, bx0, bx1, nx0, nx1, AA, SC) do { \
            nx0 = *(LAS const u32x4*)(hb + (((m_) + 1) & 3) * 512); nx1 = *(LAS const u32x4*)(hb + (((m_) + 1) & 3) * 512 + 256); \
            c0 = mx_step<m_>(AA[(m_)], bx0, bx1, c0, SC[0]); c1 = mx_step<m_>(AA[4 + (m_)], bx0, bx1, c1, SC[1]); \
            c2 = mx_step<m_>(AA[8 + (m_)], bx0, bx1, c2, SC[2]); c3 = mx_step<m_>(AA[12 + (m_)], bx0, bx1, c3, SC[3]); } while (0)
#define PU_COMPUTE(AA, SC, t_) do { \
            f32x4 c0 = {0.f, 0.f, 0.f, 0.f}, c1 = c0, c2 = c0, c3 = c0; \
            u32x4 p0 = *(LAS const u32x4*)(hb), p1 = *(LAS const u32x4*)(hb + 256), q0, q1; \
            PU_STEP(0, p0, p1, q0, q1, AA, SC); PU_STEP(1, q0, q1, p0, p1, AA, SC); PU_STEP(2, p0, p1, q0, q1, AA, SC); PU_STEP(3, q0, q1, p0, p1, AA, SC); \
            const unsigned wq_ = listw[16 * (t_) + lb], wq1_ = listw[16 * (t_) + 4 + lb], wq2_ = listw[16 * (t_) + 8 + lb], wq3_ = listw[16 * (t_) + 12 + lb];     \
            const unsigned wi_ = listw[16 * (t_) + li]; \
            _Pragma("unroll") for (int T = 0; T < 4; ++T) { \
                const f32x4 cc = T == 0 ? c0 : T == 1 ? c1 : T == 2 ? c2 : c3; const unsigned w_ = T == 0 ? wq_ : T == 1 ? wq1_ : T == 2 ? wq2_ : wq3_; \
                const float d_ = (lane & 2) ? ((lane & 1) ? cc[3] : cc[2]) : ((lane & 1) ? cc[1] : cc[0]);                   \
                const float x_ = quad_sum(d_); \
                LAS float* dst_ = (wlane && rtok == (int)((w_ >> 14) & 3u)) ? (zbuf + 4 * T + lb) : dummyw; \
                *dst_ = x_; } \
            { const int tl_ = (int)(wi_ >> 14) & 3, sl_ = (int)(wi_ >> 16) & 127; \
              const float cf = glw[tl_ * 128 + sl_] * gelu1(xsw[tl_] * zbuf[li]); \
              glw[tl_ * 128 + sl_] = cf; } } while (0)
        PU_LOAD(aA, scA, 0);
        __builtin_amdgcn_sched_barrier(0);
#pragma unroll 1
        for (int t = 0; t < 30; t += 2) {
            PU_LOAD(aB, scB, t + 1);
            __builtin_amdgcn_sched_barrier(0);
            PU_COMPUTE(aA, scA, t);
            __builtin_amdgcn_sched_barrier(0);
            PU_LOAD(aA, scA, t + 2);
            __builtin_amdgcn_sched_barrier(0);
            PU_COMPUTE(aB, scB, t + 1);
            __builtin_amdgcn_sched_barrier(0);
        }
        PU_LOAD(aB, scB, 31);
        __builtin_amdgcn_sched_barrier(0);
        PU_COMPUTE(aA, scA, 30);
        __builtin_amdgcn_sched_barrier(0);
        PU_COMPUTE(aB, scB, 31);
#undef PU_LOAD
#undef PU_COMPUTE
#undef PU_STEP
    }
    WFENCE();
    {
        float sv0[4], sv1[4];
#pragma unroll
        for (int tl = 0; tl < 4; ++tl) { sv0[tl] = SV[eidw[tl * 128 + lane]]; sv1[tl] = SV[eidw[tl * 128 + 64 + lane]]; }
#pragma unroll
        for (int tl = 0; tl < 4; ++tl) {
            const int tok = tok0 + 4 * wid + tl;
            const float cv0 = glw[tl * 128 + lane] * sv0[tl], cv1 = glw[tl * 128 + 64 + lane] * sv1[tl];
            const float cm = wave_max(fmaxf(fabsf(cv0), fabsf(cv1)));
            const float inv = cm > 0.f ? 127.0f / cm : 0.f;
            signed char* cq = (signed char*)COEF + (size_t)tok * 128;
            if (a.sub & 256) continue;
            const int q0 = (int)rintf(cv0 * inv), q1 = (int)rintf(cv1 * inv);
            cq[lane] = (signed char)q0; cq[64 + lane] = (signed char)q1;
            const int qs = wave_isum(q0 + q1);
            if (lane == 0) { CSUMP[2 * tok] = cm * (1.0f / 127.0f); CSUMP[2 * tok + 1] = (float)(8 * qs); }
        }
    }
}

__device__ __forceinline__ unsigned fkey(float s) { const unsigned u = __float_as_uint(s); return u ^ ((unsigned)((int)u >> 31) | 0x80000000u); }
__device__ __forceinline__ float fval(unsigned k) { const unsigned u = (k & 0x80000000u) ? (k & 0x7fffffffu) : ~k; return __uint_as_float(u); }
#define CE(x_, y_) do { const unsigned hi_ = (x_) > (y_) ? (x_) : (y_); const unsigned lo_ = (x_) > (y_) ? (y_) : (x_); (x_) = hi_; (y_) = lo_; } while (0)
#define S16_NET(v) do { CE(v[0], v[1]); CE(v[2], v[3]); CE(v[0], v[2]); CE(v[1], v[3]); CE(v[1], v[2]); CE(v[4], v[5]); CE(v[6], v[7]); CE(v[4], v[6]); CE(v[5], v[7]); CE(v[5], v[6]); CE(v[0], v[4]); CE(v[2], v[6]); CE(v[2], v[4]); CE(v[1], v[5]); CE(v[3], v[7]); CE(v[3], v[5]); CE(v[1], v[2]); CE(v[3], v[4]); CE(v[5], v[6]); CE(v[8], v[9]); CE(v[10], v[11]); CE(v[8], v[10]); CE(v[9], v[11]); CE(v[9], v[10]); CE(v[12], v[13]); CE(v[14], v[15]); CE(v[12], v[14]); CE(v[13], v[15]); CE(v[13], v[14]); CE(v[8], v[12]); CE(v[10], v[14]); CE(v[10], v[12]); CE(v[9], v[13]); CE(v[11], v[15]); CE(v[11], v[13]); CE(v[9], v[10]); CE(v[11], v[12]); CE(v[13], v[14]); CE(v[0], v[8]); CE(v[4], v[12]); CE(v[4], v[8]); CE(v[2], v[10]); CE(v[6], v[14]); CE(v[6], v[10]); CE(v[2], v[4]); CE(v[6], v[8]); CE(v[10], v[12]); CE(v[1], v[9]); CE(v[5], v[13]); CE(v[5], v[9]); CE(v[3], v[11]); CE(v[7], v[15]); CE(v[7], v[11]); CE(v[3], v[5]); CE(v[7], v[9]); CE(v[11], v[13]); CE(v[1], v[2]); CE(v[3], v[4]); CE(v[5], v[6]); CE(v[7], v[8]); CE(v[9], v[10]); CE(v[11], v[12]); CE(v[13], v[14]); } while (0)

__device__ __forceinline__ void sort16(unsigned (&v)[16]) { S16_NET(v); }
__device__ __forceinline__ void bitonic16(unsigned (&v)[16]) {
#pragma unroll
    for (int k = 8; k >= 1; k >>= 1)
#pragma unroll
        for (int i = 0; i < 16; ++i) if ((i & k) == 0) CE(v[i], v[i + k]);
}
__device__ __forceinline__ void merge_top16(unsigned (&m)[16], const unsigned (&b)[16]) {
#pragma unroll
    for (int i = 0; i < 16; ++i) m[i] = m[i] > b[15 - i] ? m[i] : b[15 - i];
    bitonic16(m);
}
__device__ __forceinline__ void insert16(unsigned (&L)[16], unsigned x) {
#pragma unroll
    for (int j = 0; j < 16; ++j) { const unsigned hi = L[j] > x ? L[j] : x; x = L[j] > x ? x : L[j]; L[j] = hi; }
}

__device__ __forceinline__ void phase_topk(const Args& a, LAS unsigned char* lds) {
    const int tid = threadIdx.x, wid = tid >> 6, lane = tid & 63, r = lane & 31, hh = lane >> 5;
    const bf16_t* PQ = (const bf16_t*)(a.ws + WS_PQ); const bf16_t* SUBK = (const bf16_t*)(a.ws + WS_SUBK);
    const float* ROWSQ = (const float*)(a.ws + WS_ROWSQ);
    int* IDX = (int*)(a.ws + WS_IDX);
    LAS unsigned* ib = (LAS unsigned*)(lds + wid * 2048 + lane * 32);
    for (int task = blockIdx.x * 8 + wid; task < 512 * 8; task += gridDim.x * 8) {
        const int tt = task >> 3, hd = task & 7, token = tt * 32 + r;
        unsigned LA[16], LB[16];
#pragma unroll
        for (int j = 0; j < 16; ++j) { LA[j] = 0u; LB[j] = 0u; }
#pragma unroll 1
        for (int p = 0; p < 2; ++p) {
            bf16x8 bq[8];
            const bf16_t* qp = PQ + (size_t)token * DM + hd * 256 + p * 128 + 8 * hh;
#pragma unroll
            for (int k = 0; k < 8; ++k) bq[k] = *(const bf16x8*)(qp + 16 * k);
            unsigned M[16];
#pragma unroll
            for (int j = 0; j < 16; ++j) M[j] = 0u;
#pragma unroll 1
            for (int mt = 0; mt < 4; ++mt) {
                f32x16 acc;
#pragma unroll
                for (int i = 0; i < 16; ++i) acc[i] = 0.f;
                const bf16_t* sp = SUBK + ((size_t)((hd * 2 + p) * 4 + mt) * 8 * 64 + lane) * 8;
#pragma unroll
                for (int k = 0; k < 8; ++k) { const bf16x8 ak = *(const bf16x8*)(sp + 512 * k); acc = __builtin_amdgcn_mfma_f32_32x32x16_bf16(ak, bq[k], acc, 0, 0, 0); }
                unsigned K16[16];
#pragma unroll
                for (int i = 0; i < 16; ++i) { const unsigned n = 32u * mt + (i & 3) + 8u * (i >> 2) + 4u * hh; K16[i] = (fkey(acc[i]) & ~127u) | n; }
                sort16(K16);
                merge_top16(M, K16);
            }
            unsigned P[16];
#pragma unroll
            for (int j = 0; j < 16; ++j) { const auto rr = __builtin_amdgcn_permlane32_swap(M[j], M[j], false, false); P[j] = hh ? rr[0] : rr[1]; }
            merge_top16(M, P);
#pragma unroll
            for (int j = 0; j < 16; ++j) { if (p == 0) LA[j] = M[j]; else LB[j] = M[j]; }
        }
#pragma unroll
        for (int w = 0; w < 4; ++w) {
            ib[w] = (LA[4 * w] & 127u) | ((LA[4 * w + 1] & 127u) << 8) | ((LA[4 * w + 2] & 127u) << 16) | ((LA[4 * w + 3] & 127u) << 24);
            ib[4 + w] = (LB[4 * w] & 127u) | ((LB[4 * w + 1] & 127u) << 8) | ((LB[4 * w + 2] & 127u) << 16) | ((LB[4 * w + 3] & 127u) << 24);
        }
        float va[16], vb[16];
#pragma unroll
        for (int j = 0; j < 16; ++j) { va[j] = fval(LA[j] & ~127u); vb[j] = fval(LB[j] & ~127u); }
#define CKEY(i_, j_) ((fkey(va[i_] + vb[j_]) & ~255u) | (unsigned)(255 - (16 * (i_) + (j_))))
        unsigned T[16], S1[16], S2[16];
#pragma unroll
        for (int j = 0; j < 16; ++j) T[j] = CKEY(0, j);
#pragma unroll
        for (int j = 0; j < 8; ++j) { S1[j] = CKEY(1, j); S1[15 - j] = CKEY(8 + j, 0); }
        bitonic16(S1);
        merge_top16(T, S1);
        S2[0] = CKEY(2, 0); S2[1] = CKEY(2, 1); S2[2] = CKEY(2, 2); S2[3] = CKEY(2, 3); S2[4] = CKEY(2, 4);
        S2[5] = CKEY(3, 0); S2[6] = CKEY(3, 1); S2[7] = CKEY(3, 2); S2[8] = CKEY(3, 3);
        S2[9] = CKEY(4, 0); S2[10] = CKEY(4, 1); S2[11] = CKEY(4, 2);
        S2[12] = CKEY(5, 0); S2[13] = CKEY(5, 1); S2[14] = CKEY(6, 0); S2[15] = CKEY(6, 1);
        sort16(S2);
        merge_top16(T, S2);
        insert16(T, CKEY(7, 0)); insert16(T, CKEY(7, 1));
#undef CKEY
        const float rstd = row_rstd2(ROWSQ, token);
        const float s0 = fval(T[0] & ~255u);
        float ex[16], den = 0.f; int eid[16];
        const LAS unsigned char* ibb = (const LAS unsigned char*)ib;
#pragma unroll
        for (int k = 0; k < 16; ++k) {
            const unsigned cid = 255u - (T[k] & 255u);
            const unsigned ia = ibb[cid >> 4], ibv = ibb[16 + (cid & 15u)];
            eid[k] = (int)(ia * 128u + ibv);
            ex[k] = __expf((fval(T[k] & ~255u) - s0) * rstd); den += ex[k];
        }
        const float inv = 1.0f / den;
        if (hh == 0) {
#pragma unroll
            for (int k = 0; k < 16; k += 4) { int4 v; v.x = eid[k]; v.y = eid[k + 1]; v.z = eid[k + 2]; v.w = eid[k + 3]; *(int4*)(IDX + (size_t)token * 128 + hd * 16 + k) = v; }
#pragma unroll
            for (int k = 0; k < 16; k += 8) { u32x4 v; v.x = (unsigned)eid[k] | ((unsigned)eid[k + 1] << 16); v.y = (unsigned)eid[k + 2] | ((unsigned)eid[k + 3] << 16);
                v.z = (unsigned)eid[k + 4] | ((unsigned)eid[k + 5] << 16); v.w = (unsigned)eid[k + 6] | ((unsigned)eid[k + 7] << 16);
                *(LAS u32x4*)(lds + L7_EID + (r * 128 + hd * 16 + k) * 2) = v; }
        } else {
#pragma unroll
            for (int k = 0; k < 16; k += 4) { f32x4 v; v[0] = ex[k] * inv; v[1] = ex[k + 1] * inv; v[2] = ex[k + 2] * inv; v[3] = ex[k + 3] * inv; *(LAS f32x4*)(lds + L7_GL + (r * 128 + hd * 16 + k) * 4) = v; }
        }
        asm volatile("s_waitcnt vmcnt(0) lgkmcnt(0)" ::: "memory");
        __syncthreads();
        if (!(a.sub & 1024)) gather_u_tile(a, lds, tt * 32);
        __syncthreads();
    }
}
#undef CE

constexpr int GCHUNK = 32;
__device__ __forceinline__ int swap32_isum(int x, int y) { const auto rr = __builtin_amdgcn_permlane32_swap((unsigned)x, (unsigned)y, false, false); return (int)rr[0] + (int)rr[1]; }
__device__ __forceinline__ int swap16_isum(int x, int y) { const auto rr = __builtin_amdgcn_permlane16_swap((unsigned)x, (unsigned)y, false, false); return (int)rr[0] + (int)rr[1]; }
__device__ __forceinline__ int ror8_isum(int x) { return x + __builtin_amdgcn_update_dpp(0, x, 0x128, 0xF, 0xF, true); }
__device__ __forceinline__ void phase_gather_v(const Args& a) {
    const int lane = threadIdx.x & 63;
    const int* IDX = (const int*)(a.ws + WS_IDX); const unsigned char* COEFQ = (const unsigned char*)(a.ws + WS_COEF); const float* CSC = (const float*)(a.ws + WS_XS);
    const unsigned char* V4 = (const unsigned char*)(a.ws + WS_V8); const bf16_t* H1G = (const bf16_t*)(a.ws + WS_H1G);
    unsigned* vq = (unsigned*)(a.ws + WS_CTL) + VQ_WORD;
    const unsigned xcc = xb_xcc_id() & 7u;
    const int grp = lane >> 3;
    const unsigned poff = (unsigned)(lane & 7) * 16u;
    const int ocol = 32 * (lane & 7) + 16 * (lane >> 5) + 8 * ((lane >> 4) & 1);
    const bool writer = (lane & 8) == 0;
    for (int j = 0; j < 8; ++j) {
        const int sl = (int)((xcc + (unsigned)j) & 7u);
        const unsigned char* Vs = V4 + (size_t)sl * 16384 * 128;
        f32x4 gi0, gi1; { const f32x4 g0 = *(const f32x4*)(a.norm_ffn + sl * 256 + ocol), g1 = *(const f32x4*)(a.norm_ffn + sl * 256 + ocol + 4);
#pragma unroll
            for (int e = 0; e < 4; ++e) { gi0[e] = 1.0f / g0[e]; gi1[e] = 1.0f / g1[e]; } }
        for (;;) {
            unsigned ch = 0;
            if (lane == 0) ch = __hip_atomic_fetch_add(vq + 64 * sl, 1u, __ATOMIC_RELAXED, __HIP_MEMORY_SCOPE_AGENT);
            ch = __builtin_amdgcn_readfirstlane(ch);
            if (ch >= (unsigned)(S_ROWS / GCHUNK)) break;
            const int t0 = (int)ch * GCHUNK;
            int4 inx[4]; u32x4 cA, cB; u32x4 vA[16], vB[16]; u32x4 hA, hB; pg8::f32x2 scA, scB;
#define PV_IDX(tok_) do { const int* ip_ = IDX + (size_t)(tok_) * 128 + 16 * grp; _Pragma("unroll") for (int w = 0; w < 4; ++w) inx[w] = *(const int4*)(ip_ + 4 * w); } while (0)
#define PV_ISSUE(VV, CC, HH, SCC, tok_) do { \
                HH = *(const u32x4*)(H1G + (size_t)(tok_) * DM + sl * 256 + ocol); SCC = *(const pg8::f32x2*)(CSC + 2 * (size_t)(tok_)); \
                _Pragma("unroll") for (int w = 0; w < 4; ++w) { \
                    VV[4 * w + 0] = *(const u32x4*)(Vs + (size_t)inx[w].x * 128 + poff); VV[4 * w + 1] = *(const u32x4*)(Vs + (size_t)inx[w].y * 128 + poff); \
                    VV[4 * w + 2] = *(const u32x4*)(Vs + (size_t)inx[w].z * 128 + poff); VV[4 * w + 3] = *(const u32x4*)(Vs + (size_t)inx[w].w * 128 + poff); } \
                CC = *(const u32x4*)(COEFQ + (size_t)(tok_) * 128 + 16 * grp); } while (0)
#define PV_CONSUME(VV, CC, HH, SCC, tok_) do { \
                int acc[32]; _Pragma("unroll") for (int q = 0; q < 32; ++q) acc[q] = 0; \
                float* op_ = a.out + (size_t)(tok_) * DM + sl * 256 + ocol; \
                _Pragma("unroll") for (int gq = 0; gq < 4; ++gq) { const int cp_ = (int)CC[gq]; \
                    _Pragma("unroll") for (int w = 0; w < 4; ++w) { \
                        const unsigned x0 = VV[4 * gq + 0][w], x1 = VV[4 * gq + 1][w], x2 = VV[4 * gq + 2][w], x3 = VV[4 * gq + 3][w]; \
                        const unsigned l01 = __builtin_amdgcn_perm(x1, x0, 0x05010400u), h01 = __builtin_amdgcn_perm(x1, x0, 0x07030602u); \
                        const unsigned l23 = __builtin_amdgcn_perm(x3, x2, 0x05010400u), h23 = __builtin_amdgcn_perm(x3, x2, 0x07030602u); \
                        const unsigned t0_ = __builtin_amdgcn_perm(l23, l01, 0x05040100u), t1_ = __builtin_amdgcn_perm(l23, l01, 0x07060302u); \
                        const unsigned t2_ = __builtin_amdgcn_perm(h23, h01, 0x05040100u), t3_ = __builtin_amdgcn_perm(h23, h01, 0x07060302u); \
                        acc[8 * w + 0] = __builtin_amdgcn_sdot4((int)(t0_ & 0x0f0f0f0fu), cp_, acc[8 * w + 0], false); acc[8 * w + 1] = __builtin_amdgcn_sdot4((int)t0_, cp_, acc[8 * w + 1], false); \
                        acc[8 * w + 2] = __builtin_amdgcn_sdot4((int)(t1_ & 0x0f0f0f0fu), cp_, acc[8 * w + 2], false); acc[8 * w + 3] = __builtin_amdgcn_sdot4((int)t1_, cp_, acc[8 * w + 3], false); \
                        acc[8 * w + 4] = __builtin_amdgcn_sdot4((int)(t2_ & 0x0f0f0f0fu), cp_, acc[8 * w + 4], false); acc[8 * w + 5] = __builtin_amdgcn_sdot4((int)t2_, cp_, acc[8 * w + 5], false); \
                        acc[8 * w + 6] = __builtin_amdgcn_sdot4((int)(t3_ & 0x0f0f0f0fu), cp_, acc[8 * w + 6], false); acc[8 * w + 7] = __builtin_amdgcn_sdot4((int)t3_, cp_, acc[8 * w + 7], false); } } \
                int z16[16]; _Pragma("unroll") for (int q = 0; q < 16; ++q) z16[q] = swap32_isum(acc[q], acc[16 + q]);        \
                int z8[8]; _Pragma("unroll") for (int q = 0; q < 8; ++q) z8[q] = ror8_isum(swap16_isum(z16[q], z16[8 + q]));     \
                if (writer) { const float sc_ = SCC.x, cs_ = SCC.y; f32x4 o0, o1;     \
                    o0[0] = bflo(HH.x) * gi0[0] + ((float)z8[0] - cs_) * sc_; o0[1] = bfhi(HH.x) * gi0[1] + (float)((z8[1] - z8[0]) >> 4) * sc_; \
                    o0[2] = bflo(HH.y) * gi0[2] + ((float)z8[2] - cs_) * sc_; o0[3] = bfhi(HH.y) * gi0[3] + (float)((z8[3] - z8[2]) >> 4) * sc_; \
                    o1[0] = bflo(HH.z) * gi1[0] + ((float)z8[4] - cs_) * sc_; o1[1] = bfhi(HH.z) * gi1[1] + (float)((z8[5] - z8[4]) >> 4) * sc_; \
                    o1[2] = bflo(HH.w) * gi1[2] + ((float)z8[6] - cs_) * sc_; o1[3] = bfhi(HH.w) * gi1[3] + (float)((z8[7] - z8[6]) >> 4) * sc_; \
                    *(f32x4*)op_ = o0; *(f32x4*)(op_ + 4) = o1; } } while (0)
            int4 inxB[4];
#define PV_IDXB(tok_) do { const int* ip_ = IDX + (size_t)(tok_) * 128 + 16 * grp; _Pragma("unroll") for (int w = 0; w < 4; ++w) inxB[w] = *(const int4*)(ip_ + 4 * w); } while (0)
#define PV_SWAPIDX() do { _Pragma("unroll") for (int w = 0; w < 4; ++w) { const int4 t_ = inx[w]; inx[w] = inxB[w]; inxB[w] = t_; } } while (0)
#define SB() __builtin_amdgcn_sched_barrier(0)
            PV_IDX(t0); PV_IDXB(t0 + 1); SB();
            PV_ISSUE(vA, cA, hA, scA, t0); SB();
            for (int t = 0; t < GCHUNK - 2; t += 2) {
                PV_IDX(t0 + t + 2);
                SB();
                PV_SWAPIDX();
                PV_ISSUE(vB, cB, hB, scB, t0 + t + 1);
                SB();
                PV_CONSUME(vA, cA, hA, scA, t0 + t);
                SB();
                PV_SWAPIDX();
                PV_IDXB(t0 + t + 3);
                SB();
                PV_ISSUE(vA, cA, hA, scA, t0 + t + 2);
                SB();
                PV_CONSUME(vB, cB, hB, scB, t0 + t + 1);
                SB();
            }
            PV_SWAPIDX();
            PV_ISSUE(vB, cB, hB, scB, t0 + GCHUNK - 1);
            SB();
            PV_CONSUME(vA, cA, hA, scA, t0 + GCHUNK - 2);
            SB();
            PV_CONSUME(vB, cB, hB, scB, t0 + GCHUNK - 1);
            SB();
#undef SB
#undef PV_IDXB
#undef PV_SWAPIDX
#undef PV_IDX
#undef PV_ISSUE
#undef PV_CONSUME
        }
    }
}

__global__ void __launch_bounds__(512, 2) hymba_fwd(Args a) {
    extern __shared__ __attribute__((aligned(16))) unsigned char shm[];
    LAS unsigned char* lds = (LAS unsigned char*)shm;
    volatile LAS unsigned* xbw = (volatile LAS unsigned*)(lds + LDS_BYTES - 16);
    if (threadIdx.x == 0) { xbw[0] = 0u; xbw[1] = 0u; xbw[2] = 0u; xbw[3] = 0u; }
    __syncthreads();
    XcdBarrier bar = xcd_barrier_post((unsigned*)(a.ws + WS_CTL), xbw);
#ifndef PHMASK
#define PHMASK 0x3ff
#endif
#define RUN(p) ((((PHMASK) >> (p)) & 1) && a.ph_lo <= (p) && (p) < a.ph_hi)
#define SEAM(p) do { if (a.ph_lo <= (p) && (p) + 1 < a.ph_hi) xcd_barrier(bar); } while (0)
    if (RUN(0)) phase_prep(a, lds);
    SEAM(0);
    if (RUN(1)) {
        phase_cumf_meta(a, lds);
        pg8::Gemm g; g.A = (const bf16_t*)(a.ws + WS_XN); g.Bt = (const bf16_t*)(a.ws + WS_WTIN); g.M = S_ROWS; g.N = NPROJ; g.K = DM / 2;
        pg8::StaticOrder so; so.init(g.M, g.N, (int)gridDim.x, (int)blockIdx.x);
        EpiInI8 ep; ep.O = (bf16_t*)(a.ws + WS_PROJ); ep.sa = (const float*)(a.ws + WS_SA); ep.sb = (const float*)(a.ws + WS_SBIN);
        pg8::gemm_phase<EpiInI8, pg8::StaticOrder, false, true>(lds, g, so, ep, nullptr);
    }
    SEAM(1);
    if (RUN(2)) phase_ak(a);
    SEAM(2);
    if (RUN(3)) phase_attn(a, lds);
    SEAM(3);
    if (RUN(4)) phase_merge(a);
    SEAM(4);
    if (RUN(5)) {
        pg8::Gemm g; g.A = (const bf16_t*)(a.ws + WS_MERGED); g.Bt = (const bf16_t*)(a.ws + WS_WTOUT); g.M = S_ROWS; g.N = DM; g.K = DM / 2;
        pg8::StaticOrder so; so.init(g.M, g.N, (int)gridDim.x, (int)blockIdx.x);
        EpiOut ep; ep.X = a.x; ep.H1G = (bf16_t*)(a.ws + WS_H1G); ep.gffn = a.norm_ffn; ep.rowsq = (float*)(a.ws + WS_ROWSQ);
        ep.sm = (const float*)(a.ws + WS_SM); ep.sb = (const float*)(a.ws + WS_SBOUT); ep.eb = lds + EPI_LDS;
        pg8::gemm_phase<EpiOut, pg8::StaticOrder, false, true>(lds, g, so, ep, nullptr);
    }
    SEAM(5);
    if (RUN(6)) {
        pg8::Gemm g; g.A = (const bf16_t*)(a.ws + WS_H1G); g.Bt = (const bf16_t*)(a.ws + WS_WTQ); g.M = S_ROWS; g.N = DM; g.K = DM;
        pg8::StaticOrder so; so.init(g.M, g.N, (int)gridDim.x, (int)blockIdx.x);
        pg8::EpiBf16<0> ep; ep.O = (bf16_t*)(a.ws + WS_PQ); ep.ldc = DM; ep.bias = nullptr; ep.split_cols = 0; ep.split_stride = 0;
        pg8::gemm_phase<pg8::EpiBf16<0>, pg8::StaticOrder, false>(lds, g, so, ep, nullptr);
    }
    SEAM(6);
    if (RUN(7)) phase_topk(a, lds);
    SEAM(7);
    if (RUN(9)) phase_gather_v(a);
#undef RUN
#undef SEAM
}

#ifndef N_LAUNCHES
#define N_LAUNCHES 1
#endif
extern "C" void kernel_launch(void* const* d_in, const int* in_sizes, int n_in, void* d_out, int out_size, void* d_ws, size_t ws_size, hipStream_t stream) {
    static int grid = 0;
    if (grid == 0) {
        if (n_in != 15 || in_sizes[0] != S_ROWS * DM || out_size != S_ROWS * DM || ws_size < WS_END) {
            fprintf(stderr, "kernel_launch: unexpected shapes (n_in %d, in0 %d, out %d, ws %zu, need %zu)\n", n_in, n_in > 0 ? in_sizes[0] : -1, out_size, ws_size, (size_t)WS_END); grid = -1; return; }
        int dev = 0, cus = 0, per_cu = 0;
        if (hipGetDevice(&dev) != hipSuccess || hipDeviceGetAttribute(&cus, hipDeviceAttributeMultiprocessorCount, dev) != hipSuccess) { grid = -1; return; }
        if (hipFuncSetAttribute((const void*)hymba_fwd, hipFuncAttributeMaxDynamicSharedMemorySize, LDS_BYTES) != hipSuccess) { fprintf(stderr, "kernel_launch: hipFuncSetAttribute failed\n"); grid = -1; return; }
        if (hipOccupancyMaxActiveBlocksPerMultiprocessor(&per_cu, (const void*)hymba_fwd, 512, LDS_BYTES) != hipSuccess || per_cu < 1) { fprintf(stderr, "kernel_launch: occupancy query says %d\n", per_cu); }
        (void)hipGetLastError();
        grid = cus;
    }
    if (grid < 0) return;
    Args a{};
    a.x = (const float*)d_in[0]; a.meta = (const float*)d_in[1]; a.norm_mix = (const float*)d_in[2]; a.w_in = (const float*)d_in[3]; a.b_forget = (const float*)d_in[4];
    a.gq = (const float*)d_in[5]; a.gk = (const float*)d_in[6]; a.g_sb = (const float*)d_in[7]; a.g_fox = (const float*)d_in[8]; a.w_out = (const float*)d_in[9];
    a.norm_ffn = (const float*)d_in[10]; a.w_query = (const float*)d_in[11]; a.sub_keys = (const float*)d_in[12]; a.pu = (const float*)d_in[13]; a.pv = (const float*)d_in[14];
    a.out = (float*)d_out; a.ws = (unsigned char*)d_ws; a.sub = 7; a.pad_ = 0;
#ifdef PROBE_DUP
    const int lo[3] = {0, PROBE_DUP, PROBE_DUP + 1}, hi[3] = {PROBE_DUP + 1, PROBE_DUP + 1, NPH};
    for (int li = 0; li < 3; ++li) {
        if (lo[li] >= hi[li]) continue;
        a.ph_lo = lo[li]; a.ph_hi = hi[li];
#ifdef PROBE_SUB
        a.sub = (li == 1) ? PROBE_SUB : 7;
#endif
        (void)hipMemsetAsync((char*)d_ws + WS_CTL, 0, CTL_BYTES, stream);
        hipLaunchKernelGGL(hymba_fwd, dim3(grid), dim3(512), LDS_BYTES, stream, a);
    }
#else
    for (int li = 0; li < N_LAUNCHES; ++li) {
        if (N_LAUNCHES == 1) { a.ph_lo = 0; a.ph_hi = NPH; } else { a.ph_lo = li * NPH / N_LAUNCHES; a.ph_hi = (li + 1) * NPH / N_LAUNCHES; }
        (void)hipMemsetAsync((char*)d_ws + WS_CTL, 0, li == 0 ? CTL_BYTES : (size_t)XCD_BAR_WORDS * 4, stream);
        hipLaunchKernelGGL(hymba_fwd, dim3(grid), dim3(512), LDS_BYTES, stream, a);
    }
#endif
}
```

```cpp
#include <hip/hip_runtime.h>
#include <cstdio>
#include <cstdint>
#include <cstddef>


typedef short s16x4 __attribute__((ext_vector_type(4)));
typedef float f32x16 __attribute__((ext_vector_type(16)));
typedef unsigned u32x2 __attribute__((ext_vector_type(2)));
#define XB_TMO      128
#define XB_XCNT(j)  (256  + 64 * (j))
#define XB_XSUB(j)  (1280 + 64 * (j))
#define XB_XGEN(j)  (2304 + 64 * (j))
#define XB_TOP      3328
#define XB_TOPGEN   3392
#define XCD_BAR_WORDS 3456
#define XB_SPIN_CAP (1u << 18)
#define LAS __attribute__((address_space(3)))

__device__ __forceinline__ unsigned xb_ld(unsigned* p)              { return __hip_atomic_load(p, __ATOMIC_RELAXED, __HIP_MEMORY_SCOPE_AGENT); }
__device__ __forceinline__ unsigned xb_add(unsigned* p, unsigned v) { return __hip_atomic_fetch_add(p, v, __ATOMIC_RELAXED, __HIP_MEMORY_SCOPE_AGENT); }
__device__ __forceinline__ unsigned xb_xcc_id() { return (unsigned)__builtin_amdgcn_s_getreg((3 << 11) | 20) & 0xFu; }
#define XB_SPIN(cond, bar) do { unsigned _sp = 0; while (cond) { __builtin_amdgcn_s_sleep(1); \
    if ((++_sp & 255u) == 0u) { if (xb_ld(&(bar)[XB_TMO])) break; if (_sp > XB_SPIN_CAP) { atomicAdd(&(bar)[XB_TMO], 1u); break; } } } } while (0)

struct XcdBarrier {
    unsigned* bar; unsigned x;
    volatile LAS unsigned* st;
};

__device__ __forceinline__ XcdBarrier xcd_barrier_post(unsigned* bar, volatile LAS unsigned* st) {
    XcdBarrier b; b.bar = bar; b.x = xb_xcc_id(); b.st = st;
    if (threadIdx.x == 0) (void)xb_add(&bar[XB_XCNT(b.x)], 1u);
    return b;
}
__device__ __forceinline__ void xcd_barrier_complete(unsigned* bar, unsigned x, unsigned& nloc, unsigned& nx) {
    const unsigned G = gridDim.x * gridDim.y * gridDim.z;
    unsigned sum, cnt, mine, sp = 0u;
    for (;;) {
        sum = 0u; cnt = 0u; mine = 0u;
#pragma unroll
        for (unsigned j = 0; j < 16; ++j) { const unsigned c = xb_ld(&bar[XB_XCNT(j)]); sum += c; cnt += (c > 0u) ? 1u : 0u; mine = (j == x) ? c : mine; }
        if (sum == G) break;
        __builtin_amdgcn_s_sleep(1);
        if ((++sp & 255u) == 0u) { if (xb_ld(&bar[XB_TMO])) break; if (sp > XB_SPIN_CAP) { atomicAdd(&bar[XB_TMO], 1u); break; } }
    }
    nloc = mine > 0u ? mine : 1u; nx = cnt > 0u ? cnt : 1u;
}

__device__ __forceinline__ void xcd_barrier(const XcdBarrier& b) {
    asm volatile("s_waitcnt vmcnt(0)" ::: "memory");
    __syncthreads();
    if (threadIdx.x == 0) {
        unsigned* bar = b.bar;
        __builtin_amdgcn_s_waitcnt(0);
        unsigned nloc = b.st[0], nx = b.st[1];
        if (nloc == 0u) { xcd_barrier_complete(bar, b.x, nloc, nx); b.st[0] = nloc; b.st[1] = nx; }
        const unsigned old = xb_add(&bar[XB_XSUB(b.x)], 1u);
        const unsigned gen = old / nloc;
        if (old + 1u == (gen + 1u) * nloc) {
            __builtin_amdgcn_fence(__ATOMIC_RELEASE, "agent");
            asm volatile("s_waitcnt vmcnt(0)" ::: "memory");
            const unsigned og = xb_add(&bar[XB_TOP], 1u);
            const unsigned tg = og / nx;
            if (og + 1u == (tg + 1u) * nx) xb_add(&bar[XB_TOPGEN], 1u);
            else XB_SPIN(xb_ld(&bar[XB_TOPGEN]) == tg, bar);
            __builtin_amdgcn_fence(__ATOMIC_ACQUIRE, "agent");
            xb_add(&bar[XB_XGEN(b.x)], 1u);
            asm volatile("s_waitcnt vmcnt(0)" ::: "memory");
        } else {
            XB_SPIN(xb_ld(&bar[XB_XGEN(b.x)]) == gen, bar);
            __builtin_amdgcn_fence(__ATOMIC_ACQUIRE, "agent");
            asm volatile("s_waitcnt vmcnt(0)" ::: "memory");
        }
    }
    __syncthreads();
}

namespace pg8 {
#define PG8_LAS __attribute__((address_space(3)))
typedef unsigned short bf16_t;
typedef short bf16x8 __attribute__((ext_vector_type(8)));
typedef float f32x4 __attribute__((ext_vector_type(4)));
typedef unsigned u32x4 __attribute__((ext_vector_type(4)));
constexpr int BM = 256, BK = 64, HALF = 128, HTB = HALF * BK * 2  , STAGE_BYTES = 8 * HTB, NXCD = 8, WGM = 8;

__host__ __device__ __forceinline__ int lds_byte(int r, int c) { const int st = (r >> 4) * 2 + (c >> 5), rr = r & 15, cc = c & 31, ob = rr * 64 + cc * 2; return st * 1024 + (ob ^ (((ob >> 9) & 1) << 5)); }
__host__ __device__ __forceinline__ void stage_rc(int b, int& R, int& C) { const int st = b / 1024, sb = b % 1024, swz = sb ^ (((sb >> 9) & 1) << 5); R = (st >> 1) * 16 + swz / 64; C = (st & 1) * 32 + (swz % 64) / 2; }
__host__ __device__ __forceinline__ int perm32(int rho) { const int n = rho >> 4, i = rho & 15; return 8 * (i >> 2) + 4 * n + (i & 3); }

struct Unit { int pm, pn; };
struct Gemm { const bf16_t* A; const bf16_t* Bt; int M, N, K; };

struct StaticOrder {
    int nM, nN, nwg, G, c;
    __host__ __device__ void init(int M, int N, int G_, int c_) { nM = M / BM; nN = N / BM; nwg = nM * nN; G = G_; c = c_; }
    __host__ __device__ bool next(int i, Unit& u) const {
        const long L = (long)i * G + c; if (L >= nwg) return false;
        int wgid = (int)L; { const int q = nwg / NXCD, r = nwg % NXCD, xcd = wgid % NXCD, off = wgid / NXCD; wgid = (xcd < r ? xcd * (q + 1) : r * (q + 1) + (xcd - r) * q) + off; }
        const int nig = WGM * nN, gid = wgid / nig, fm = gid * WGM, gsz = (nM - fm) < WGM ? (nM - fm) : WGM;
        u.pm = fm + ((wgid % nig) % gsz); u.pn = (wgid % nig) / gsz; return true;
    }
    __device__ __forceinline__ void a_ready(const Unit&) const {}
    __device__ __forceinline__ void done(const Unit&) const {}
};

typedef __bf16 bf16x2_t __attribute__((ext_vector_type(2)));
__device__ __forceinline__ unsigned cvt_pk_bf16(float lo, float hi) { bf16x2_t v; v[0] = (__bf16)lo; v[1] = (__bf16)hi; return __builtin_bit_cast(unsigned, v); }
typedef float f32x2 __attribute__((ext_vector_type(2)));
__device__ __forceinline__ f32x2 gelu_pk(f32x2 v) {
    const f32x2 av = __builtin_elementwise_abs(v), d = av * 0.2316418882f + 1.0f;
    f32x2 t; t.x = __builtin_amdgcn_rcpf(d.x); t.y = __builtin_amdgcn_rcpf(d.y);
    f32x2 q = t * 0.5307027145f + (-0.7265760135f); q = q * t + 0.7107068705f; q = q * t + (-0.142248368f); q = q * t + 0.127414796f; q = q * t;
    const f32x2 s = (v * v) * (-0.72134752044f);
    f32x2 e; e.x = __builtin_amdgcn_exp2f(s.x); e.y = __builtin_amdgcn_exp2f(s.y);
    const f32x2 m = v * (q * e), r = v - m;
    f32x2 o; o.x = v.x < 0.f ? m.x : r.x; o.y = v.y < 0.f ? m.y : r.y; return o;
}
template <int ACT  > struct EpiBf16 {
    static constexpr bool PERM = true, AFTER_DRAIN = false; typedef f32x4 AccT;
    bf16_t* O; int ldc; const float* bias; int split_cols; size_t split_stride;
    __device__ __forceinline__ void operator()(const f32x4 (&acc)[2][2][4][2], const Unit& u, int wr, int wc, int fr, int fq) const {
        const int row0 = u.pm * BM + wr * 64 + fr; int colt = u.pn * BM; bf16_t* base = O;
        if (split_cols) { const int t = colt / split_cols; base += (size_t)t * split_stride; colt -= t * split_cols; }
        const int col0 = colt + wc * 32 + 8 * fq, bcol0 = u.pn * BM + wc * 32 + 8 * fq;
        f32x4 bv[2][2];
#pragma unroll
        for (int bj = 0; bj < 2; ++bj)
#pragma unroll
            for (int n = 0; n < 2; ++n) bv[bj][n] = bias ? *(const f32x4*)(bias + bcol0 + bj * HALF + 4 * n) : (f32x4){0.f, 0.f, 0.f, 0.f};
#pragma unroll
        for (int ai = 0; ai < 2; ++ai)
#pragma unroll
            for (int m = 0; m < 4; ++m) { bf16_t* rowp = base + (size_t)(row0 + ai * HALF + m * 16) * ldc + col0;
#pragma unroll
                for (int bj = 0; bj < 2; ++bj) { f32x4 v0 = acc[ai][bj][m][0] + bv[bj][0], v1 = acc[ai][bj][m][1] + bv[bj][1];
                    if (ACT == 1) { f32x2 a = gelu_pk((f32x2){v0[0], v0[1]}), b = gelu_pk((f32x2){v0[2], v0[3]}), c = gelu_pk((f32x2){v1[0], v1[1]}), d = gelu_pk((f32x2){v1[2], v1[3]});
                        v0 = (f32x4){a.x, a.y, b.x, b.y}; v1 = (f32x4){c.x, c.y, d.x, d.y}; }
                    if (ACT == 2) {
#pragma unroll
                        for (int j = 0; j < 4; ++j) { v0[j] = 0.5f * v0[j] * (1.0f + erff(v0[j] * 0.70710678f)); v1[j] = 0.5f * v1[j] * (1.0f + erff(v1[j] * 0.70710678f)); } }
                    u32x4 w; w.x = cvt_pk_bf16(v0[0], v0[1]); w.y = cvt_pk_bf16(v0[2], v0[3]); w.z = cvt_pk_bf16(v1[0], v1[1]); w.w = cvt_pk_bf16(v1[2], v1[3]);
                    *(u32x4*)(rowp + bj * HALF) = w; } }
    }
};

typedef int i32x4 __attribute__((ext_vector_type(4)));
template <class Epi, class Sched, bool STAMP = false, bool I8 = false>
__device__ __forceinline__ void gemm_phase(PG8_LAS unsigned char* lds, const Gemm g, const Sched& S, const Epi& E, unsigned long long* stamps) {
    const int tid = threadIdx.x, wid = __builtin_amdgcn_readfirstlane(tid >> 6), lane = tid & 63, wr = wid >> 2, wc = wid & 3, fr = lane & 15, fq = lane >> 4;
    const int K = g.K, nt = K / BK;
    int ts_lo = 0, ts_hi = 0, nts = 0; const unsigned long long rt_entry = STAMP ? (unsigned long long)wall_clock64() : 0ull;
#define PG8_STAMP() do { if (STAMP && wid == 0 && nts < 64) { const unsigned long long _c = (unsigned long long)clock64(); \
        ts_lo = (lane == nts) ? (int)(unsigned)_c : ts_lo; ts_hi = (lane == nts) ? (int)(unsigned)(_c >> 32) : ts_hi; ++nts; } } while (0)
    PG8_STAMP();
    unsigned voffA[2], voffB[2];
#pragma unroll
    for (int i = 0; i < 2; ++i) { int R, C; stage_rc(tid * 16 + i * 8192, R, C); const int Rb = Epi::PERM ? ((R & ~31) + perm32(R & 31)) : R;
        voffA[i] = (unsigned)(R * K + C) * 2u; voffB[i] = (unsigned)(Rb * K + C) * 2u; }
    const size_t kstep = (size_t)(BK * 2);
    const size_t hstep = (size_t)HALF * K * 2;
    const size_t tstep = 2 * hstep;
    const unsigned ldsw = (unsigned)wid * 1024u;
    const int aoff = lds_byte(wr * 64 + fr, fq * 8), boff = lds_byte(wc * 32 + fr, fq * 8);
#define PG8_SA(b, h) (((b) * 2 + (h)) * HTB)
#define PG8_SB(b, h) ((4 + (b) * 2 + (h)) * HTB)
#define PG8_STAGE(bufoff, gbase, voff) do { _Pragma("unroll") for (int _i = 0; _i < 2; ++_i) \
        __builtin_amdgcn_global_load_lds((const unsigned*)((const char*)(gbase) + (voff)[_i]), (PG8_LAS unsigned*)(lds + (bufoff) + ldsw + _i * 8192), 16, 0, 0); } while (0)
#define PG8_LDA(dst, b, h) do { _Pragma("unroll") for (int m = 0; m < 4; ++m) _Pragma("unroll") for (int k = 0; k < 2; ++k) dst[m][k] = *(const PG8_LAS bf16x8*)(lds + PG8_SA(b, h) + aoff + m * 2048 + k * 1024); } while (0)
#define PG8_LDB(dst, b, h) do { _Pragma("unroll") for (int n = 0; n < 2; ++n) _Pragma("unroll") for (int k = 0; k < 2; ++k) dst[n][k] = *(const PG8_LAS bf16x8*)(lds + PG8_SB(b, h) + boff + n * 2048 + k * 1024); } while (0)
#define PG8_MMA(ai, bj, At, Bt) do { __builtin_amdgcn_s_setprio(1); _Pragma("unroll") for (int m = 0; m < 4; ++m) _Pragma("unroll") for (int n = 0; n < 2; ++n) _Pragma("unroll") for (int k = 0; k < 2; ++k) { \
        if constexpr (I8) acc[ai][bj][m][n] = __builtin_bit_cast(AccT, __builtin_amdgcn_mfma_i32_16x16x64_i8(__builtin_bit_cast(i32x4, Bt[n][k]), __builtin_bit_cast(i32x4, At[m][k]), __builtin_bit_cast(i32x4, acc[ai][bj][m][n]), 0, 0, 0)); \
        else acc[ai][bj][m][n] = __builtin_bit_cast(AccT, __builtin_amdgcn_mfma_f32_16x16x32_bf16(Bt[n][k], At[m][k], __builtin_bit_cast(f32x4, acc[ai][bj][m][n]), 0, 0, 0)); } __builtin_amdgcn_s_setprio(0); } while (0)
#define PG8_WAIT_V(n) asm volatile("s_waitcnt vmcnt(" #n ")" ::: "memory")
#define PG8_WAIT_L(n) asm volatile("s_waitcnt lgkmcnt(" #n ")" ::: "memory")
#define PG8_BAR __builtin_amdgcn_s_barrier()
#define PG8_SCHED __builtin_amdgcn_sched_barrier(0)
    Unit cur, nxt; int ui = 0;
    if (!S.next(0, cur)) return;
    typedef typename Epi::AccT AccT;
    AccT acc[2][2][4][2];
#pragma unroll
    for (int a = 0; a < 2; ++a)
#pragma unroll
        for (int b = 0; b < 2; ++b)
#pragma unroll
            for (int m = 0; m < 4; ++m)
#pragma unroll
                for (int n = 0; n < 2; ++n) acc[a][b][m][n] = (AccT){0, 0, 0, 0};
    bf16x8 At[4][2], B0[2][2], B1[2][2];
    const char* cA = (const char*)g.A + (size_t)cur.pm * tstep; const char* cB = (const char*)g.Bt + (size_t)cur.pn * tstep;
    S.a_ready(cur);
    PG8_STAGE(PG8_SB(0, 0), cB, voffB); PG8_STAGE(PG8_SA(0, 0), cA, voffA); PG8_STAGE(PG8_SB(0, 1), cB + hstep, voffB); PG8_STAGE(PG8_SA(0, 1), cA + hstep, voffA);
    if (wr == 1) PG8_BAR;
    PG8_WAIT_V(4); PG8_BAR;
    PG8_STAGE(PG8_SB(1, 0), cB + kstep, voffB); PG8_STAGE(PG8_SA(1, 0), cA + kstep, voffA); PG8_STAGE(PG8_SB(1, 1), cB + hstep + kstep, voffB);
    PG8_WAIT_V(6); PG8_BAR;
    PG8_STAMP();
    for (;;) {
        const bool has_next = S.next(ui + 1, nxt);
        const char* nA = has_next ? (const char*)g.A + (size_t)nxt.pm * tstep : cA; const char* nB = has_next ? (const char*)g.Bt + (size_t)nxt.pn * tstep : cB;
        for (int t = 0; t < nt; t += 2) {
            const bool last = (t == nt - 2);
            const char* a1 = cA + (size_t)(t + 1) * kstep;
            const char* a2 = last ? nA : cA + (size_t)(t + 2) * kstep; const char* b2 = last ? nB : cB + (size_t)(t + 2) * kstep;
            const char* a3 = a2 + kstep; const char* b3 = b2 + kstep;
            if (last && has_next) S.a_ready(nxt);
            PG8_LDB(B0, 0, 0); PG8_SCHED; PG8_LDA(At, 0, 0); PG8_STAGE(PG8_SA(1, 1), a1 + hstep, voffA);
            PG8_WAIT_L(8); PG8_BAR; PG8_WAIT_L(0); PG8_MMA(0, 0, At, B0); PG8_BAR; PG8_SCHED;
            PG8_LDB(B1, 0, 1); PG8_STAGE(PG8_SB(0, 0), b2, voffB);
            PG8_BAR; PG8_WAIT_L(0); PG8_MMA(0, 1, At, B1); PG8_BAR;
            PG8_LDA(At, 0, 1); PG8_STAGE(PG8_SA(0, 0), a2, voffA);
            PG8_BAR; PG8_WAIT_L(0); PG8_MMA(1, 0, At, B0); PG8_BAR; PG8_SCHED;
            PG8_STAGE(PG8_SB(0, 1), b2 + hstep, voffB);
            PG8_WAIT_V(6); PG8_BAR; PG8_MMA(1, 1, At, B1); PG8_BAR;
            PG8_LDB(B0, 1, 0); PG8_SCHED; PG8_LDA(At, 1, 0); PG8_STAGE(PG8_SA(0, 1), a2 + hstep, voffA);
            PG8_WAIT_L(8); PG8_BAR; PG8_WAIT_L(0); PG8_MMA(0, 0, At, B0); PG8_BAR; PG8_SCHED;
            PG8_LDB(B1, 1, 1); PG8_STAGE(PG8_SB(1, 0), b3, voffB);
            PG8_BAR; PG8_WAIT_L(0); PG8_MMA(0, 1, At, B1); PG8_BAR;
            PG8_LDA(At, 1, 1); PG8_STAGE(PG8_SA(1, 0), a3, voffA);
            PG8_BAR; PG8_WAIT_L(0); PG8_MMA(1, 0, At, B0); PG8_BAR; PG8_SCHED;
            PG8_STAGE(PG8_SB(1, 1), b3 + hstep, voffB);
            PG8_WAIT_V(6); PG8_BAR; PG8_MMA(1, 1, At, B1); PG8_BAR;
        }
        PG8_STAMP();
        if constexpr (!Epi::AFTER_DRAIN) { E(acc, cur, wr, wc, fr, fq); S.done(cur); }
        PG8_STAMP();
        if (!has_next) break;
#pragma unroll
        for (int a = 0; a < 2; ++a)
#pragma unroll
            for (int b = 0; b < 2; ++b)
#pragma unroll
                for (int m = 0; m < 4; ++m)
#pragma unroll
                    for (int n = 0; n < 2; ++n) acc[a][b][m][n] = (AccT){0, 0, 0, 0};
        cur = nxt; cA = nA; cB = nB; ++ui;
    }
    PG8_WAIT_V(0);
    if (wr == 0) PG8_BAR;
    PG8_BAR;
    if constexpr (Epi::AFTER_DRAIN) { E.fused(acc, cur, wr, wc, fr, fq, lds, wid, lane); S.done(cur); }
    PG8_STAMP();
    if (STAMP && wid == 0) { stamps[lane] = lane < nts ? (((unsigned long long)(unsigned)ts_hi << 32) | (unsigned)ts_lo) : 0ull;
        if (lane == 62) stamps[62] = rt_entry; if (lane == 63) stamps[63] = (unsigned long long)wall_clock64(); }
#undef PG8_STAMP
#undef PG8_SA
#undef PG8_SB
#undef PG8_STAGE
#undef PG8_LDA
#undef PG8_LDB
#undef PG8_MMA
#undef PG8_WAIT_V
#undef PG8_WAIT_L
#undef PG8_BAR
#undef PG8_SCHED
}
}
using pg8::bf16_t; using pg8::bf16x8; using pg8::f32x4; using pg8::u32x4;

constexpr int S_ROWS = 16384, NMETA = 16, DM = 2048, WID = 1024, CIN = 7176, NPROJ = 7168;
constexpr int KPAD = 16416;
constexpr float EPS = 1e-6f;
constexpr float LOG2E = 1.4426950408889634f;
constexpr float QSCALE2 = 0.08838834764831845f * 1.4426950408889634f;
constexpr int LDS_BYTES = 155648;
constexpr int NPH = 10;
constexpr float PRUNE_LOG2 = -64.0f;

constexpr size_t al256(size_t x) { return (x + 255) & ~(size_t)255; }
constexpr size_t PROJ_T   = (size_t)S_ROWS * WID * 2;
constexpr size_t WS_CTL   = 0;
constexpr size_t CTL_BYTES = 65536;
constexpr size_t WS_WTIN  = CTL_BYTES;
constexpr size_t WS_WTOUT = WS_WTIN + (size_t)NPROJ * DM * 2;
constexpr size_t WS_WTQ   = WS_WTOUT + (size_t)DM * DM * 2;
constexpr size_t WS_SUBK  = WS_WTQ + (size_t)DM * DM * 2;
constexpr size_t WS_XN    = WS_SUBK + (size_t)16 * 128 * 128 * 2;
constexpr size_t WS_PROJ  = WS_XN + (size_t)KPAD * DM * 2;
constexpr size_t WS_METAKV= WS_PROJ + 7 * PROJ_T;
constexpr size_t WS_LCUM  = WS_METAKV + (size_t)4 * 32 * 1024 * 2;
constexpr size_t WS_CHT   = WS_LCUM + (size_t)KPAD * 8 * 4;
constexpr size_t WS_CK2   = al256(WS_CHT + 257 * 8 * 4);
constexpr size_t WS_AK    = WS_CK2 + (size_t)8 * KPAD * 4;
constexpr size_t WS_ATT   = al256(WS_AK + (size_t)8 * KPAD * 4);
constexpr size_t WS_SQ    = WS_ATT + 2 * PROJ_T;
constexpr size_t WS_ROWSQ = WS_SQ + 2 * (size_t)S_ROWS * 8 * 4;
constexpr size_t WS_U8    = WS_ROWSQ + (size_t)S_ROWS * 32 * 4;
constexpr size_t WS_SU4   = WS_U8 + (size_t)16384 * 1024;
constexpr size_t WS_V8    = WS_U8 + (size_t)16384 * DM;
constexpr size_t WS_SU    = WS_V8 + (size_t)16384 * DM;
constexpr size_t WS_SV    = WS_SU + (size_t)16384 * 4;
constexpr size_t WS_SA    = WS_SV + (size_t)16384 * 4;
constexpr size_t WS_SBIN  = WS_SA + (size_t)KPAD * 4;
constexpr size_t WS_SBOUT = WS_SBIN + (size_t)NPROJ * 4;
constexpr size_t WS_SM    = WS_SBOUT + (size_t)DM * 4;
constexpr size_t WS_END   = WS_SM + (size_t)S_ROWS * 4;
constexpr size_t WS_MERGED= WS_XN;
constexpr size_t WS_PQ    = WS_XN;
constexpr size_t WS_H1G   = WS_PROJ;
constexpr size_t WS_IDX   = WS_PROJ + 2 * PROJ_T;
constexpr size_t WS_G     = WS_IDX + (size_t)S_ROWS * 128 * 4;
constexpr size_t WS_HN8   = WS_PROJ + 3 * PROJ_T;
constexpr size_t WS_COEF  = WS_PROJ + 4 * PROJ_T;
constexpr size_t WS_XS    = WS_COEF + (size_t)S_ROWS * 128 * 4;
constexpr int QCTR_WORD = 4096;
constexpr int UQ_WORD = 4096 + 64;
constexpr int VQ_WORD = 4096 + 64 * 17;
static_assert((VQ_WORD + 64 * 16) * 4 <= (int)CTL_BYTES, "control words");
static_assert(WS_END <= ((size_t)512 << 20), "workspace");

struct Args {
    const float *x, *meta, *norm_mix, *w_in, *b_forget, *gq, *gk, *g_sb, *g_fox, *w_out, *norm_ffn, *w_query, *sub_keys, *pu, *pv;
    float* out; unsigned char* ws;
    int ph_lo, ph_hi;
    int sub, pad_;
};

__device__ __forceinline__ float bf2f(unsigned short b) { return __uint_as_float((unsigned)b << 16); }
__device__ __forceinline__ float bflo(unsigned w) { return __uint_as_float(w << 16); }
__device__ __forceinline__ float bfhi(unsigned w) { return __uint_as_float(w & 0xffff0000u); }
__device__ __forceinline__ unsigned pk_bf16(float lo, float hi) { return pg8::cvt_pk_bf16(lo, hi); }
__device__ __forceinline__ float wave_sum(float v) {
    v += __uint_as_float((unsigned)__builtin_amdgcn_update_dpp(0, (int)__float_as_uint(v), 0xB1, 0xF, 0xF, true));
    v += __uint_as_float((unsigned)__builtin_amdgcn_update_dpp(0, (int)__float_as_uint(v), 0x4E, 0xF, 0xF, true));
    v += __uint_as_float((unsigned)__builtin_amdgcn_update_dpp(0, (int)__float_as_uint(v), 0x141, 0xF, 0xF, true));
    v += __uint_as_float((unsigned)__builtin_amdgcn_update_dpp(0, (int)__float_as_uint(v), 0x140, 0xF, 0xF, true));
    v += __uint_as_float((unsigned)__builtin_amdgcn_update_dpp(0, (int)__float_as_uint(v), 0x142, 0xA, 0xF, true));
    v += __uint_as_float((unsigned)__builtin_amdgcn_update_dpp(0, (int)__float_as_uint(v), 0x143, 0xC, 0xF, true));
    return __uint_as_float((unsigned)__builtin_amdgcn_readlane((int)__float_as_uint(v), 63));
}
__device__ __forceinline__ float wave_max(float v) {
    v = fmaxf(v, __uint_as_float((unsigned)__builtin_amdgcn_update_dpp((int)__float_as_uint(v), (int)__float_as_uint(v), 0xB1, 0xF, 0xF, false)));
    v = fmaxf(v, __uint_as_float((unsigned)__builtin_amdgcn_update_dpp((int)__float_as_uint(v), (int)__float_as_uint(v), 0x4E, 0xF, 0xF, false)));
    v = fmaxf(v, __uint_as_float((unsigned)__builtin_amdgcn_update_dpp((int)__float_as_uint(v), (int)__float_as_uint(v), 0x141, 0xF, 0xF, false)));
    v = fmaxf(v, __uint_as_float((unsigned)__builtin_amdgcn_update_dpp((int)__float_as_uint(v), (int)__float_as_uint(v), 0x140, 0xF, 0xF, false)));
    v = fmaxf(v, __uint_as_float((unsigned)__builtin_amdgcn_update_dpp((int)__float_as_uint(v), (int)__float_as_uint(v), 0x142, 0xA, 0xF, false)));
    v = fmaxf(v, __uint_as_float((unsigned)__builtin_amdgcn_update_dpp((int)__float_as_uint(v), (int)__float_as_uint(v), 0x143, 0xC, 0xF, false)));
    return __uint_as_float((unsigned)__builtin_amdgcn_readlane((int)__float_as_uint(v), 63));
}
__device__ __forceinline__ int wave_isum(int v) {
    v += __builtin_amdgcn_update_dpp(0, v, 0xB1, 0xF, 0xF, true);
    v += __builtin_amdgcn_update_dpp(0, v, 0x4E, 0xF, 0xF, true);
    v += __builtin_amdgcn_update_dpp(0, v, 0x141, 0xF, 0xF, true);
    v += __builtin_amdgcn_update_dpp(0, v, 0x140, 0xF, 0xF, true);
    v += __builtin_amdgcn_update_dpp(0, v, 0x142, 0xA, 0xF, true);
    v += __builtin_amdgcn_update_dpp(0, v, 0x143, 0xC, 0xF, true);
    return __builtin_amdgcn_readlane(v, 63);
}
__device__ __forceinline__ float xhalf(float v) { const auto rr = __builtin_amdgcn_permlane32_swap(__float_as_uint(v), __float_as_uint(v), false, false); return (threadIdx.x & 32) ? __uint_as_float(rr[0]) : __uint_as_float(rr[1]); }
__device__ __forceinline__ float pair_max(float v) { const auto rr = __builtin_amdgcn_permlane32_swap(__float_as_uint(v), __float_as_uint(v), false, false); return fmaxf(__uint_as_float(rr[0]), __uint_as_float(rr[1])); }
__device__ __forceinline__ float pair_sum(float v) { const auto rr = __builtin_amdgcn_permlane32_swap(__float_as_uint(v), __float_as_uint(v), false, false); return __uint_as_float(rr[0]) + __uint_as_float(rr[1]); }
__device__ __forceinline__ float ex2(float x) { return __builtin_amdgcn_exp2f(x); }
__device__ __forceinline__ float lg2(float x) { return __builtin_amdgcn_logf(x); }

__device__ __forceinline__ void quant_rows(const Args& a, const int row_lo, const int row_hi) {
    const int tid = threadIdx.x, wid = tid >> 6, lane = tid & 63;
    {
        signed char* U8 = (signed char*)(a.ws + WS_U8); unsigned char* V8 = (unsigned char*)(a.ws + WS_V8);
        float* SU = (float*)(a.ws + WS_SU); float* SV = (float*)(a.ws + WS_SV);
        f32x4 qn[8];
        const int rstep = 8, rr0 = row_lo + wid;
        if (rr0 < row_hi) {
            const float* s0 = (rr0 >= 16384 ? a.pv + (size_t)(rr0 - 16384) * DM : a.pu + (size_t)rr0 * DM);
#pragma unroll
            for (int k = 0; k < 8; ++k) qn[k] = *(const f32x4*)(s0 + k * 256 + lane * 4);
        }
        for (int rr = rr0; rr < row_hi; rr += rstep) {
            const bool isv = rr >= 16384; const int e = isv ? rr - 16384 : rr;
            f32x4 v[8]; float am = 0.f;
#pragma unroll
            for (int k = 0; k < 8; ++k) v[k] = qn[k];
            if (rr + rstep < row_hi) {
                const int r1 = rr + rstep;
                const float* s1 = (r1 >= 16384 ? a.pv + (size_t)(r1 - 16384) * DM : a.pu + (size_t)r1 * DM);
#pragma unroll
                for (int k = 0; k < 8; ++k) qn[k] = *(const f32x4*)(s1 + k * 256 + lane * 4);
            }
#pragma unroll
            for (int k = 0; k < 8; ++k) am = fmaxf(fmaxf(am, fmaxf(fabsf(v[k][0]), fabsf(v[k][1]))), fmaxf(fabsf(v[k][2]), fabsf(v[k][3])));
            if (!isv) {
                unsigned char* U4 = (unsigned char*)(a.ws + WS_U8); unsigned char* SUE = (unsigned char*)(a.ws + WS_SU4);
#pragma unroll
                for (int k = 0; k < 8; ++k) {
                    float gm = fmaxf(fmaxf(fabsf(v[k][0]), fabsf(v[k][1])), fmaxf(fabsf(v[k][2]), fabsf(v[k][3])));
                    gm = fmaxf(gm, __shfl_xor(gm, 1)); gm = fmaxf(gm, __shfl_xor(gm, 2)); gm = fmaxf(gm, __shfl_xor(gm, 4));
                    const unsigned gb = __float_as_uint(gm);
                    int sbyte = (int)((gb >> 23) & 255u) - 2 + (((gb & 0x7fffffu) > 0x600000u) ? 1 : 0);
                    sbyte = gm > 0.f ? (sbyte < 1 ? 1 : sbyte) : 127;
                    const float gs = __uint_as_float((unsigned)sbyte << 23);
                    unsigned w = 0u;
                    w = (unsigned)__builtin_amdgcn_cvt_scalef32_pk_fp4_f32(w, v[k][0], v[k][1], gs, 0);
                    w = (unsigned)__builtin_amdgcn_cvt_scalef32_pk_fp4_f32(w, v[k][2], v[k][3], gs, 1);
                    *(unsigned short*)(U4 + (size_t)e * 1024 + 128 * k + 2 * lane) = (unsigned short)w;
                    if ((lane & 7) == 0) SUE[(size_t)e * 64 + ((((2 * k + (lane >> 5)) & 3) * 4 + ((lane >> 3) & 3)) * 4) + (k >> 1)] = (unsigned char)sbyte;
                }
                continue;
            }
            am = wave_max(am);
            float ssq = 0.f;
#pragma unroll
            for (int k = 0; k < 8; ++k) ssq += (v[k][0] * v[k][0] + v[k][1] * v[k][1]) + (v[k][2] * v[k][2] + v[k][3] * v[k][3]);
            ssq = wave_sum(ssq);
            const float sc4 = fminf(am, 2.5f * sqrtf(ssq * (1.0f / DM))) * (1.0f / 7.0f);
            const float inv = sc4 > 0.f ? 1.0f / sc4 : 0.f;
#pragma unroll
            for (int k = 0; k < 8; ++k) {
                unsigned w = 0u;
#pragma unroll
                for (int b = 0; b < 4; ++b) { int q = (int)rintf(v[k][b] * inv); q = q > 7 ? 7 : (q < -7 ? -7 : q); w |= (unsigned)((b & 1) ? (q & 15) : (q + 8)) << (4 * b); }
                *(unsigned short*)((unsigned char*)V8 + ((size_t)k * 16384 + e) * 128 + lane * 2) = (unsigned short)w;
            }
            if (lane == 0) SV[e] = sc4;
        }
    }
}

__device__ __forceinline__ void phase_prep(const Args& a, LAS unsigned char* lds) {
    const int tid = threadIdx.x, wid = tid >> 6, lane = tid & 63;
    LAS float* WF = (LAS float*)lds;
    LAS float* LF = (LAS float*)(lds + 65536);
    LAS float* TT = (LAS float*)(lds + 69632);
    unsigned char* XN8 = (unsigned char*)(a.ws + WS_XN); float* SA = (float*)(a.ws + WS_SA);
    float* LCUM = (float*)(a.ws + WS_LCUM); float* CHT = (float*)(a.ws + WS_CHT);
    for (int i = tid; i < 2048 * 2; i += 512) {
        const int d = i >> 1, part = i & 1;
        const f32x4 v = *(const f32x4*)(a.w_in + (size_t)d * CIN + NPROJ + part * 4);
        *(LAS f32x4*)(WF + ((((d & 3) * 2 + part) * 512) + (d >> 2)) * 4) = v;
    }
    __syncthreads();
    if (a.sub & 1)
    for (int g = (int)(gridDim.x - 1 - blockIdx.x); g < 257; g += gridDim.x) {
        const int nrows = g < 256 ? 64 : NMETA;
        const int rbase = g < 256 ? g * 64 : S_ROWS;
        f32x4 vn[8];
        if (wid < nrows) {
            const float* src0 = g < 256 ? a.x + (size_t)(rbase + wid) * DM : a.meta + (size_t)wid * DM;
#pragma unroll
            for (int c = 0; c < 8; ++c) vn[c] = *(const f32x4*)(src0 + c * 256 + lane * 4);
        }
        for (int r = wid; r < nrows; r += 8) {
            f32x4 v[8]; float ss = 0.f;
#pragma unroll
            for (int c = 0; c < 8; ++c) v[c] = vn[c];
            if (r + 8 < nrows) {
                const float* src1 = g < 256 ? a.x + (size_t)(rbase + r + 8) * DM : a.meta + (size_t)(r + 8) * DM;
#pragma unroll
                for (int c = 0; c < 8; ++c) vn[c] = *(const f32x4*)(src1 + c * 256 + lane * 4);
            }
            float amx = 0.f;
#pragma unroll
            for (int c = 0; c < 8; ++c) {
                const f32x4 gn = *(const f32x4*)(a.norm_mix + c * 256 + lane * 4);
                ss += v[c][0] * v[c][0] + v[c][1] * v[c][1] + v[c][2] * v[c][2] + v[c][3] * v[c][3];
                amx = fmaxf(fmaxf(amx, fmaxf(fabsf(v[c][0] * gn[0]), fabsf(v[c][1] * gn[1]))), fmaxf(fabsf(v[c][2] * gn[2]), fabsf(v[c][3] * gn[3])));
            }
            ss = wave_sum(ss); amx = wave_max(amx);
            const float rstd = rsqrtf(ss * (1.0f / DM) + EPS);
            const float am = amx * rstd * 1.000001f;
            const float qi = am > 0.f ? 127.0f / am : 0.f;
            if (lane == 0) SA[rbase + r] = am * (1.0f / 127.0f);
            float fl[8];
#pragma unroll
            for (int h = 0; h < 8; ++h) fl[h] = 0.f;
#pragma unroll
            for (int c = 0; c < 8; ++c) {
                const f32x4 gn = *(const f32x4*)(a.norm_mix + c * 256 + lane * 4);
                f32x4 y;
#pragma unroll
                for (int e = 0; e < 4; ++e) y[e] = (v[c][e] * rstd) * gn[e];
                unsigned w = 0u;
#pragma unroll
                for (int e = 0; e < 4; ++e) w |= ((unsigned)(int)rintf(y[e] * qi) & 0xffu) << (8 * e);
                *(unsigned*)(XN8 + (size_t)(rbase + r) * DM + c * 256 + lane * 4) = w;
                f32x4 wq[8];
#pragma unroll
                for (int q = 0; q < 8; ++q) wq[q] = *(const LAS f32x4*)(WF + ((q * 512) + c * 64 + lane) * 4);
#pragma unroll
                for (int e = 0; e < 4; ++e) {
                    const f32x4 w0 = wq[2 * e], w1 = wq[2 * e + 1];
                    fl[0] += y[e] * w0[0]; fl[1] += y[e] * w0[1]; fl[2] += y[e] * w0[2]; fl[3] += y[e] * w0[3];
                    fl[4] += y[e] * w1[0]; fl[5] += y[e] * w1[1]; fl[6] += y[e] * w1[2]; fl[7] += y[e] * w1[3];
                }
            }
#pragma unroll
            for (int o = 32; o >= 1; o >>= 1) {
                float t8[8];
#pragma unroll
                for (int h = 0; h < 8; ++h) t8[h] = __shfl_xor(fl[h], o);
#pragma unroll
                for (int h = 0; h < 8; ++h) fl[h] += t8[h];
            }
            float mine = 0.f;
#pragma unroll
            for (int h = 0; h < 8; ++h) mine = (lane == h) ? fl[h] : mine;
            if (lane < 8) { const float z = mine + a.b_forget[lane]; LF[r * 8 + lane] = fminf(z, 0.f) - log1pf(expf(-fabsf(z))); }
        }
        __syncthreads();
        if (tid < 8) {
            float run = 0.f;
            for (int r = 0; r < nrows; ++r) { run += LF[r * 8 + tid]; LCUM[(size_t)(rbase + r) * 8 + tid] = run; }
            CHT[g * 8 + tid] = run;
        }
        __syncthreads();
    }
    if (a.sub & 2) {
        LAS float* CM = (LAS float*)(lds + 69632);
        LAS unsigned char* TB = lds + 69632 + 8192 + 256;
        const int kr = tid >> 3, c4 = tid & 7;
        for (int u = blockIdx.x; u < 224 + 64; u += gridDim.x) {
            const bool isin = u < 224;
            const float* src = isin ? a.w_in : a.w_out; const int ld = isin ? CIN : DM; const int n0 = (isin ? u : u - 224) * 32;
            unsigned char* dst = (unsigned char*)(a.ws + (isin ? WS_WTIN : WS_WTOUT)); float* SB = (float*)(a.ws + (isin ? WS_SBIN : WS_SBOUT));
            f32x4 w[32]; f32x4 m4 = (f32x4){0.f, 0.f, 0.f, 0.f};
            const unsigned loffb = (unsigned)(4 * kr * ld + c4 * 4) * 4u;
#pragma unroll
            for (int q = 0; q < 32; ++q) {
                const float* sq = src + (size_t)((q >> 2) * 256 + (q & 3)) * ld + n0;
                w[q] = *(const f32x4*)((const char*)sq + loffb);
            }
#pragma unroll
            for (int q = 0; q < 32; ++q)
#pragma unroll
                for (int e = 0; e < 4; ++e) m4[e] = fmaxf(m4[e], fabsf(w[q][e]));
            *(LAS f32x4*)(CM + kr * 32 + c4 * 4) = m4;
            __syncthreads();
            if (tid < 32) { float m = 0.f; for (int i = 0; i < 64; ++i) m = fmaxf(m, CM[i * 32 + tid]); CM[2048 + tid] = m; SB[n0 + tid] = m * (1.0f / 127.0f); }
            __syncthreads();
            const f32x4 cm4 = *(const LAS f32x4*)(CM + 2048 + c4 * 4);
            f32x4 qi;
#pragma unroll
            for (int e = 0; e < 4; ++e) qi[e] = cm4[e] > 0.f ? 127.0f / cm4[e] : 0.f;
#pragma unroll
            for (int bb = 0; bb < 8; ++bb) {
#pragma unroll
                for (int e = 0; e < 4; ++e) {
                    unsigned pk = 0u;
#pragma unroll
                    for (int q = 0; q < 4; ++q) pk |= ((unsigned)(int)rintf(w[4 * bb + q][e] * qi[e]) & 0xffu) << (8 * q);
                    *(LAS unsigned*)(TB + (c4 * 4 + e) * 272 + 4 * kr) = pk;
                }
                __syncthreads();
                {
                    const int n = tid >> 4, k16 = (tid & 15) * 16;
                    const u32x4 o = *(const LAS u32x4*)(TB + n * 272 + k16);
                    *(u32x4*)(dst + (size_t)(n0 + n) * DM + bb * 256 + k16) = o;
                }
                __syncthreads();
            }
        }
    }
    if (a.sub & 4) {
        const int r = tid >> 4, c4 = tid & 15;
        f32x4 pv0, pv1;
        bf16_t* dst = (bf16_t*)(a.ws + WS_WTQ);
#define TR_LOAD(t_) do { const int kt_ = (t_) & 31, nt_ = (t_) >> 5; \
            pv0 = *(const f32x4*)(a.w_query + (size_t)(kt_ * 64 + r) * DM + nt_ * 64 + c4 * 4); pv1 = *(const f32x4*)(a.w_query + (size_t)(kt_ * 64 + r + 32) * DM + nt_ * 64 + c4 * 4); } while (0)
        const int NTILE = 1024;
        const int nskip = (int)gridDim.x > 64 ? (288 - (int)gridDim.x > 0 ? 288 - (int)gridDim.x : 0) : 0;
        const int tstart = (int)blockIdx.x - nskip, tstep = (int)gridDim.x - nskip;
        if (tstart >= 0 && tstart < NTILE) TR_LOAD(tstart);
        for (int t = tstart >= 0 ? tstart : NTILE; t < NTILE; t += tstep) {
            const int kt = t & 31, nt = t >> 5;
#pragma unroll
            for (int e = 0; e < 4; ++e) { TT[r * 65 + c4 * 4 + e] = pv0[e]; TT[(r + 32) * 65 + c4 * 4 + e] = pv1[e]; }
            __syncthreads();
            if (t + tstep < NTILE) TR_LOAD(t + tstep);
            {
                const int n = tid >> 3, k8 = (tid & 7) * 8;
                float f[8];
#pragma unroll
                for (int j = 0; j < 8; ++j) f[j] = TT[(k8 + j) * 65 + n];
                u32x4 w; w.x = pk_bf16(f[0], f[1]); w.y = pk_bf16(f[2], f[3]); w.z = pk_bf16(f[4], f[5]); w.w = pk_bf16(f[6], f[7]);
                *(u32x4*)(dst + (size_t)(nt * 64 + n) * DM + kt * 64 + k8) = w;
            }
            __syncthreads();
        }
#undef TR_LOAD
    }
    const int gt = blockIdx.x * 512 + tid, ngt = gridDim.x * 512;
    bf16_t* SUBK = (bf16_t*)(a.ws + WS_SUBK);
    for (int i = gt; i < 16 * 128 * 128 / 4; i += ngt) {
        const f32x4 v = *(const f32x4*)(a.sub_keys + (size_t)i * 4);
        u32x2 pk; pk.x = pk_bf16(v[0], v[1]); pk.y = pk_bf16(v[2], v[3]);
        const int c = (i * 4) & 127, n = ((i * 4) >> 7) & 127, hp = (i * 4) >> 14;
        *(u32x2*)(SUBK + ((size_t)(((hp * 4 + (n >> 5)) * 8 + (c >> 4)) * 64 + (n & 31) + 32 * ((c >> 3) & 1))) * 8 + (c & 7)) = pk;
    }
    bf16_t* MKV = (bf16_t*)(a.ws + WS_METAKV);
    for (int i = gt; i < 4 * 16 * 1024 / 8; i += ngt) {
        const int tsel = i / (16 * 1024 / 8), rem = i % (16 * 1024 / 8);
        *(u32x4*)(MKV + (size_t)tsel * 32 * 1024 + 16 * 1024 + (size_t)rem * 8) = (u32x4){0u, 0u, 0u, 0u};
    }
}

__device__ __forceinline__ void phase_cumf_meta(const Args& a, LAS unsigned char* lds) {
    const int tid = threadIdx.x, wid = tid >> 6, lane = tid & 63;
    const float* LCUM = (const float*)(a.ws + WS_LCUM); const float* CHT = (const float*)(a.ws + WS_CHT);
    float* CK2 = (float*)(a.ws + WS_CK2);
    for (int g = blockIdx.x; g < 256; g += gridDim.x) {
        if (wid == 0) {
            float pre[8];
#pragma unroll
            for (int h = 0; h < 8; ++h) { float p = 0.f; for (int c = lane; c < g; c += 64) p += CHT[c * 8 + h]; pre[h] = wave_sum(p) + CHT[256 * 8 + h]; }
            const int row = g * 64 + lane;
            const f32x4 l0 = *(const f32x4*)(LCUM + (size_t)row * 8), l1 = *(const f32x4*)(LCUM + (size_t)row * 8 + 4);
#pragma unroll
            for (int h = 0; h < 4; ++h) { CK2[(size_t)h * KPAD + row] = (pre[h] + l0[h]) * LOG2E; CK2[(size_t)(h + 4) * KPAD + row] = (pre[h + 4] + l1[h]) * LOG2E; }
        }
    }
    if (blockIdx.x == 0 && wid == 1 && lane < 32) {
#pragma unroll
        for (int h = 0; h < 8; ++h)
            CK2[(size_t)h * KPAD + S_ROWS + lane] = lane < NMETA ? LCUM[(size_t)(S_ROWS + lane) * 8 + h] * LOG2E : 1e30f;
    }
    const unsigned char* XN8 = (const unsigned char*)(a.ws + WS_XN); const unsigned char* WT8 = (const unsigned char*)(a.ws + WS_WTIN);
    const float* SA = (const float*)(a.ws + WS_SA); const float* SBI = (const float*)(a.ws + WS_SBIN);
    bf16_t* MKV = (bf16_t*)(a.ws + WS_METAKV);
    LAS int* PART = (LAS int*)lds;
    for (int cg = blockIdx.x; cg < 256; cg += gridDim.x) {
        const int tsel = cg >> 6, col = (cg & 63) * 16;
        const int nsrc = (tsel == 0 ? 1024 : tsel == 1 ? 2048 : tsel == 2 ? 4096 : 5120) + col;
        const int m = lane & 15, kq = lane >> 4;
        pg8::i32x4 acc = (pg8::i32x4){0, 0, 0, 0};
        const unsigned char* ap = XN8 + (size_t)(S_ROWS + m) * DM + wid * 256 + 16 * kq;
        const unsigned char* bp = WT8 + (size_t)(nsrc + m) * DM + wid * 256 + 16 * kq;
#pragma unroll
        for (int ks = 0; ks < 4; ++ks) {
            const pg8::i32x4 av = *(const pg8::i32x4*)(ap + 64 * ks), bv = *(const pg8::i32x4*)(bp + 64 * ks);
            acc = __builtin_amdgcn_mfma_i32_16x16x64_i8(av, bv, acc, 0, 0, 0);
        }
#pragma unroll
        for (int rg = 0; rg < 4; ++rg) PART[wid * 256 + (4 * kq + rg) * 16 + m] = acc[rg];
        __syncthreads();
        if (tid < 256) {
            int sI = 0;
#pragma unroll
            for (int w = 0; w < 8; ++w) sI += PART[w * 256 + tid];
            const int mm = tid >> 4, nn = tid & 15;
            const float val = (float)sI * SA[S_ROWS + mm] * SBI[nsrc + nn];
            MKV[(size_t)tsel * 32 * 1024 + (size_t)mm * 1024 + col + nn] = (bf16_t)(pk_bf16(val, 0.f) & 0xffffu);
        }
        __syncthreads();
    }
}

__device__ __forceinline__ void phase_ak(const Args& a) {
    const int tid = threadIdx.x, wid = tid >> 6, lane = tid & 63;
    bf16_t* FK = (bf16_t*)(a.ws + WS_PROJ + 4 * PROJ_T); bf16_t* MFK = (bf16_t*)(a.ws + WS_METAKV) + 2 * 32 * 1024;
    const int dcol = (lane & 7) * 16;
    f32x4 gk4[4];
#pragma unroll
    for (int q = 0; q < 4; ++q) gk4[q] = *(const f32x4*)(a.gk + dcol + 4 * q);
    for (int row = blockIdx.x * 8 + wid; row < S_ROWS + NMETA; row += gridDim.x * 8) {
        bf16_t* src = row < S_ROWS ? FK + (size_t)row * WID : MFK + (size_t)(row - S_ROWS) * WID;
        const u32x4 w0 = *(const u32x4*)(src + lane * 16), w1 = *(const u32x4*)(src + lane * 16 + 8);
        float f[16]; float ss = 0.f;
#pragma unroll
        for (int e = 0; e < 4; ++e) { f[2 * e] = bflo(w0[e]); f[2 * e + 1] = bfhi(w0[e]); f[8 + 2 * e] = bflo(w1[e]); f[9 + 2 * e] = bfhi(w1[e]); }
#pragma unroll
        for (int j = 0; j < 16; ++j) ss += f[j] * f[j];
        ss += __shfl_xor(ss, 1); ss += __shfl_xor(ss, 2); ss += __shfl_xor(ss, 4);
        const float rstd = rsqrtf(ss * (1.0f / 128.0f) + EPS);
        u32x4 o0, o1;
#pragma unroll
        for (int e = 0; e < 4; ++e) {
            o0[e] = pk_bf16((f[2 * e] * rstd) * gk4[e >> 1][(2 * e) & 3], (f[2 * e + 1] * rstd) * gk4[e >> 1][(2 * e + 1) & 3]);
            o1[e] = pk_bf16((f[8 + 2 * e] * rstd) * gk4[2 + (e >> 1)][(2 * e) & 3], (f[9 + 2 * e] * rstd) * gk4[2 + (e >> 1)][(2 * e + 1) & 3]);
        }
        *(u32x4*)(src + lane * 16) = o0; *(u32x4*)(src + lane * 16 + 8) = o1;
    }
}

__device__ __forceinline__ unsigned vimg_off(unsigned row, unsigned ch) { return 256u * row + 16u * (ch ^ (((row & 3u) << 2) | ((row >> 2) & 3u))); }
constexpr int AT_TILE = 16384 + 256;
constexpr int AT_STAGE = 2 * AT_TILE;
constexpr int AT_FLAGS = 2 * AT_STAGE;
constexpr int AT_TASK  = AT_FLAGS + 64;
constexpr int AT_RANK  = AT_TASK + 64;

template <bool FOX>
__device__ __forceinline__ void attn_unit(const Args& a, const int head, const int qb, LAS unsigned char* lds, const float zb2) {
    const int tid = threadIdx.x, wid = tid >> 6, lane = tid & 63;
    const int r = lane & 31, hh = lane >> 5;
    const int qt = 8 * qb + wid, q0 = qt * 32;
    const bf16_t* Qt = (const bf16_t*)(a.ws + WS_PROJ + (FOX ? 3 : 0) * PROJ_T);
    const bf16_t* Kt = (const bf16_t*)(a.ws + WS_PROJ + (FOX ? 4 : 1) * PROJ_T) + head * 128;
    const bf16_t* Vt = (const bf16_t*)(a.ws + WS_PROJ + (FOX ? 5 : 2) * PROJ_T) + head * 128;
    const bf16_t* MK = (const bf16_t*)(a.ws + WS_METAKV) + (FOX ? 2 : 0) * 32 * 1024 + head * 128;
    const bf16_t* MV = (const bf16_t*)(a.ws + WS_METAKV) + (FOX ? 3 : 1) * 32 * 1024 + head * 128;
    const float* CK2 = (const float*)(a.ws + WS_CK2) + (size_t)head * KPAD;
    volatile LAS int* flags = (volatile LAS int*)(lds + AT_FLAGS);
    bf16x8 qf[8];
    {
        const bf16_t* qp = Qt + (size_t)(q0 + r) * WID + head * 128 + 8 * hh;
        if (FOX) {
            bf16x8 raw[8]; float ss = 0.f;
#pragma unroll
            for (int k = 0; k < 8; ++k) {
                raw[k] = *(const bf16x8*)(qp + 16 * k);
#pragma unroll
                for (int j = 0; j < 8; ++j) { const float f = bf2f((unsigned short)raw[k][j]); ss += f * f; }
            }
            ss = pair_sum(ss);
            const float rstd = rsqrtf(ss * (1.0f / 128.0f) + EPS);
#pragma unroll
            for (int k = 0; k < 8; ++k) {
                const f32x4 g0 = *(const f32x4*)(a.gq + 16 * k + 8 * hh), g1 = *(const f32x4*)(a.gq + 16 * k + 8 * hh + 4);
                float y[8];
#pragma unroll
                for (int j = 0; j < 4; ++j) { y[j] = ((bf2f((unsigned short)raw[k][j]) * rstd) * g0[j]) * QSCALE2; y[4 + j] = ((bf2f((unsigned short)raw[k][4 + j]) * rstd) * g1[j]) * QSCALE2; }
                u32x4 w; w.x = pk_bf16(y[0], y[1]); w.y = pk_bf16(y[2], y[3]); w.z = pk_bf16(y[4], y[5]); w.w = pk_bf16(y[6], y[7]);
                qf[k] = __builtin_bit_cast(bf16x8, w);
            }
        } else {
#pragma unroll
            for (int k = 0; k < 8; ++k) {
                const bf16x8 raw = *(const bf16x8*)(qp + 16 * k);
                float y[8];
#pragma unroll
                for (int j = 0; j < 8; ++j) y[j] = bf2f((unsigned short)raw[j]) * QSCALE2;
                u32x4 w; w.x = pk_bf16(y[0], y[1]); w.y = pk_bf16(y[2], y[3]); w.z = pk_bf16(y[4], y[5]); w.w = pk_bf16(y[6], y[7]);
                qf[k] = __builtin_bit_cast(bf16x8, w);
            }
        }
    }
    f32x16 o[4];
#pragma unroll
    for (int dt = 0; dt < 4; ++dt)
#pragma unroll
        for (int i = 0; i < 16; ++i) o[dt][i] = 0.f;
    float lsum = 0.f, carry = FOX ? 0.f : 1.0f, mxrun = -1e30f;
    const float cq2 = FOX ? CK2[q0 + r] : 0.f;
    float sh = cq2;
    unsigned kra[8], trb[2], trx[4];
#pragma unroll
    for (int k = 0; k < 8; ++k) kra[k] = vimg_off((unsigned)r, (unsigned)(2 * k + hh));
    {
        const unsigned tq = (lane & 15) >> 2, tp = lane & 3, tblk = (lane >> 4) & 1;
#pragma unroll
        for (int jj = 0; jj < 2; ++jj) trb[jj] = 8192u + 256u * (8u * jj + 4u * hh + tq) + 16u * ((2u * tblk + (tp >> 1)) ^ (hh + 2u * jj)) + 8u * (tp & 1u);
#pragma unroll
        for (int dt = 0; dt < 4; ++dt) trx[dt] = 64u * ((unsigned)dt ^ tq);
    }
    const int lrow = 4 * wid + (lane >> 4);
    const unsigned goff = (unsigned)(lrow * WID + (lane & 15) * 8) * 2u;
    const unsigned soff = vimg_off((unsigned)lrow, (unsigned)(lane & 15));
    const int it_top = 8 * qb + 7;
    u32x4 rk0, rv0, rk1, rv1; float rc0 = 0.f, rc1 = 0.f;
#define AT_LOAD(pp_) do { const int pp__ = (pp_); \
        const bf16_t* kp_ = pp__ >= 0 ? Kt + (size_t)(2 * pp__ + 1) * 32 * WID : MK; const bf16_t* vp_ = pp__ >= 0 ? Vt + (size_t)(2 * pp__ + 1) * 32 * WID : MV; \
        rk0 = *(const u32x4*)((const char*)kp_ + goff); rv0 = *(const u32x4*)((const char*)vp_ + goff); \
        if (pp__ >= 0) { rk1 = *(const u32x4*)((const char*)(Kt + (size_t)(2 * pp__) * 32 * WID) + goff); rv1 = *(const u32x4*)((const char*)(Vt + (size_t)(2 * pp__) * 32 * WID) + goff); } \
        if (FOX && tid < 33) {     \
            const int i0_ = pp__ >= 0 ? (2 * pp__ + 1) * 32 : S_ROWS, i1_ = 2 * pp__ * 32; \
            rc0 = tid < 32 ? CK2[i0_ + tid] : (pp__ >= 0 ? CK2[i0_ - 1] : 0.f); \
            if (pp__ >= 0) rc1 = tid < 32 ? CK2[i1_ + tid] : (pp__ >= 1 ? CK2[i1_ - 1] : CK2[S_ROWS + NMETA - 1]); } } while (0)
#define AT_STORE(st_) do { LAS unsigned char* b_ = lds + (st_) * AT_STAGE + soff; \
        *(LAS u32x4*)b_ = rk0; *(LAS u32x4*)(b_ + 8192) = rv0; *(LAS u32x4*)(b_ + AT_TILE) = rk1; *(LAS u32x4*)(b_ + AT_TILE + 8192) = rv1; \
        if (FOX && tid < 33) { LAS float* c_ = (LAS float*)(lds + (st_) * AT_STAGE + 16384) + tid; c_[0] = rc0; c_[AT_TILE / 4] = rc1; } } while (0)
    if (lane == 0) flags[wid] = 0x7fffffff;
    const int pp_top = (it_top - 1) >> 1;
    rk1 = (u32x4){0u, 0u, 0u, 0u}; rv1 = rk1;
    AT_LOAD(pp_top); AT_STORE(0);
    AT_LOAD(pp_top - 1);
    bool done = false;
    int iter = 0;
    for (int pp = pp_top; pp >= -1; --pp, ++iter) {
        __syncthreads();
        {
            const int f0 = flags[0], f1 = flags[1], f2 = flags[2], f3 = flags[3], f4 = flags[4], f5 = flags[5], f6 = flags[6], f7 = flags[7];
            const int fm = max(max(max(f0, f1), max(f2, f3)), max(max(f4, f5), max(f6, f7)));
            if (fm < iter) break;
        }
        if (pp >= 0) AT_STORE((iter + 1) & 1);
        if (pp >= 1) AT_LOAD(pp - 2);
      if (FOX && !done && pp >= 0 && (2 * pp + 1) < qt) {
          LAS unsigned char* sb0 = lds + (iter & 1) * AT_STAGE; LAS unsigned char* sb1 = sb0 + AT_TILE;
          f32x16 st0, st1;
          {
              bf16x8 kf[8];
#pragma unroll
              for (int k = 0; k < 8; ++k) kf[k] = *(const LAS bf16x8*)(sb0 + kra[k]);
#pragma unroll
              for (int aa = 0; aa < 4; ++aa) { const f32x4 ck4 = *(const LAS f32x4*)(sb0 + 16384 + (8 * aa + 4 * hh) * 4);
#pragma unroll
                  for (int e = 0; e < 4; ++e) st0[4 * aa + e] = sh - ck4[e]; }
#pragma unroll
              for (int k = 0; k < 8; ++k) st0 = __builtin_amdgcn_mfma_f32_32x32x16_bf16(kf[k], qf[k], st0, 0, 0, 0);
          }
          {
              bf16x8 kg[8];
#pragma unroll
              for (int k = 0; k < 8; ++k) kg[k] = *(const LAS bf16x8*)(sb1 + kra[k]);
#pragma unroll
              for (int aa = 0; aa < 4; ++aa) { const f32x4 ck4 = *(const LAS f32x4*)(sb1 + 16384 + (8 * aa + 4 * hh) * 4);
#pragma unroll
                  for (int e = 0; e < 4; ++e) st1[4 * aa + e] = sh - ck4[e]; }
#pragma unroll
              for (int k = 0; k < 8; ++k) st1 = __builtin_amdgcn_mfma_f32_32x32x16_bf16(kg[k], qf[k], st1, 0, 0, 0);
          }
          __builtin_amdgcn_sched_barrier(0);
#pragma unroll
          for (int tl = 0; tl < 2; ++tl) {
              LAS unsigned char* sb = tl ? sb1 : sb0;
              float t[16];
#pragma unroll
              for (int i = 0; i < 16; ++i) t[i] = tl ? st1[i] : st0[i];
              float mx = t[0];
#pragma unroll
              for (int i = 1; i < 16; ++i) mx = fmaxf(mx, t[i]);
              mx = pair_max(mx);
              if (__any(mx > 8.0f)) {
                  const float shift = mx > 8.0f ? mx : 0.f;
                  const float alpha = ex2(-shift);
                  lsum *= alpha; sh -= shift; mxrun -= shift; mx -= shift;
#pragma unroll
                  for (int dt = 0; dt < 4; ++dt)
#pragma unroll
                      for (int i = 0; i < 16; ++i) o[dt][i] *= alpha;
#pragma unroll
                  for (int i = 0; i < 16; ++i) t[i] -= shift;
                  if (tl == 0) {
#pragma unroll
                      for (int i = 0; i < 16; ++i) st1[i] -= shift;
                  }
              }
              mxrun = fmaxf(mxrun, mx);
              float p[16]; float ps = 0.f;
#pragma unroll
              for (int i = 0; i < 16; ++i) { p[i] = ex2(t[i]); ps += p[i]; }
              lsum += ps;
              bf16x8 pb[2];
#pragma unroll
              for (int s2 = 0; s2 < 2; ++s2) {
                  u32x4 w; w.x = pk_bf16(p[8 * s2 + 0], p[8 * s2 + 1]); w.y = pk_bf16(p[8 * s2 + 2], p[8 * s2 + 3]); w.z = pk_bf16(p[8 * s2 + 4], p[8 * s2 + 5]); w.w = pk_bf16(p[8 * s2 + 6], p[8 * s2 + 7]);
                  pb[s2] = __builtin_bit_cast(bf16x8, w);
              }
              s16x4 tv[4][2][2];
#pragma unroll
              for (int dt = 0; dt < 4; ++dt)
#pragma unroll
                  for (int s2 = 0; s2 < 2; ++s2) {
                      tv[dt][s2][0] = __builtin_amdgcn_ds_read_tr16_b64_v4i16((LAS s16x4*)(sb + (trb[0] + trx[dt]) + 4096u * s2));
                      tv[dt][s2][1] = __builtin_amdgcn_ds_read_tr16_b64_v4i16((LAS s16x4*)(sb + (trb[1] + trx[dt]) + 4096u * s2));
                  }
#pragma unroll
              for (int dt = 0; dt < 4; ++dt)
#pragma unroll
                  for (int s2 = 0; s2 < 2; ++s2) {
                      const s16x4 t0 = tv[dt][s2][0], t1 = tv[dt][s2][1];
                      bf16x8 vf; vf[0] = t0[0]; vf[1] = t0[1]; vf[2] = t0[2]; vf[3] = t0[3]; vf[4] = t1[0]; vf[5] = t1[1]; vf[6] = t1[2]; vf[7] = t1[3];
                      o[dt] = __builtin_amdgcn_mfma_f32_32x32x16_bf16(vf, pb[s2], o[dt], 0, 0, 0);
                  }
          }
          {
              const float cnext = *(const LAS float*)(sb1 + 16384 + 128);
              if (__all((zb2 + sh - cnext - mxrun) < PRUNE_LOG2)) { done = true; if (lane == 0) flags[wid] = iter; }
          }
          continue;
      }
      for (int sub = 0; sub < 2; ++sub) {
        const int it = pp >= 0 ? 2 * pp + 1 - sub : -1;
        if (pp < 0 && sub == 1) break;
        const bool meta = it < 0, diag = it == qt;
        if (!done && (meta || it <= qt)) {
            LAS unsigned char* sb = lds + (iter & 1) * AT_STAGE + sub * AT_TILE;
            bf16x8 kf[8];
#pragma unroll
            for (int k = 0; k < 8; ++k) kf[k] = *(const LAS bf16x8*)(sb + kra[k]);
            f32x16 st;
            if (FOX) {
#pragma unroll
                for (int aa = 0; aa < 4; ++aa) {
                    const f32x4 ck4 = *(const LAS f32x4*)(sb + 16384 + (8 * aa + 4 * hh) * 4);
#pragma unroll
                    for (int e = 0; e < 4; ++e) st[4 * aa + e] = sh - ck4[e];
                }
            } else {
#pragma unroll
                for (int i = 0; i < 16; ++i) st[i] = 0.f;
            }
#pragma unroll
            for (int k = 0; k < 8; ++k) st = __builtin_amdgcn_mfma_f32_32x32x16_bf16(kf[k], qf[k], st, 0, 0, 0);
            float p[16];
            if (FOX) {
                float t[16];
#pragma unroll
                for (int i = 0; i < 16; ++i) t[i] = st[i];
                if (diag) {
#pragma unroll
                    for (int i = 0; i < 16; ++i) { const int kl = (i & 3) + 8 * (i >> 2) + 4 * hh; t[i] = kl > r ? -1e30f : t[i]; }
                }
                if (meta) {
#pragma unroll
                    for (int i = 0; i < 16; ++i) { const int kl = (i & 3) + 8 * (i >> 2) + 4 * hh; t[i] = kl >= NMETA ? -1e30f : t[i]; }
                }
                float mx = t[0];
#pragma unroll
                for (int i = 1; i < 16; ++i) mx = fmaxf(mx, t[i]);
                mx = pair_max(mx);
                if (__any(mx > 8.0f)) {
                    const float shift = mx > 8.0f ? mx : 0.f;
                    const float alpha = ex2(-shift);
                    lsum *= alpha; sh -= shift; mxrun -= shift; mx -= shift;
#pragma unroll
                    for (int dt = 0; dt < 4; ++dt)
#pragma unroll
                        for (int i = 0; i < 16; ++i) o[dt][i] *= alpha;
#pragma unroll
                    for (int i = 0; i < 16; ++i) t[i] -= shift;
                }
                mxrun = fmaxf(mxrun, mx);
                float ps = 0.f;
#pragma unroll
                for (int i = 0; i < 16; ++i) { p[i] = ex2(t[i]); ps += p[i]; }
                lsum += ps;
            } else {
                float be[16], om[16];
#pragma unroll
                for (int i = 0; i < 16; ++i) {
                    const float z = st[i];
                    const float u = ex2(-fabsf(z)), inv = __builtin_amdgcn_rcpf(1.0f + u), ui = u * inv;
                    be[i] = z >= 0.f ? inv : ui; om[i] = z >= 0.f ? ui : inv;
                }
                if (diag) {
#pragma unroll
                    for (int i = 0; i < 16; ++i) { const int kl = (i & 3) + 8 * (i >> 2) + 4 * hh; const bool vis = kl < r; be[i] = vis ? be[i] : 0.f; om[i] = vis ? om[i] : 1.0f; }
                }
                if (meta) {
#pragma unroll
                    for (int i = 0; i < 16; ++i) { const int kl = (i & 3) + 8 * (i >> 2) + 4 * hh; const bool vis = kl < NMETA; be[i] = vis ? be[i] : 0.f; om[i] = vis ? om[i] : 1.0f; }
                }
                float g[4], pg[4];
#pragma unroll
                for (int aa = 0; aa < 4; ++aa) g[aa] = (om[4 * aa + 3] * om[4 * aa + 2]) * (om[4 * aa + 1] * om[4 * aa]);
#pragma unroll
                for (int aa = 0; aa < 4; ++aa) pg[aa] = xhalf(g[aa]);
                float run = carry;
#pragma unroll
                for (int aa = 3; aa >= 0; --aa) {
                    const float gh1 = hh ? g[aa] : pg[aa];
                    const float off = hh ? run : run * gh1;
                    const float e3 = off, e2 = off * om[4 * aa + 3], e1 = e2 * om[4 * aa + 2], e0 = e1 * om[4 * aa + 1];
                    p[4 * aa + 3] = be[4 * aa + 3] * e3; p[4 * aa + 2] = be[4 * aa + 2] * e2;
                    p[4 * aa + 1] = be[4 * aa + 1] * e1; p[4 * aa + 0] = be[4 * aa + 0] * e0;
                    run *= g[aa] * pg[aa];
                }
                carry = run;
            }
            bf16x8 pb[2];
#pragma unroll
            for (int s = 0; s < 2; ++s) {
                u32x4 w; w.x = pk_bf16(p[8 * s + 0], p[8 * s + 1]); w.y = pk_bf16(p[8 * s + 2], p[8 * s + 3]); w.z = pk_bf16(p[8 * s + 4], p[8 * s + 5]); w.w = pk_bf16(p[8 * s + 6], p[8 * s + 7]);
                pb[s] = __builtin_bit_cast(bf16x8, w);
            }
            s16x4 tv[4][2][2];
#pragma unroll
            for (int dt = 0; dt < 4; ++dt)
#pragma unroll
                for (int s = 0; s < 2; ++s) {
                    tv[dt][s][0] = __builtin_amdgcn_ds_read_tr16_b64_v4i16((LAS s16x4*)(sb + (trb[0] + trx[dt]) + 4096u * s));
                    tv[dt][s][1] = __builtin_amdgcn_ds_read_tr16_b64_v4i16((LAS s16x4*)(sb + (trb[1] + trx[dt]) + 4096u * s));
                }
#pragma unroll
            for (int dt = 0; dt < 4; ++dt) {
#pragma unroll
                for (int s = 0; s < 2; ++s) {
                    const s16x4 t0 = tv[dt][s][0], t1 = tv[dt][s][1];
                    bf16x8 vf; vf[0] = t0[0]; vf[1] = t0[1]; vf[2] = t0[2]; vf[3] = t0[3]; vf[4] = t1[0]; vf[5] = t1[1]; vf[6] = t1[2]; vf[7] = t1[3];
                    o[dt] = __builtin_amdgcn_mfma_f32_32x32x16_bf16(vf, pb[s], o[dt], 0, 0, 0);
                }
            }
            bool fin = meta;
            if (!meta) {
                if (FOX) {
                    const float cnext = *(const LAS float*)(sb + 16384 + 128);
                    fin = __all((zb2 + sh - cnext - mxrun) < PRUNE_LOG2);
                } else {
                    fin = __all(carry < 5.421010862427522e-20f);
                }
            }
            if (fin) { done = true; if (lane == 0) flags[wid] = iter; }
        }
      }
    }
#undef AT_LOAD
#undef AT_STORE
    if (FOX) {
        lsum = pair_sum(lsum);
        const float inv = 1.0f / lsum;
#pragma unroll
        for (int dt = 0; dt < 4; ++dt)
#pragma unroll
            for (int i = 0; i < 16; ++i) o[dt][i] *= inv;
    }
    float sq = 0.f;
#pragma unroll
    for (int dt = 0; dt < 4; ++dt)
#pragma unroll
        for (int i = 0; i < 16; ++i) sq += o[dt][i] * o[dt][i];
    sq = pair_sum(sq);
    float* SQ = (float*)(a.ws + WS_SQ) + (FOX ? (size_t)S_ROWS * 8 : 0);
    if (hh == 0) SQ[(size_t)(q0 + r) * 8 + head] = sq;
    bf16_t* Ot = (bf16_t*)(a.ws + WS_ATT + (FOX ? PROJ_T : 0)) + (size_t)(q0 + r) * WID + head * 128 + 4 * hh;
#pragma unroll
    for (int dt = 0; dt < 4; ++dt)
#pragma unroll
        for (int aa = 0; aa < 4; ++aa) {
            u32x2 w; w.x = pk_bf16(o[dt][4 * aa], o[dt][4 * aa + 1]); w.y = pk_bf16(o[dt][4 * aa + 2], o[dt][4 * aa + 3]);
            *(u32x2*)(Ot + 32 * dt + 8 * aa) = w;
        }
    __syncthreads();
}

__device__ __forceinline__ void phase_attn(const Args& a, LAS unsigned char* lds) {
    const int tid = threadIdx.x, lane = tid & 63;
    unsigned* qctr = (unsigned*)(a.ws + WS_CTL) + QCTR_WORD;
    volatile LAS int* taskw = (volatile LAS int*)(lds + AT_TASK);
    volatile LAS int* rankw = (volatile LAS int*)(lds + AT_RANK);
    float gmq = wave_max(fmaxf(fabsf(a.gq[lane]), fabsf(a.gq[lane + 64])));
    float gmk = wave_max(fmaxf(fabsf(a.gk[lane]), fabsf(a.gk[lane + 64])));
    const float zb2 = 128.0f * gmq * gmk * QSCALE2 * 1.02f;
    if (tid < 8) {
        const float bh = a.b_forget[tid]; int rank = 0;
#pragma unroll
        for (int j = 0; j < 8; ++j) { const float bj = a.b_forget[j]; rank += (bj > bh || (bj == bh && j < tid)) ? 1 : 0; }
        rankw[rank] = tid;
    }
    for (;;) {
        __syncthreads();
        if (tid == 0) taskw[0] = (int)__hip_atomic_fetch_add(qctr, 1u, __ATOMIC_RELAXED, __HIP_MEMORY_SCOPE_AGENT);
        __syncthreads();
        const int T = taskw[0];
        if (T >= 1024) break;
        if (T < 512) attn_unit<true>(a, rankw[T >> 6], 63 - (T & 63), lds, zb2);
        else { const int U = T - 512; attn_unit<false>(a, U & 7, 63 - (U >> 3), lds, zb2); }
        if ((T & 1) == 0) quant_rows(a, (T >> 1) * 64, (T >> 1) * 64 + 64);
    }
}

__device__ __forceinline__ void phase_merge(const Args& a) {
    const int tid = threadIdx.x, wid = tid >> 6, lane = tid & 63;
    const bf16_t* SBO = (const bf16_t*)(a.ws + WS_ATT); const bf16_t* FOXO = (const bf16_t*)(a.ws + WS_ATT + PROJ_T);
    const bf16_t* FG = (const bf16_t*)(a.ws + WS_PROJ + 6 * PROJ_T);
    const float* SBSQ = (const float*)(a.ws + WS_SQ); const float* FOXSQ = SBSQ + (size_t)S_ROWS * 8;
    unsigned char* MG8 = (unsigned char*)(a.ws + WS_MERGED); float* SM = (float*)(a.ws + WS_SM);
    const bool fox = lane >= 32; const int c0 = (lane & 31) * 32;
    f32x4 gn[8];
#pragma unroll
    for (int q = 0; q < 8; ++q) gn[q] = *(const f32x4*)((fox ? a.g_fox : a.g_sb) + c0 + 4 * q);
    for (int row = blockIdx.x * 8 + wid; row < S_ROWS; row += gridDim.x * 8) {
        const float* sqp = (fox ? FOXSQ : SBSQ) + (size_t)row * 8;
        const f32x4 s0 = *(const f32x4*)sqp, s1 = *(const f32x4*)(sqp + 4);
        const float rstd = rsqrtf(((s0[0] + s0[1]) + (s0[2] + s0[3]) + (s1[0] + s1[1]) + (s1[2] + s1[3])) * (1.0f / WID) + EPS);
        const bf16_t* op = (fox ? FOXO : SBO) + (size_t)row * WID + c0;
        u32x4 ov[4], gv[4];
#pragma unroll
        for (int q = 0; q < 4; ++q) ov[q] = *(const u32x4*)(op + 8 * q);
        if (fox) {
#pragma unroll
            for (int q = 0; q < 4; ++q) gv[q] = *(const u32x4*)(FG + (size_t)row * WID + c0 + 8 * q);
        }
        float y[32]; float am = 0.f;
#pragma unroll
        for (int q = 0; q < 4; ++q)
#pragma unroll
            for (int e = 0; e < 4; ++e) {
                const int j = 8 * q + 2 * e;
                y[j] = (bflo(ov[q][e]) * rstd) * gn[j >> 2][j & 3]; y[j + 1] = (bfhi(ov[q][e]) * rstd) * gn[(j + 1) >> 2][(j + 1) & 3];
                if (fox) { y[j] *= 1.0f / (1.0f + __expf(-bflo(gv[q][e]))); y[j + 1] *= 1.0f / (1.0f + __expf(-bfhi(gv[q][e]))); }
                am = fmaxf(am, fmaxf(fabsf(y[j]), fabsf(y[j + 1])));
            }
        am = wave_max(am);
        const float qi = am > 0.f ? 127.0f / am : 0.f;
        u32x4 o0, o1;
#pragma unroll
        for (int w = 0; w < 4; ++w) {
            unsigned p0 = 0u, p1 = 0u;
#pragma unroll
            for (int b = 0; b < 4; ++b) { p0 |= ((unsigned)(int)rintf(y[4 * w + b] * qi) & 0xffu) << (8 * b); p1 |= ((unsigned)(int)rintf(y[16 + 4 * w + b] * qi) & 0xffu) << (8 * b); }
            o0[w] = p0; o1[w] = p1;
        }
        unsigned char* dp = MG8 + (size_t)row * DM + (fox ? WID : 0) + c0;
        *(u32x4*)dp = o0; *(u32x4*)(dp + 16) = o1;
        if (lane == 0) SM[row] = am * (1.0f / 127.0f);
    }
}

struct EpiInI8 {
    static constexpr bool PERM = true, AFTER_DRAIN = false; typedef pg8::i32x4 AccT;
    bf16_t* O; const float* sa; const float* sb;
    __device__ __forceinline__ void operator()(const pg8::i32x4 (&acc)[2][2][4][2], const pg8::Unit& u, int wr, int wc, int fr, int fq) const {
        const int row0 = u.pm * 256 + wr * 64 + fr; const int ctile = u.pn * 256;
        const int t = ctile >> 10; bf16_t* base = O + (size_t)t * S_ROWS * WID; const int colt = ctile - (t << 10);
        const int col0 = colt + wc * 32 + 8 * fq, gcol0 = ctile + wc * 32 + 8 * fq;
        f32x4 sb0[2], sb1[2];
#pragma unroll
        for (int bj = 0; bj < 2; ++bj) { sb0[bj] = *(const f32x4*)(sb + gcol0 + bj * 128); sb1[bj] = *(const f32x4*)(sb + gcol0 + bj * 128 + 4); }
#pragma unroll
        for (int ai = 0; ai < 2; ++ai)
#pragma unroll
            for (int m = 0; m < 4; ++m) {
                const int row = row0 + ai * 128 + m * 16; const float rs = sa[row];
                bf16_t* rowp = base + (size_t)row * WID + col0;
#pragma unroll
                for (int bj = 0; bj < 2; ++bj) {
                    const pg8::i32x4 v0 = acc[ai][bj][m][0], v1 = acc[ai][bj][m][1];
                    u32x4 w;
                    w.x = pk_bf16((float)v0[0] * rs * sb0[bj][0], (float)v0[1] * rs * sb0[bj][1]); w.y = pk_bf16((float)v0[2] * rs * sb0[bj][2], (float)v0[3] * rs * sb0[bj][3]);
                    w.z = pk_bf16((float)v1[0] * rs * sb1[bj][0], (float)v1[1] * rs * sb1[bj][1]); w.w = pk_bf16((float)v1[2] * rs * sb1[bj][2], (float)v1[3] * rs * sb1[bj][3]);
                    *(u32x4*)(rowp + bj * 128) = w;
                }
            }
    }
};
constexpr int EPI_LDS = pg8::STAGE_BYTES, EPI_WAVE = 16 * 144;
struct EpiOut {
    static constexpr bool PERM = true, AFTER_DRAIN = false; typedef pg8::i32x4 AccT;
    const float* X; bf16_t* H1G; const float* gffn; float* rowsq; const float* sm; const float* sb; LAS unsigned char* eb;
    __device__ __forceinline__ void operator()(const pg8::i32x4 (&acc)[2][2][4][2], const pg8::Unit& u, int wr, int wc, int fr, int fq) const {
        const int lane = threadIdx.x & 63; LAS unsigned char* ws_ = eb + (threadIdx.x >> 6) * EPI_WAVE;
        const int row0 = u.pm * 256 + wr * 64 + fr, col0 = u.pn * 256 + wc * 32 + 8 * fq;
        const float* xq = X + (size_t)(u.pm * 256 + wr * 64 + (lane >> 2)) * DM + u.pn * 256 + wc * 32 + (lane & 3) * 4;
        LAS unsigned char* wp_ = ws_ + (lane >> 2) * 144 + (lane & 3) * 16; const LAS unsigned char* rp_ = ws_ + fr * 144 + fq * 32;
        f32x4 xa[4];
#pragma unroll
        for (int q = 0; q < 4; ++q) xa[q] = *(const f32x4*)(xq + (q >> 1) * 128 + (q & 1) * 16);
#pragma unroll
        for (int ai = 0; ai < 2; ++ai)
#pragma unroll
            for (int m = 0; m < 4; ++m) {
                const int row = row0 + ai * 128 + m * 16; float ss = 0.f; const float rs = sm[row];
                f32x4 xc[4];
#pragma unroll
                for (int q = 0; q < 4; ++q) xc[q] = xa[q];
                if (ai * 4 + m < 7) { const int nx = ai * 4 + m + 1; const float* xn = xq + (size_t)((nx >> 2) * 128 + (nx & 3) * 16) * DM;
#pragma unroll
                    for (int q = 0; q < 4; ++q) xa[q] = *(const f32x4*)(xn + (q >> 1) * 128 + (q & 1) * 16); }
#pragma unroll
                for (int bj = 0; bj < 2; ++bj) {
                    const int c = col0 + bj * 128;
                    *(LAS f32x4*)(wp_) = xc[2 * bj]; *(LAS f32x4*)(wp_ + 64) = xc[2 * bj + 1];
                    const f32x4 x0 = *(const LAS f32x4*)(rp_), x1 = *(const LAS f32x4*)(rp_ + 16);
                    const f32x4 g0 = *(const f32x4*)(gffn + c), g1 = *(const f32x4*)(gffn + c + 4);
                    const f32x4 b0 = *(const f32x4*)(sb + c), b1 = *(const f32x4*)(sb + c + 4);
                    const pg8::i32x4 a0 = acc[ai][bj][m][0], a1 = acc[ai][bj][m][1];
                    f32x4 h0, h1;
#pragma unroll
                    for (int e = 0; e < 4; ++e) { h0[e] = (float)a0[e] * rs * b0[e] + x0[e]; h1[e] = (float)a1[e] * rs * b1[e] + x1[e]; }
                    ss += (h0[0] * h0[0] + h0[1] * h0[1]) + (h0[2] * h0[2] + h0[3] * h0[3]) + (h1[0] * h1[0] + h1[1] * h1[1]) + (h1[2] * h1[2] + h1[3] * h1[3]);
                    u32x4 w; w.x = pk_bf16(h0[0] * g0[0], h0[1] * g0[1]); w.y = pk_bf16(h0[2] * g0[2], h0[3] * g0[3]);
                    w.z = pk_bf16(h1[0] * g1[0], h1[1] * g1[1]); w.w = pk_bf16(h1[2] * g1[2], h1[3] * g1[3]);
                    *(u32x4*)(H1G + (size_t)row * DM + c) = w;
                }
                ss += __shfl_xor(ss, 16); ss += __shfl_xor(ss, 32);
                if (fq == 0) rowsq[(size_t)row * 32 + u.pn * 4 + wc] = ss;
            }
    }
};

__device__ __forceinline__ float row_rstd2(const float* ROWSQ, int row) {
    const float* p = ROWSQ + (size_t)row * 32; float s = 0.f;
#pragma unroll
    for (int j = 0; j < 8; ++j) { const f32x4 v = *(const f32x4*)(p + 4 * j); s += (v[0] + v[1]) + (v[2] + v[3]); }
    return rsqrtf(s * (1.0f / DM) + EPS);
}

__device__ __forceinline__ float gelu1(float v) {
    const float av = fabsf(v), t = __builtin_amdgcn_rcpf(av * 0.2316418882f + 1.0f);
    float q = t * 0.5307027145f + (-0.7265760135f); q = q * t + 0.7107068705f; q = q * t + (-0.142248368f); q = q * t + 0.127414796f; q = q * t;
    const float m = v * (q * __builtin_amdgcn_exp2f((v * v) * (-0.72134752044f)));
    return v < 0.f ? m : v - m;
}
__device__ __forceinline__ float wave_fsum(float v) {
    v += __uint_as_float((unsigned)__builtin_amdgcn_update_dpp(0, (int)__float_as_uint(v), 0xB1, 0xF, 0xF, true));
    v += __uint_as_float((unsigned)__builtin_amdgcn_update_dpp(0, (int)__float_as_uint(v), 0x4E, 0xF, 0xF, true));
    v += __uint_as_float((unsigned)__builtin_amdgcn_update_dpp(0, (int)__float_as_uint(v), 0x141, 0xF, 0xF, true));
    v += __uint_as_float((unsigned)__builtin_amdgcn_update_dpp(0, (int)__float_as_uint(v), 0x140, 0xF, 0xF, true));
    v += __uint_as_float((unsigned)__builtin_amdgcn_update_dpp(0, (int)__float_as_uint(v), 0x142, 0xA, 0xF, true));
    v += __uint_as_float((unsigned)__builtin_amdgcn_update_dpp(0, (int)__float_as_uint(v), 0x143, 0xC, 0xF, true));
    return __uint_as_float((unsigned)__builtin_amdgcn_readlane((int)__float_as_uint(v), 63));
}
constexpr int UP_RSH = 10, UP_NR = 16384 >> UP_RSH;
#ifndef UP_AUX
#define UP_AUX 0
#endif
constexpr int UP_HQW = 8448;
constexpr int L7_IB = 0, L7_EID = 16384, L7_GL = L7_EID + 8192, L7_HQ = L7_GL + 16384, L7_LIST = L7_HQ + 8 * UP_HQW, L7_HIST = L7_LIST + 16384, L7_BASE = L7_HIST + 2048, L7_XS = L7_BASE + 2048, L7_END = L7_XS + 128;
static_assert(L7_END <= LDS_BYTES - 16 && UP_NR <= 64, "phase 7 LDS map");
static_assert(EPI_LDS + 8 * EPI_WAVE <= LDS_BYTES - 16, "epilogue scratch");
typedef int i32x8 __attribute__((ext_vector_type(8)));
#define WFENCE() asm volatile("s_waitcnt lgkmcnt(0)" ::: "memory")
__device__ __forceinline__ int up_tokoff(int t) { return t * 2048 + (t & 1) * 16 + (t >> 1) * 128; }
template <int OPS> __device__ __forceinline__ f32x4 mx_step(const u32x4 av4, const u32x4 b0, const u32x4 b1, const f32x4 c, const unsigned sc) {
    const i32x8 av = {(int)av4[0], (int)av4[1], (int)av4[2], (int)av4[3], 0, 0, 0, 0};
    const i32x8 bv = {(int)b0[0], (int)b0[1], (int)b0[2], (int)b0[3], (int)b1[0], (int)b1[1], (int)b1[2], (int)b1[3]};
    return __builtin_amdgcn_mfma_scale_f32_16x16x128_f8f6f4(av, bv, c, 4, 0, OPS, (int)sc, 0, 0x7f7f7f7f);
}
__device__ __forceinline__ float quad_sum(float v) {
    v += __uint_as_float((unsigned)__builtin_amdgcn_update_dpp(0, (int)__float_as_uint(v), 0xB1, 0xF, 0xF, true));
    v += __uint_as_float((unsigned)__builtin_amdgcn_update_dpp(0, (int)__float_as_uint(v), 0x4E, 0xF, 0xF, true));
    return v;
}
__device__ __forceinline__ void gather_u_tile(const Args& a, LAS unsigned char* lds, const int tok0) {
    const int tid = threadIdx.x, wid = __builtin_amdgcn_readfirstlane(tid >> 6), lane = tid & 63;
    const int li = lane & 15, lb = lane >> 4;
    const bf16_t* H1G = (const bf16_t*)(a.ws + WS_H1G); const float* ROWSQ = (const float*)(a.ws + WS_ROWSQ);
    const unsigned char* U4 = (const unsigned char*)(a.ws + WS_U8); const unsigned char* SUE = (const unsigned char*)(a.ws + WS_SU4);
    const float* SV = (const float*)(a.ws + WS_SV);
    float* COEF = (float*)(a.ws + WS_COEF); float* CSUMP = (float*)(a.ws + WS_XS);
    LAS unsigned char* hqw = lds + L7_HQ + wid * UP_HQW;
    LAS float* glw = (LAS float*)(lds + L7_GL + wid * 2048);
    LAS const unsigned short* eidw = (LAS const unsigned short*)(lds + L7_EID + wid * 1024);
    LAS unsigned* listw = (LAS unsigned*)(lds + L7_LIST + wid * 2048);
    LAS unsigned* histw = (LAS unsigned*)(lds + L7_HIST + wid * 256);
    LAS unsigned* basew = (LAS unsigned*)(lds + L7_BASE + wid * 256);
    LAS float* xsw = (LAS float*)(lds + L7_XS + wid * 16);
    {
        u32x4 hr[4][4];
#pragma unroll
        for (int tl = 0; tl < 4; ++tl)
#pragma unroll
            for (int q = 0; q < 4; ++q) hr[tl][q] = *(const u32x4*)(H1G + (size_t)(tok0 + 4 * wid + tl) * DM + lane * 32 + 8 * q);
#pragma unroll
        for (int tl = 0; tl < 4; ++tl) {
            const int tok = tok0 + 4 * wid + tl;
            float f[32]; float am = 0.f;
#pragma unroll
            for (int q = 0; q < 4; ++q)
#pragma unroll
                for (int e = 0; e < 4; ++e) { f[8 * q + 2 * e] = bflo(hr[tl][q][e]); f[8 * q + 2 * e + 1] = bfhi(hr[tl][q][e]); }
#pragma unroll
            for (int j = 0; j < 32; ++j) am = fmaxf(am, fabsf(f[j]));
            am = wave_max(am);
            const float inv = am > 0.f ? 256.0f / am : 0.f;
            u32x4 h0, h1;
#pragma unroll
            for (int w = 0; w < 8; ++w) {
                int pk = 0;
                pk = __builtin_amdgcn_cvt_pk_fp8_f32(f[4 * w] * inv, f[4 * w + 1] * inv, pk, false);
                pk = __builtin_amdgcn_cvt_pk_fp8_f32(f[4 * w + 2] * inv, f[4 * w + 3] * inv, pk, true);
                if (w < 4) h0[w] = (unsigned)pk; else h1[w - 4] = (unsigned)pk;
            }
            *(LAS u32x4*)(hqw + up_tokoff(tl) + lane * 32) = h0; *(LAS u32x4*)(hqw + up_tokoff(tl) + lane * 32 + 16) = h1;
            const float xs = row_rstd2(ROWSQ, tok) * (am * (1.0f / 256.0f));
            if (lane == 0) xsw[tl] = xs;
        }
    }
    if (lane < UP_NR) histw[lane] = 0u;
    WFENCE();
    {
        const int tl_l = lane >> 4, s0 = 8 * (lane & 15);
        const u32x4 ev = *(LAS const u32x4*)(eidw + tl_l * 128 + s0);
        unsigned it[8], pos[8];
#pragma unroll
        for (int i = 0; i < 8; ++i) {
            const unsigned e = (ev[i >> 1] >> (16 * (i & 1))) & 0xffffu;
            it[i] = e | ((unsigned)tl_l << 14) | ((unsigned)(s0 + i) << 16);
            pos[i] = __hip_atomic_fetch_add(histw + (e >> UP_RSH), 1u, __ATOMIC_RELAXED, __HIP_MEMORY_SCOPE_WORKGROUP);
        }
        WFENCE();
        const unsigned c = lane < UP_NR ? histw[lane] : 0u; unsigned inc = c;
#pragma unroll
        for (int d = 1; d < UP_NR; d <<= 1) { const unsigned t = (unsigned)__shfl_up((int)inc, d); inc += (lane >= d) ? t : 0u; }
        if (lane < UP_NR) basew[lane] = inc - c;
        WFENCE();
#pragma unroll
        for (int i = 0; i < 8; ++i) listw[basew[(it[i] & 0x3fffu) >> UP_RSH] + pos[i]] = it[i];
        WFENCE();
    }
    {
        LAS const unsigned char* hb = hqw + up_tokoff(li >> 2) + (lb >> 1) * 128 + (li & 3) * 32 + (lb & 1) * 16;
        LAS float* zbuf = (LAS float*)basew;
        LAS float* dummyw = (LAS float*)histw + lane;
        const int emask = (a.sub & 512) ? 1023 : 0x3fff;
        const unsigned rowoff = (unsigned)lb * 64u + (unsigned)(li & 3) * 16u;
        const unsigned scoff = ((unsigned)lb * 4u + (unsigned)(li & 3)) * 4u;
        const int gq = li >> 2;
        const bool wlane = (lane & 3) == 0; const int rtok = (lane >> 2) & 3;
        const __amdgpu_buffer_rsrc_t urs = __builtin_amdgcn_make_buffer_rsrc((void*)U4, 0, 16384 * 1024, 0x00020000);
        u32x4 aA[16], aB[16]; unsigned scA[4], scB[4];
#define PU_LOAD(AA, SC, t_) do { \
            _Pragma("unroll") for (int T = 0; T < 4; ++T) { const int e_ = (int)(listw[16 * (t_) + 4 * T + gq] & 0x3fffu) & emask; \
                const unsigned ro_ = (unsigned)e_ * 1024u + rowoff; \
                SC[T] = *(const unsigned*)(SUE + (size_t)e_ * 64 + scoff); \
                _Pragma("unroll") for (int m = 0; m < 4; ++m) AA[4 * T + m] = __builtin_amdgcn_raw_buffer_load_b128(urs, ro_ + m * 256, 0, UP_AUX); } } while (0)
#define PU_STEP(m_, bx0, bx1, nx0, nx1, AA, SC) do { \
            nx0 = *(LAS const u32x4*)(hb + (((m_) + 1) & 3) * 512); nx1 = *(LAS const u32x4*)(hb + (((m_) + 1) & 3) * 512 + 256); \
            c0 = mx_step<m_>(AA[(m_)], bx0, bx1, c0, SC[0]); c1 = mx_step<m_>(AA[4 + (m_)], bx0, bx1, c1, SC[1]); \
            c2 = mx_step<m_>(AA[8 + (m_)], bx0, bx1, c2, SC[2]); c3 = mx_step<m_>(AA[12 + (m_)], bx0, bx1, c3, SC[3]); } while (0)
#define PU_COMPUTE(AA, SC, t_) do { \
            f32x4 c0 = {0.f, 0.f, 0.f, 0.f}, c1 = c0, c2 = c0, c3 = c0; \
            u32x4 p0 = *(LAS const u32x4*)(hb), p1 = *(LAS const u32x4*)(hb + 256), q0, q1; \
            PU_STEP(0, p0, p1, q0, q1, AA, SC); PU_STEP(1, q0, q1, p0, p1, AA, SC); PU_STEP(2, p0, p1, q0, q1, AA, SC); PU_STEP(3, q0, q1, p0, p1, AA, SC); \
            const unsigned wq_ = listw[16 * (t_) + lb], wq1_ = listw[16 * (t_) + 4 + lb], wq2_ = listw[16 * (t_) + 8 + lb], wq3_ = listw[16 * (t_) + 12 + lb];     \
            const unsigned wi_ = listw[16 * (t_) + li]; \
            _Pragma("unroll") for (int T = 0; T < 4; ++T) { \
                const f32x4 cc = T == 0 ? c0 : T == 1 ? c1 : T == 2 ? c2 : c3; const unsigned w_ = T == 0 ? wq_ : T == 1 ? wq1_ : T == 2 ? wq2_ : wq3_; \
                const float d_ = (lane & 2) ? ((lane & 1) ? cc[3] : cc[2]) : ((lane & 1) ? cc[1] : cc[0]);                   \
                const float x_ = quad_sum(d_); \
                LAS float* dst_ = (wlane && rtok == (int)((w_ >> 14) & 3u)) ? (zbuf + 4 * T + lb) : dummyw; \
                *dst_ = x_; } \
            { const int tl_ = (int)(wi_ >> 14) & 3, sl_ = (int)(wi_ >> 16) & 127; \
              const float cf = glw[tl_ * 128 + sl_] * gelu1(xsw[tl_] * zbuf[li]); \
              glw[tl_ * 128 + sl_] = cf; } } while (0)
        PU_LOAD(aA, scA, 0);
        __builtin_amdgcn_sched_barrier(0);
#pragma unroll 1
        for (int t = 0; t < 30; t += 2) {
            PU_LOAD(aB, scB, t + 1);
            __builtin_amdgcn_sched_barrier(0);
            PU_COMPUTE(aA, scA, t);
            __builtin_amdgcn_sched_barrier(0);
            PU_LOAD(aA, scA, t + 2);
            __builtin_amdgcn_sched_barrier(0);
            PU_COMPUTE(aB, scB, t + 1);
            __builtin_amdgcn_sched_barrier(0);
        }
        PU_LOAD(aB, scB, 31);
        __builtin_amdgcn_sched_barrier(0);
        PU_COMPUTE(aA, scA, 30);
        __builtin_amdgcn_sched_barrier(0);
        PU_COMPUTE(aB, scB, 31);
#undef PU_LOAD
#undef PU_COMPUTE
#undef PU_STEP
    }
    WFENCE();
    {
        float sv0[4], sv1[4];
#pragma unroll
        for (int tl = 0; tl < 4; ++tl) { sv0[tl] = SV[eidw[tl * 128 + lane]]; sv1[tl] = SV[eidw[tl * 128 + 64 + lane]]; }
#pragma unroll
        for (int tl = 0; tl < 4; ++tl) {
            const int tok = tok0 + 4 * wid + tl;
            const float cv0 = glw[tl * 128 + lane] * sv0[tl], cv1 = glw[tl * 128 + 64 + lane] * sv1[tl];
            const float cm = wave_max(fmaxf(fabsf(cv0), fabsf(cv1)));
            const float inv = cm > 0.f ? 127.0f / cm : 0.f;
            signed char* cq = (signed char*)COEF + (size_t)tok * 128;
            if (a.sub & 256) continue;
            const int q0 = (int)rintf(cv0 * inv), q1 = (int)rintf(cv1 * inv);
            cq[lane] = (signed char)q0; cq[64 + lane] = (signed char)q1;
            const int qs = wave_isum(q0 + q1);
            if (lane == 0) { CSUMP[2 * tok] = cm * (1.0f / 127.0f); CSUMP[2 * tok + 1] = (float)(8 * qs); }
        }
    }
}

__device__ __forceinline__ unsigned fkey(float s) { const unsigned u = __float_as_uint(s); return u ^ ((unsigned)((int)u >> 31) | 0x80000000u); }
__device__ __forceinline__ float fval(unsigned k) { const unsigned u = (k & 0x80000000u) ? (k & 0x7fffffffu) : ~k; return __uint_as_float(u); }
#define CE(x_, y_) do { const unsigned hi_ = (x_) > (y_) ? (x_) : (y_); const unsigned lo_ = (x_) > (y_) ? (y_) : (x_); (x_) = hi_; (y_) = lo_; } while (0)
#define S16_NET(v) do { CE(v[0], v[1]); CE(v[2], v[3]); CE(v[0], v[2]); CE(v[1], v[3]); CE(v[1], v[2]); CE(v[4], v[5]); CE(v[6], v[7]); CE(v[4], v[6]); CE(v[5], v[7]); CE(v[5], v[6]); CE(v[0], v[4]); CE(v[2], v[6]); CE(v[2], v[4]); CE(v[1], v[5]); CE(v[3], v[7]); CE(v[3], v[5]); CE(v[1], v[2]); CE(v[3], v[4]); CE(v[5], v[6]); CE(v[8], v[9]); CE(v[10], v[11]); CE(v[8], v[10]); CE(v[9], v[11]); CE(v[9], v[10]); CE(v[12], v[13]); CE(v[14], v[15]); CE(v[12], v[14]); CE(v[13], v[15]); CE(v[13], v[14]); CE(v[8], v[12]); CE(v[10], v[14]); CE(v[10], v[12]); CE(v[9], v[13]); CE(v[11], v[15]); CE(v[11], v[13]); CE(v[9], v[10]); CE(v[11], v[12]); CE(v[13], v[14]); CE(v[0], v[8]); CE(v[4], v[12]); CE(v[4], v[8]); CE(v[2], v[10]); CE(v[6], v[14]); CE(v[6], v[10]); CE(v[2], v[4]); CE(v[6], v[8]); CE(v[10], v[12]); CE(v[1], v[9]); CE(v[5], v[13]); CE(v[5], v[9]); CE(v[3], v[11]); CE(v[7], v[15]); CE(v[7], v[11]); CE(v[3], v[5]); CE(v[7], v[9]); CE(v[11], v[13]); CE(v[1], v[2]); CE(v[3], v[4]); CE(v[5], v[6]); CE(v[7], v[8]); CE(v[9], v[10]); CE(v[11], v[12]); CE(v[13], v[14]); } while (0)

__device__ __forceinline__ void sort16(unsigned (&v)[16]) { S16_NET(v); }
__device__ __forceinline__ void bitonic16(unsigned (&v)[16]) {
#pragma unroll
    for (int k = 8; k >= 1; k >>= 1)
#pragma unroll
        for (int i = 0; i < 16; ++i) if ((i & k) == 0) CE(v[i], v[i + k]);
}
__device__ __forceinline__ void merge_top16(unsigned (&m)[16], const unsigned (&b)[16]) {
#pragma unroll
    for (int i = 0; i < 16; ++i) m[i] = m[i] > b[15 - i] ? m[i] : b[15 - i];
    bitonic16(m);
}
__device__ __forceinline__ void insert16(unsigned (&L)[16], unsigned x) {
#pragma unroll
    for (int j = 0; j < 16; ++j) { const unsigned hi = L[j] > x ? L[j] : x; x = L[j] > x ? x : L[j]; L[j] = hi; }
}

__device__ __forceinline__ void phase_topk(const Args& a, LAS unsigned char* lds) {
    const int tid = threadIdx.x, wid = tid >> 6, lane = tid & 63, r = lane & 31, hh = lane >> 5;
    const bf16_t* PQ = (const bf16_t*)(a.ws + WS_PQ); const bf16_t* SUBK = (const bf16_t*)(a.ws + WS_SUBK);
    const float* ROWSQ = (const float*)(a.ws + WS_ROWSQ);
    int* IDX = (int*)(a.ws + WS_IDX);
    LAS unsigned* ib = (LAS unsigned*)(lds + wid * 2048 + lane * 32);
    for (int task = blockIdx.x * 8 + wid; task < 512 * 8; task += gridDim.x * 8) {
        const int tt = task >> 3, hd = task & 7, token = tt * 32 + r;
        unsigned LA[16], LB[16];
#pragma unroll
        for (int j = 0; j < 16; ++j) { LA[j] = 0u; LB[j] = 0u; }
#pragma unroll 1
        for (int p = 0; p < 2; ++p) {
            bf16x8 bq[8];
            const bf16_t* qp = PQ + (size_t)token * DM + hd * 256 + p * 128 + 8 * hh;
#pragma unroll
            for (int k = 0; k < 8; ++k) bq[k] = *(const bf16x8*)(qp + 16 * k);
            unsigned M[16];
#pragma unroll
            for (int j = 0; j < 16; ++j) M[j] = 0u;
#pragma unroll 1
            for (int mt = 0; mt < 4; ++mt) {
                f32x16 acc;
#pragma unroll
                for (int i = 0; i < 16; ++i) acc[i] = 0.f;
                const bf16_t* sp = SUBK + ((size_t)((hd * 2 + p) * 4 + mt) * 8 * 64 + lane) * 8;
#pragma unroll
                for (int k = 0; k < 8; ++k) { const bf16x8 ak = *(const bf16x8*)(sp + 512 * k); acc = __builtin_amdgcn_mfma_f32_32x32x16_bf16(ak, bq[k], acc, 0, 0, 0); }
                unsigned K16[16];
#pragma unroll
                for (int i = 0; i < 16; ++i) { const unsigned n = 32u * mt + (i & 3) + 8u * (i >> 2) + 4u * hh; K16[i] = (fkey(acc[i]) & ~127u) | n; }
                sort16(K16);
                merge_top16(M, K16);
            }
            unsigned P[16];
#pragma unroll
            for (int j = 0; j < 16; ++j) { const auto rr = __builtin_amdgcn_permlane32_swap(M[j], M[j], false, false); P[j] = hh ? rr[0] : rr[1]; }
            merge_top16(M, P);
#pragma unroll
            for (int j = 0; j < 16; ++j) { if (p == 0) LA[j] = M[j]; else LB[j] = M[j]; }
        }
#pragma unroll
        for (int w = 0; w < 4; ++w) {
            ib[w] = (LA[4 * w] & 127u) | ((LA[4 * w + 1] & 127u) << 8) | ((LA[4 * w + 2] & 127u) << 16) | ((LA[4 * w + 3] & 127u) << 24);
            ib[4 + w] = (LB[4 * w] & 127u) | ((LB[4 * w + 1] & 127u) << 8) | ((LB[4 * w + 2] & 127u) << 16) | ((LB[4 * w + 3] & 127u) << 24);
        }
        float va[16], vb[16];
#pragma unroll
        for (int j = 0; j < 16; ++j) { va[j] = fval(LA[j] & ~127u); vb[j] = fval(LB[j] & ~127u); }
#define CKEY(i_, j_) ((fkey(va[i_] + vb[j_]) & ~255u) | (unsigned)(255 - (16 * (i_) + (j_))))
        unsigned T[16], S1[16], S2[16];
#pragma unroll
        for (int j = 0; j < 16; ++j) T[j] = CKEY(0, j);
#pragma unroll
        for (int j = 0; j < 8; ++j) { S1[j] = CKEY(1, j); S1[15 - j] = CKEY(8 + j, 0); }
        bitonic16(S1);
        merge_top16(T, S1);
        S2[0] = CKEY(2, 0); S2[1] = CKEY(2, 1); S2[2] = CKEY(2, 2); S2[3] = CKEY(2, 3); S2[4] = CKEY(2, 4);
        S2[5] = CKEY(3, 0); S2[6] = CKEY(3, 1); S2[7] = CKEY(3, 2); S2[8] = CKEY(3, 3);
        S2[9] = CKEY(4, 0); S2[10] = CKEY(4, 1); S2[11] = CKEY(4, 2);
        S2[12] = CKEY(5, 0); S2[13] = CKEY(5, 1); S2[14] = CKEY(6, 0); S2[15] = CKEY(6, 1);
        sort16(S2);
        merge_top16(T, S2);
        insert16(T, CKEY(7, 0)); insert16(T, CKEY(7, 1));
#undef CKEY
        const float rstd = row_rstd2(ROWSQ, token);
        const float s0 = fval(T[0] & ~255u);
        float ex[16], den = 0.f; int eid[16];
        const LAS unsigned char* ibb = (const LAS unsigned char*)ib;
#pragma unroll
        for (int k = 0; k < 16; ++k) {
            const unsigned cid = 255u - (T[k] & 255u);
            const unsigned ia = ibb[cid >> 4], ibv = ibb[16 + (cid & 15u)];
            eid[k] = (int)(ia * 128u + ibv);
            ex[k] = __expf((fval(T[k] & ~255u) - s0) * rstd); den += ex[k];
        }
        const float inv = 1.0f / den;
        if (hh == 0) {
#pragma unroll
            for (int k = 0; k < 16; k += 4) { int4 v; v.x = eid[k]; v.y = eid[k + 1]; v.z = eid[k + 2]; v.w = eid[k + 3]; *(int4*)(IDX + (size_t)token * 128 + hd * 16 + k) = v; }
#pragma unroll
            for (int k = 0; k < 16; k += 8) { u32x4 v; v.x = (unsigned)eid[k] | ((unsigned)eid[k + 1] << 16); v.y = (unsigned)eid[k + 2] | ((unsigned)eid[k + 3] << 16);
                v.z = (unsigned)eid[k + 4] | ((unsigned)eid[k + 5] << 16); v.w = (unsigned)eid[k + 6] | ((unsigned)eid[k + 7] << 16);
                *(LAS u32x4*)(lds + L7_EID + (r * 128 + hd * 16 + k) * 2) = v; }
        } else {
#pragma unroll
            for (int k = 0; k < 16; k += 4) { f32x4 v; v[0] = ex[k] * inv; v[1] = ex[k + 1] * inv; v[2] = ex[k + 2] * inv; v[3] = ex[k + 3] * inv; *(LAS f32x4*)(lds + L7_GL + (r * 128 + hd * 16 + k) * 4) = v; }
        }
        asm volatile("s_waitcnt vmcnt(0) lgkmcnt(0)" ::: "memory");
        __syncthreads();
        if (!(a.sub & 1024)) gather_u_tile(a, lds, tt * 32);
        __syncthreads();
    }
}
#undef CE

constexpr int GCHUNK = 32;
__device__ __forceinline__ int swap32_isum(int x, int y) { const auto rr = __builtin_amdgcn_permlane32_swap((unsigned)x, (unsigned)y, false, false); return (int)rr[0] + (int)rr[1]; }
__device__ __forceinline__ int swap16_isum(int x, int y) { const auto rr = __builtin_amdgcn_permlane16_swap((unsigned)x, (unsigned)y, false, false); return (int)rr[0] + (int)rr[1]; }
__device__ __forceinline__ int ror8_isum(int x) { return x + __builtin_amdgcn_update_dpp(0, x, 0x128, 0xF, 0xF, true); }
__device__ __forceinline__ void phase_gather_v(const Args& a) {
    const int lane = threadIdx.x & 63;
    const int* IDX = (const int*)(a.ws + WS_IDX); const unsigned char* COEFQ = (const unsigned char*)(a.ws + WS_COEF); const float* CSC = (const float*)(a.ws + WS_XS);
    const unsigned char* V4 = (const unsigned char*)(a.ws + WS_V8); const bf16_t* H1G = (const bf16_t*)(a.ws + WS_H1G);
    unsigned* vq = (unsigned*)(a.ws + WS_CTL) + VQ_WORD;
    const unsigned xcc = xb_xcc_id() & 7u;
    const int grp = lane >> 3;
    const unsigned poff = (unsigned)(lane & 7) * 16u;
    const int ocol = 32 * (lane & 7) + 16 * (lane >> 5) + 8 * ((lane >> 4) & 1);
    const bool writer = (lane & 8) == 0;
    for (int j = 0; j < 8; ++j) {
        const int sl = (int)((xcc + (unsigned)j) & 7u);
        const unsigned char* Vs = V4 + (size_t)sl * 16384 * 128;
        f32x4 gi0, gi1; { const f32x4 g0 = *(const f32x4*)(a.norm_ffn + sl * 256 + ocol), g1 = *(const f32x4*)(a.norm_ffn + sl * 256 + ocol + 4);
#pragma unroll
            for (int e = 0; e < 4; ++e) { gi0[e] = 1.0f / g0[e]; gi1[e] = 1.0f / g1[e]; } }
        for (;;) {
            unsigned ch = 0;
            if (lane == 0) ch = __hip_atomic_fetch_add(vq + 64 * sl, 1u, __ATOMIC_RELAXED, __HIP_MEMORY_SCOPE_AGENT);
            ch = __builtin_amdgcn_readfirstlane(ch);
            if (ch >= (unsigned)(S_ROWS / GCHUNK)) break;
            const int t0 = (int)ch * GCHUNK;
            int4 inx[4]; u32x4 cA, cB; u32x4 vA[16], vB[16]; u32x4 hA, hB; pg8::f32x2 scA, scB;
#define PV_IDX(tok_) do { const int* ip_ = IDX + (size_t)(tok_) * 128 + 16 * grp; _Pragma("unroll") for (int w = 0; w < 4; ++w) inx[w] = *(const int4*)(ip_ + 4 * w); } while (0)
#define PV_ISSUE(VV, CC, HH, SCC, tok_) do { \
                HH = *(const u32x4*)(H1G + (size_t)(tok_) * DM + sl * 256 + ocol); SCC = *(const pg8::f32x2*)(CSC + 2 * (size_t)(tok_)); \
                _Pragma("unroll") for (int w = 0; w < 4; ++w) { \
                    VV[4 * w + 0] = *(const u32x4*)(Vs + (size_t)inx[w].x * 128 + poff); VV[4 * w + 1] = *(const u32x4*)(Vs + (size_t)inx[w].y * 128 + poff); \
                    VV[4 * w + 2] = *(const u32x4*)(Vs + (size_t)inx[w].z * 128 + poff); VV[4 * w + 3] = *(const u32x4*)(Vs + (size_t)inx[w].w * 128 + poff); } \
                CC = *(const u32x4*)(COEFQ + (size_t)(tok_) * 128 + 16 * grp); } while (0)
#define PV_CONSUME(VV, CC, HH, SCC, tok_) do { \
                int acc[32]; _Pragma("unroll") for (int q = 0; q < 32; ++q) acc[q] = 0; \
                float* op_ = a.out + (size_t)(tok_) * DM + sl * 256 + ocol; \
                _Pragma("unroll") for (int gq = 0; gq < 4; ++gq) { const int cp_ = (int)CC[gq]; \
                    _Pragma("unroll") for (int w = 0; w < 4; ++w) { \
                        const unsigned x0 = VV[4 * gq + 0][w], x1 = VV[4 * gq + 1][w], x2 = VV[4 * gq + 2][w], x3 = VV[4 * gq + 3][w]; \
                        const unsigned l01 = __builtin_amdgcn_perm(x1, x0, 0x05010400u), h01 = __builtin_amdgcn_perm(x1, x0, 0x07030602u); \
                        const unsigned l23 = __builtin_amdgcn_perm(x3, x2, 0x05010400u), h23 = __builtin_amdgcn_perm(x3, x2, 0x07030602u); \
                        const unsigned t0_ = __builtin_amdgcn_perm(l23, l01, 0x05040100u), t1_ = __builtin_amdgcn_perm(l23, l01, 0x07060302u); \
                        const unsigned t2_ = __builtin_amdgcn_perm(h23, h01, 0x05040100u), t3_ = __builtin_amdgcn_perm(h23, h01, 0x07060302u); \
                        acc[8 * w + 0] = __builtin_amdgcn_sdot4((int)(t0_ & 0x0f0f0f0fu), cp_, acc[8 * w + 0], false); acc[8 * w + 1] = __builtin_amdgcn_sdot4((int)t0_, cp_, acc[8 * w + 1], false); \
                        acc[8 * w + 2] = __builtin_amdgcn_sdot4((int)(t1_ & 0x0f0f0f0fu), cp_, acc[8 * w + 2], false); acc[8 * w + 3] = __builtin_amdgcn_sdot4((int)t1_, cp_, acc[8 * w + 3], false); \
                        acc[8 * w + 4] = __builtin_amdgcn_sdot4((int)(t2_ & 0x0f0f0f0fu), cp_, acc[8 * w + 4], false); acc[8 * w + 5] = __builtin_amdgcn_sdot4((int)t2_, cp_, acc[8 * w + 5], false); \
                        acc[8 * w + 6] = __builtin_amdgcn_sdot4((int)(t3_ & 0x0f0f0f0fu), cp_, acc[8 * w + 6], false); acc[8 * w + 7] = __builtin_amdgcn_sdot4((int)t3_, cp_, acc[8 * w + 7], false); } } \
                int z16[16]; _Pragma("unroll") for (int q = 0; q < 16; ++q) z16[q] = swap32_isum(acc[q], acc[16 + q]);        \
                int z8[8]; _Pragma("unroll") for (int q = 0; q < 8; ++q) z8[q] = ror8_isum(swap16_isum(z16[q], z16[8 + q]));     \
                if (writer) { const float sc_ = SCC.x, cs_ = SCC.y; f32x4 o0, o1;     \
                    o0[0] = bflo(HH.x) * gi0[0] + ((float)z8[0] - cs_) * sc_; o0[1] = bfhi(HH.x) * gi0[1] + (float)((z8[1] - z8[0]) >> 4) * sc_; \
                    o0[2] = bflo(HH.y) * gi0[2] + ((float)z8[2] - cs_) * sc_; o0[3] = bfhi(HH.y) * gi0[3] + (float)((z8[3] - z8[2]) >> 4) * sc_; \
                    o1[0] = bflo(HH.z) * gi1[0] + ((float)z8[4] - cs_) * sc_; o1[1] = bfhi(HH.z) * gi1[1] + (float)((z8[5] - z8[4]) >> 4) * sc_; \
                    o1[2] = bflo(HH.w) * gi1[2] + ((float)z8[6] - cs_) * sc_; o1[3] = bfhi(HH.w) * gi1[3] + (float)((z8[7] - z8[6]) >> 4) * sc_; \
                    *(f32x4*)op_ = o0; *(f32x4*)(op_ + 4) = o1; } } while (0)
            int4 inxB[4];
#define PV_IDXB(tok_) do { const int* ip_ = IDX + (size_t)(tok_) * 128 + 16 * grp; _Pragma("unroll") for (int w = 0; w < 4; ++w) inxB[w] = *(const int4*)(ip_ + 4 * w); } while (0)
#define PV_SWAPIDX() do { _Pragma("unroll") for (int w = 0; w < 4; ++w) { const int4 t_ = inx[w]; inx[w] = inxB[w]; inxB[w] = t_; } } while (0)
#define SB() __builtin_amdgcn_sched_barrier(0)
            PV_IDX(t0); PV_IDXB(t0 + 1); SB();
            PV_ISSUE(vA, cA, hA, scA, t0); SB();
            for (int t = 0; t < GCHUNK - 2; t += 2) {
                PV_IDX(t0 + t + 2);
                SB();
                PV_SWAPIDX();
                PV_ISSUE(vB, cB, hB, scB, t0 + t + 1);
                SB();
                PV_CONSUME(vA, cA, hA, scA, t0 + t);
                SB();
                PV_SWAPIDX();
                PV_IDXB(t0 + t + 3);
                SB();
                PV_ISSUE(vA, cA, hA, scA, t0 + t + 2);
                SB();
                PV_CONSUME(vB, cB, hB, scB, t0 + t + 1);
                SB();
            }
            PV_SWAPIDX();
            PV_ISSUE(vB, cB, hB, scB, t0 + GCHUNK - 1);
            SB();
            PV_CONSUME(vA, cA, hA, scA, t0 + GCHUNK - 2);
            SB();
            PV_CONSUME(vB, cB, hB, scB, t0 + GCHUNK - 1);
            SB();
#undef SB
#undef PV_IDXB
#undef PV_SWAPIDX
#undef PV_IDX
#undef PV_ISSUE
#undef PV_CONSUME
        }
    }
}

__global__ void __launch_bounds__(512, 2) hymba_fwd(Args a) {
    extern __shared__ __attribute__((aligned(16))) unsigned char shm[];
    LAS unsigned char* lds = (LAS unsigned char*)shm;
    volatile LAS unsigned* xbw = (volatile LAS unsigned*)(lds + LDS_BYTES - 16);
    if (threadIdx.x == 0) { xbw[0] = 0u; xbw[1] = 0u; xbw[2] = 0u; xbw[3] = 0u; }
    __syncthreads();
    XcdBarrier bar = xcd_barrier_post((unsigned*)(a.ws + WS_CTL), xbw);
#ifndef PHMASK
#define PHMASK 0x3ff
#endif
#define RUN(p) ((((PHMASK) >> (p)) & 1) && a.ph_lo <= (p) && (p) < a.ph_hi)
#define SEAM(p) do { if (a.ph_lo <= (p) && (p) + 1 < a.ph_hi) xcd_barrier(bar); } while (0)
    if (RUN(0)) phase_prep(a, lds);
    SEAM(0);
    if (RUN(1)) {
        phase_cumf_meta(a, lds);
        pg8::Gemm g; g.A = (const bf16_t*)(a.ws + WS_XN); g.Bt = (const bf16_t*)(a.ws + WS_WTIN); g.M = S_ROWS; g.N = NPROJ; g.K = DM / 2;
        pg8::StaticOrder so; so.init(g.M, g.N, (int)gridDim.x, (int)blockIdx.x);
        EpiInI8 ep; ep.O = (bf16_t*)(a.ws + WS_PROJ); ep.sa = (const float*)(a.ws + WS_SA); ep.sb = (const float*)(a.ws + WS_SBIN);
        pg8::gemm_phase<EpiInI8, pg8::StaticOrder, false, true>(lds, g, so, ep, nullptr);
    }
    SEAM(1);
    if (RUN(2)) phase_ak(a);
    SEAM(2);
    if (RUN(3)) phase_attn(a, lds);
    SEAM(3);
    if (RUN(4)) phase_merge(a);
    SEAM(4);
    if (RUN(5)) {
        pg8::Gemm g; g.A = (const bf16_t*)(a.ws + WS_MERGED); g.Bt = (const bf16_t*)(a.ws + WS_WTOUT); g.M = S_ROWS; g.N = DM; g.K = DM / 2;
        pg8::StaticOrder so; so.init(g.M, g.N, (int)gridDim.x, (int)blockIdx.x);
        EpiOut ep; ep.X = a.x; ep.H1G = (bf16_t*)(a.ws + WS_H1G); ep.gffn = a.norm_ffn; ep.rowsq = (float*)(a.ws + WS_ROWSQ);
        ep.sm = (const float*)(a.ws + WS_SM); ep.sb = (const float*)(a.ws + WS_SBOUT); ep.eb = lds + EPI_LDS;
        pg8::gemm_phase<EpiOut, pg8::StaticOrder, false, true>(lds, g, so, ep, nullptr);
    }
    SEAM(5);
    if (RUN(6)) {
        pg8::Gemm g; g.A = (const bf16_t*)(a.ws + WS_H1G); g.Bt = (const bf16_t*)(a.ws + WS_WTQ); g.M = S_ROWS; g.N = DM; g.K = DM;
        pg8::StaticOrder so; so.init(g.M, g.N, (int)gridDim.x, (int)blockIdx.x);
        pg8::EpiBf16<0> ep; ep.O = (bf16_t*)(a.ws + WS_PQ); ep.ldc = DM; ep.bias = nullptr; ep.split_cols = 0; ep.split_stride = 0;
        pg8::gemm_phase<pg8::EpiBf16<0>, pg8::StaticOrder, false>(lds, g, so, ep, nullptr);
    }
    SEAM(6);
    if (RUN(7)) phase_topk(a, lds);
    SEAM(7);
    if (RUN(9)) phase_gather_v(a);
#undef RUN
#undef SEAM
}

#ifndef N_LAUNCHES
#define N_LAUNCHES 1
#endif
extern "C" void kernel_launch(void* const* d_in, const int* in_sizes, int n_in, void* d_out, int out_size, void* d_ws, size_t ws_size, hipStream_t stream) {
    static int grid = 0;
    if (grid == 0) {
        if (n_in != 15 || in_sizes[0] != S_ROWS * DM || out_size != S_ROWS * DM || ws_size < WS_END) {
            fprintf(stderr, "kernel_launch: unexpected shapes (n_in %d, in0 %d, out %d, ws %zu, need %zu)\n", n_in, n_in > 0 ? in_sizes[0] : -1, out_size, ws_size, (size_t)WS_END); grid = -1; return; }
        int dev = 0, cus = 0, per_cu = 0;
        if (hipGetDevice(&dev) != hipSuccess || hipDeviceGetAttribute(&cus, hipDeviceAttributeMultiprocessorCount, dev) != hipSuccess) { grid = -1; return; }
        if (hipFuncSetAttribute((const void*)hymba_fwd, hipFuncAttributeMaxDynamicSharedMemorySize, LDS_BYTES) != hipSuccess) { fprintf(stderr, "kernel_launch: hipFuncSetAttribute failed\n"); grid = -1; return; }
        if (hipOccupancyMaxActiveBlocksPerMultiprocessor(&per_cu, (const void*)hymba_fwd, 512, LDS_BYTES) != hipSuccess || per_cu < 1) { fprintf(stderr, "kernel_launch: occupancy query says %d\n", per_cu); }
        (void)hipGetLastError();
        grid = cus;
    }
    if (grid < 0) return;
    Args a{};
    a.x = (const float*)d_in[0]; a.meta = (const float*)d_in[1]; a.norm_mix = (const float*)d_in[2]; a.w_in = (const float*)d_in[3]; a.b_forget = (const float*)d_in[4];
    a.gq = (const float*)d_in[5]; a.gk = (const float*)d_in[6]; a.g_sb = (const float*)d_in[7]; a.g_fox = (const float*)d_in[8]; a.w_out = (const float*)d_in[9];
    a.norm_ffn = (const float*)d_in[10]; a.w_query = (const float*)d_in[11]; a.sub_keys = (const float*)d_in[12]; a.pu = (const float*)d_in[13]; a.pv = (const float*)d_in[14];
    a.out = (float*)d_out; a.ws = (unsigned char*)d_ws; a.sub = 7; a.pad_ = 0;
#ifdef PROBE_DUP
    const int lo[3] = {0, PROBE_DUP, PROBE_DUP + 1}, hi[3] = {PROBE_DUP + 1, PROBE_DUP + 1, NPH};
    for (int li = 0; li < 3; ++li) {
        if (lo[li] >= hi[li]) continue;
        a.ph_lo = lo[li]; a.ph_hi = hi[li];
#ifdef PROBE_SUB
        a.sub = (li == 1) ? PROBE_SUB : 7;
#endif
        (void)hipMemsetAsync((char*)d_ws + WS_CTL, 0, CTL_BYTES, stream);
        hipLaunchKernelGGL(hymba_fwd, dim3(grid), dim3(512), LDS_BYTES, stream, a);
    }
#else
    for (int li = 0; li < N_LAUNCHES; ++li) {
        if (N_LAUNCHES == 1) { a.ph_lo = 0; a.ph_hi = NPH; } else { a.ph_lo = li * NPH / N_LAUNCHES; a.ph_hi = (li + 1) * NPH / N_LAUNCHES; }
        (void)hipMemsetAsync((char*)d_ws + WS_CTL, 0, li == 0 ? CTL_BYTES : (size_t)XCD_BAR_WORDS * 4, stream);
        hipLaunchKernelGGL(hymba_fwd, dim3(grid), dim3(512), LDS_BYTES, stream, a);
    }
#endif
}
```

```cpp
#include <hip/hip_runtime.h>
#include <cstdio>
#include <cstdint>
#include <cstddef>


typedef short s16x4 __attribute__((ext_vector_type(4)));
typedef float f32x16 __attribute__((ext_vector_type(16)));
typedef unsigned u32x2 __attribute__((ext_vector_type(2)));
#define XB_TMO      128
#define XB_XCNT(j)  (256  + 64 * (j))
#define XB_XSUB(j)  (1280 + 64 * (j))
#define XB_XGEN(j)  (2304 + 64 * (j))
#define XB_TOP      3328
#define XB_TOPGEN   3392
#define XCD_BAR_WORDS 3456
#define XB_SPIN_CAP (1u << 18)
#define LAS __attribute__((address_space(3)))

__device__ __forceinline__ unsigned xb_ld(unsigned* p)              { return __hip_atomic_load(p, __ATOMIC_RELAXED, __HIP_MEMORY_SCOPE_AGENT); }
__device__ __forceinline__ unsigned xb_add(unsigned* p, unsigned v) { return __hip_atomic_fetch_add(p, v, __ATOMIC_RELAXED, __HIP_MEMORY_SCOPE_AGENT); }
__device__ __forceinline__ unsigned xb_xcc_id() { return (unsigned)__builtin_amdgcn_s_getreg((3 << 11) | 20) & 0xFu; }
#define XB_SPIN(cond, bar) do { unsigned _sp = 0; while (cond) { __builtin_amdgcn_s_sleep(1); \
    if ((++_sp & 255u) == 0u) { if (xb_ld(&(bar)[XB_TMO])) break; if (_sp > XB_SPIN_CAP) { atomicAdd(&(bar)[XB_TMO], 1u); break; } } } } while (0)

struct XcdBarrier {
    unsigned* bar; unsigned x;
    volatile LAS unsigned* st;
};

__device__ __forceinline__ XcdBarrier xcd_barrier_post(unsigned* bar, volatile LAS unsigned* st) {
    XcdBarrier b; b.bar = bar; b.x = xb_xcc_id(); b.st = st;
    if (threadIdx.x == 0) (void)xb_add(&bar[XB_XCNT(b.x)], 1u);
    return b;
}
__device__ __forceinline__ void xcd_barrier_complete(unsigned* bar, unsigned x, unsigned& nloc, unsigned& nx) {
    const unsigned G = gridDim.x * gridDim.y * gridDim.z;
    unsigned sum, cnt, mine, sp = 0u;
    for (;;) {
        sum = 0u; cnt = 0u; mine = 0u;
#pragma unroll
        for (unsigned j = 0; j < 16; ++j) { const unsigned c = xb_ld(&bar[XB_XCNT(j)]); sum += c; cnt += (c > 0u) ? 1u : 0u; mine = (j == x) ? c : mine; }
        if (sum == G) break;
        __builtin_amdgcn_s_sleep(1);
        if ((++sp & 255u) == 0u) { if (xb_ld(&bar[XB_TMO])) break; if (sp > XB_SPIN_CAP) { atomicAdd(&bar[XB_TMO], 1u); break; } }
    }
    nloc = mine > 0u ? mine : 1u; nx = cnt > 0u ? cnt : 1u;
}

__device__ __forceinline__ void xcd_barrier(const XcdBarrier& b) {
    asm volatile("s_waitcnt vmcnt(0)" ::: "memory");
    __syncthreads();
    if (threadIdx.x == 0) {
        unsigned* bar = b.bar;
        __builtin_amdgcn_s_waitcnt(0);
        unsigned nloc = b.st[0], nx = b.st[1];
        if (nloc == 0u) { xcd_barrier_complete(bar, b.x, nloc, nx); b.st[0] = nloc; b.st[1] = nx; }
        const unsigned old = xb_add(&bar[XB_XSUB(b.x)], 1u);
        const unsigned gen = old / nloc;
        if (old + 1u == (gen + 1u) * nloc) {
            __builtin_amdgcn_fence(__ATOMIC_RELEASE, "agent");
            asm volatile("s_waitcnt vmcnt(0)" ::: "memory");
            const unsigned og = xb_add(&bar[XB_TOP], 1u);
            const unsigned tg = og / nx;
            if (og + 1u == (tg + 1u) * nx) xb_add(&bar[XB_TOPGEN], 1u);
            else XB_SPIN(xb_ld(&bar[XB_TOPGEN]) == tg, bar);
            __builtin_amdgcn_fence(__ATOMIC_ACQUIRE, "agent");
            xb_add(&bar[XB_XGEN(b.x)], 1u);
            asm volatile("s_waitcnt vmcnt(0)" ::: "memory");
        } else {
            XB_SPIN(xb_ld(&bar[XB_XGEN(b.x)]) == gen, bar);
            __builtin_amdgcn_fence(__ATOMIC_ACQUIRE, "agent");
            asm volatile("s_waitcnt vmcnt(0)" ::: "memory");
        }
    }
    __syncthreads();
}

namespace pg8 {
#define PG8_LAS __attribute__((address_space(3)))
typedef unsigned short bf16_t;
typedef short bf16x8 __attribute__((ext_vector_type(8)));
typedef float f32x4 __attribute__((ext_vector_type(4)));
typedef unsigned u32x4 __attribute__((ext_vector_type(4)));
constexpr int BM = 256, BK = 64, HALF = 128, HTB = HALF * BK * 2  , STAGE_BYTES = 8 * HTB, NXCD = 8, WGM = 8;

__host__ __device__ __forceinline__ int lds_byte(int r, int c) { const int st = (r >> 4) * 2 + (c >> 5), rr = r & 15, cc = c & 31, ob = rr * 64 + cc * 2; return st * 1024 + (ob ^ (((ob >> 9) & 1) << 5)); }
__host__ __device__ __forceinline__ void stage_rc(int b, int& R, int& C) { const int st = b / 1024, sb = b % 1024, swz = sb ^ (((sb >> 9) & 1) << 5); R = (st >> 1) * 16 + swz / 64; C = (st & 1) * 32 + (swz % 64) / 2; }
__host__ __device__ __forceinline__ int perm32(int rho) { const int n = rho >> 4, i = rho & 15; return 8 * (i >> 2) + 4 * n + (i & 3); }

struct Unit { int pm, pn; };
struct Gemm { const bf16_t* A; const bf16_t* Bt; int M, N, K; };

struct StaticOrder {
    int nM, nN, nwg, G, c;
    __host__ __device__ void init(int M, int N, int G_, int c_) { nM = M / BM; nN = N / BM; nwg = nM * nN; G = G_; c = c_; }
    __host__ __device__ bool next(int i, Unit& u) const {
        const long L = (long)i * G + c; if (L >= nwg) return false;
        int wgid = (int)L; { const int q = nwg / NXCD, r = nwg % NXCD, xcd = wgid % NXCD, off = wgid / NXCD; wgid = (xcd < r ? xcd * (q + 1) : r * (q + 1) + (xcd - r) * q) + off; }
        const int nig = WGM * nN, gid = wgid / nig, fm = gid * WGM, gsz = (nM - fm) < WGM ? (nM - fm) : WGM;
        u.pm = fm + ((wgid % nig) % gsz); u.pn = (wgid % nig) / gsz; return true;
    }
    __device__ __forceinline__ void a_ready(const Unit&) const {}
    __device__ __forceinline__ void done(const Unit&) const {}
};

typedef __bf16 bf16x2_t __attribute__((ext_vector_type(2)));
__device__ __forceinline__ unsigned cvt_pk_bf16(float lo, float hi) { bf16x2_t v; v[0] = (__bf16)lo; v[1] = (__bf16)hi; return __builtin_bit_cast(unsigned, v); }
typedef float f32x2 __attribute__((ext_vector_type(2)));
__device__ __forceinline__ f32x2 gelu_pk(f32x2 v) {
    const f32x2 av = __builtin_elementwise_abs(v), d = av * 0.2316418882f + 1.0f;
    f32x2 t; t.x = __builtin_amdgcn_rcpf(d.x); t.y = __builtin_amdgcn_rcpf(d.y);
    f32x2 q = t * 0.5307027145f + (-0.7265760135f); q = q * t + 0.7107068705f; q = q * t + (-0.142248368f); q = q * t + 0.127414796f; q = q * t;
    const f32x2 s = (v * v) * (-0.72134752044f);
    f32x2 e; e.x = __builtin_amdgcn_exp2f(s.x); e.y = __builtin_amdgcn_exp2f(s.y);
    const f32x2 m = v * (q * e), r = v - m;
    f32x2 o; o.x = v.x < 0.f ? m.x : r.x; o.y = v.y < 0.f ? m.y : r.y; return o;
}
template <int ACT  > struct EpiBf16 {
    static constexpr bool PERM = true, AFTER_DRAIN = false; typedef f32x4 AccT;
    bf16_t* O; int ldc; const float* bias; int split_cols; size_t split_stride;
    __device__ __forceinline__ void operator()(const f32x4 (&acc)[2][2][4][2], const Unit& u, int wr, int wc, int fr, int fq) const {
        const int row0 = u.pm * BM + wr * 64 + fr; int colt = u.pn * BM; bf16_t* base = O;
        if (split_cols) { const int t = colt / split_cols; base += (size_t)t * split_stride; colt -= t * split_cols; }
        const int col0 = colt + wc * 32 + 8 * fq, bcol0 = u.pn * BM + wc * 32 + 8 * fq;
        f32x4 bv[2][2];
#pragma unroll
        for (int bj = 0; bj < 2; ++bj)
#pragma unroll
            for (int n = 0; n < 2; ++n) bv[bj][n] = bias ? *(const f32x4*)(bias + bcol0 + bj * HALF + 4 * n) : (f32x4){0.f, 0.f, 0.f, 0.f};
#pragma unroll
        for (int ai = 0; ai < 2; ++ai)
#pragma unroll
            for (int m = 0; m < 4; ++m) { bf16_t* rowp = base + (size_t)(row0 + ai * HALF + m * 16) * ldc + col0;
#pragma unroll
                for (int bj = 0; bj < 2; ++bj) { f32x4 v0 = acc[ai][bj][m][0] + bv[bj][0], v1 = acc[ai][bj][m][1] + bv[bj][1];
                    if (ACT == 1) { f32x2 a = gelu_pk((f32x2){v0[0], v0[1]}), b = gelu_pk((f32x2){v0[2], v0[3]}), c = gelu_pk((f32x2){v1[0], v1[1]}), d = gelu_pk((f32x2){v1[2], v1[3]});
                        v0 = (f32x4){a.x, a.y, b.x, b.y}; v1 = (f32x4){c.x, c.y, d.x, d.y}; }
                    if (ACT == 2) {
#pragma unroll
                        for (int j = 0; j < 4; ++j) { v0[j] = 0.5f * v0[j] * (1.0f + erff(v0[j] * 0.70710678f)); v1[j] = 0.5f * v1[j] * (1.0f + erff(v1[j] * 0.70710678f)); } }
                    u32x4 w; w.x = cvt_pk_bf16(v0[0], v0[1]); w.y = cvt_pk_bf16(v0[2], v0[3]); w.z = cvt_pk_bf16(v1[0], v1[1]); w.w = cvt_pk_bf16(v1[2], v1[3]);
                    *(u32x4*)(rowp + bj * HALF) = w; } }
    }
};

typedef int i32x4 __attribute__((ext_vector_type(4)));
template <class Epi, class Sched, bool STAMP = false, bool I8 = false>
__device__ __forceinline__ void gemm_phase(PG8_LAS unsigned char* lds, const Gemm g, const Sched& S, const Epi& E, unsigned long long* stamps) {
    const int tid = threadIdx.x, wid = __builtin_amdgcn_readfirstlane(tid >> 6), lane = tid & 63, wr = wid >> 2, wc = wid & 3, fr = lane & 15, fq = lane >> 4;
    const int K = g.K, nt = K / BK;
    int ts_lo = 0, ts_hi = 0, nts = 0; const unsigned long long rt_entry = STAMP ? (unsigned long long)wall_clock64() : 0ull;
#define PG8_STAMP() do { if (STAMP && wid == 0 && nts < 64) { const unsigned long long _c = (unsigned long long)clock64(); \
        ts_lo = (lane == nts) ? (int)(unsigned)_c : ts_lo; ts_hi = (lane == nts) ? (int)(unsigned)(_c >> 32) : ts_hi; ++nts; } } while (0)
    PG8_STAMP();
    unsigned voffA[2], voffB[2];
#pragma unroll
    for (int i = 0; i < 2; ++i) { int R, C; stage_rc(tid * 16 + i * 8192, R, C); const int Rb = Epi::PERM ? ((R & ~31) + perm32(R & 31)) : R;
        voffA[i] = (unsigned)(R * K + C) * 2u; voffB[i] = (unsigned)(Rb * K + C) * 2u; }
    const size_t kstep = (size_t)(BK * 2);
    const size_t hstep = (size_t)HALF * K * 2;
    const size_t tstep = 2 * hstep;
    const unsigned ldsw = (unsigned)wid * 1024u;
    const int aoff = lds_byte(wr * 64 + fr, fq * 8), boff = lds_byte(wc * 32 + fr, fq * 8);
#define PG8_SA(b, h) (((b) * 2 + (h)) * HTB)
#define PG8_SB(b, h) ((4 + (b) * 2 + (h)) * HTB)
#define PG8_STAGE(bufoff, gbase, voff) do { _Pragma("unroll") for (int _i = 0; _i < 2; ++_i) \
        __builtin_amdgcn_global_load_lds((const unsigned*)((const char*)(gbase) + (voff)[_i]), (PG8_LAS unsigned*)(lds + (bufoff) + ldsw + _i * 8192), 16, 0, 0); } while (0)
#define PG8_LDA(dst, b, h) do { _Pragma("unroll") for (int m = 0; m < 4; ++m) _Pragma("unroll") for (int k = 0; k < 2; ++k) dst[m][k] = *(const PG8_LAS bf16x8*)(lds + PG8_SA(b, h) + aoff + m * 2048 + k * 1024); } while (0)
#define PG8_LDB(dst, b, h) do { _Pragma("unroll") for (int n = 0; n < 2; ++n) _Pragma("unroll") for (int k = 0; k < 2; ++k) dst[n][k] = *(const PG8_LAS bf16x8*)(lds + PG8_SB(b, h) + boff + n * 2048 + k * 1024); } while (0)
#define PG8_MMA(ai, bj, At, Bt) do { __builtin_amdgcn_s_setprio(1); _Pragma("unroll") for (int m = 0; m < 4; ++m) _Pragma("unroll") for (int n = 0; n < 2; ++n) _Pragma("unroll") for (int k = 0; k < 2; ++k) { \
        if constexpr (I8) acc[ai][bj][m][n] = __builtin_bit_cast(AccT, __builtin_amdgcn_mfma_i32_16x16x64_i8(__builtin_bit_cast(i32x4, Bt[n][k]), __builtin_bit_cast(i32x4, At[m][k]), __builtin_bit_cast(i32x4, acc[ai][bj][m][n]), 0, 0, 0)); \
        else acc[ai][bj][m][n] = __builtin_bit_cast(AccT, __builtin_amdgcn_mfma_f32_16x16x32_bf16(Bt[n][k], At[m][k], __builtin_bit_cast(f32x4, acc[ai][bj][m][n]), 0, 0, 0)); } __builtin_amdgcn_s_setprio(0); } while (0)
#define PG8_WAIT_V(n) asm volatile("s_waitcnt vmcnt(" #n ")" ::: "memory")
#define PG8_WAIT_L(n) asm volatile("s_waitcnt lgkmcnt(" #n ")" ::: "memory")
#define PG8_BAR __builtin_amdgcn_s_barrier()
#define PG8_SCHED __builtin_amdgcn_sched_barrier(0)
    Unit cur, nxt; int ui = 0;
    if (!S.next(0, cur)) return;
    typedef typename Epi::AccT AccT;
    AccT acc[2][2][4][2];
#pragma unroll
    for (int a = 0; a < 2; ++a)
#pragma unroll
        for (int b = 0; b < 2; ++b)
#pragma unroll
            for (int m = 0; m < 4; ++m)
#pragma unroll
                for (int n = 0; n < 2; ++n) acc[a][b][m][n] = (AccT){0, 0, 0, 0};
    bf16x8 At[4][2], B0[2][2], B1[2][2];
    const char* cA = (const char*)g.A + (size_t)cur.pm * tstep; const char* cB = (const char*)g.Bt + (size_t)cur.pn * tstep;
    S.a_ready(cur);
    PG8_STAGE(PG8_SB(0, 0), cB, voffB); PG8_STAGE(PG8_SA(0, 0), cA, voffA); PG8_STAGE(PG8_SB(0, 1), cB + hstep, voffB); PG8_STAGE(PG8_SA(0, 1), cA + hstep, voffA);
    if (wr == 1) PG8_BAR;
    PG8_WAIT_V(4); PG8_BAR;
    PG8_STAGE(PG8_SB(1, 0), cB + kstep, voffB); PG8_STAGE(PG8_SA(1, 0), cA + kstep, voffA); PG8_STAGE(PG8_SB(1, 1), cB + hstep + kstep, voffB);
    PG8_WAIT_V(6); PG8_BAR;
    PG8_STAMP();
    for (;;) {
        const bool has_next = S.next(ui + 1, nxt);
        const char* nA = has_next ? (const char*)g.A + (size_t)nxt.pm * tstep : cA; const char* nB = has_next ? (const char*)g.Bt + (size_t)nxt.pn * tstep : cB;
        for (int t = 0; t < nt; t += 2) {
            const bool last = (t == nt - 2);
            const char* a1 = cA + (size_t)(t + 1) * kstep;
            const char* a2 = last ? nA : cA + (size_t)(t + 2) * kstep; const char* b2 = last ? nB : cB + (size_t)(t + 2) * kstep;
            const char* a3 = a2 + kstep; const char* b3 = b2 + kstep;
            if (last && has_next) S.a_ready(nxt);
            PG8_LDB(B0, 0, 0); PG8_SCHED; PG8_LDA(At, 0, 0); PG8_STAGE(PG8_SA(1, 1), a1 + hstep, voffA);
            PG8_WAIT_L(8); PG8_BAR; PG8_WAIT_L(0); PG8_MMA(0, 0, At, B0); PG8_BAR; PG8_SCHED;
            PG8_LDB(B1, 0, 1); PG8_STAGE(PG8_SB(0, 0), b2, voffB);
            PG8_BAR; PG8_WAIT_L(0); PG8_MMA(0, 1, At, B1); PG8_BAR;
            PG8_LDA(At, 0, 1); PG8_STAGE(PG8_SA(0, 0), a2, voffA);
            PG8_BAR; PG8_WAIT_L(0); PG8_MMA(1, 0, At, B0); PG8_BAR; PG8_SCHED;
            PG8_STAGE(PG8_SB(0, 1), b2 + hstep, voffB);
            PG8_WAIT_V(6); PG8_BAR; PG8_MMA(1, 1, At, B1); PG8_BAR;
            PG8_LDB(B0, 1, 0); PG8_SCHED; PG8_LDA(At, 1, 0); PG8_STAGE(PG8_SA(0, 1), a2 + hstep, voffA);
            PG8_WAIT_L(8); PG8_BAR; PG8_WAIT_L(0); PG8_MMA(0, 0, At, B0); PG8_BAR; PG8_SCHED;
            PG8_LDB(B1, 1, 1); PG8_STAGE(PG8_SB(1, 0), b3, voffB);
            PG8_BAR; PG8_WAIT_L(0); PG8_MMA(0, 1, At, B1); PG8_BAR;
            PG8_LDA(At, 1, 1); PG8_STAGE(PG8_SA(1, 0), a3, voffA);
            PG8_BAR; PG8_WAIT_L(0); PG8_MMA(1, 0, At, B0); PG8_BAR; PG8_SCHED;
            PG8_STAGE(PG8_SB(1, 1), b3 + hstep, voffB);
            PG8_WAIT_V(6); PG8_BAR; PG8_MMA(1, 1, At, B1); PG8_BAR;
        }
        PG8_STAMP();
        if constexpr (!Epi::AFTER_DRAIN) { E(acc, cur, wr, wc, fr, fq); S.done(cur); }
        PG8_STAMP();
        if (!has_next) break;
#pragma unroll
        for (int a = 0; a < 2; ++a)
#pragma unroll
            for (int b = 0; b < 2; ++b)
#pragma unroll
                for (int m = 0; m < 4; ++m)
#pragma unroll
                    for (int n = 0; n < 2; ++n) acc[a][b][m][n] = (AccT){0, 0, 0, 0};
        cur = nxt; cA = nA; cB = nB; ++ui;
    }
    PG8_WAIT_V(0);
    if (wr == 0) PG8_BAR;
    PG8_BAR;
    if constexpr (Epi::AFTER_DRAIN) { E.fused(acc, cur, wr, wc, fr, fq, lds, wid, lane); S.done(cur); }
    PG8_STAMP();
    if (STAMP && wid == 0) { stamps[lane] = lane < nts ? (((unsigned long long)(unsigned)ts_hi << 32) | (unsigned)ts_lo) : 0ull;
        if (lane == 62) stamps[62] = rt_entry; if (lane == 63) stamps[63] = (unsigned long long)wall_clock64(); }
#undef PG8_STAMP
#undef PG8_SA
#undef PG8_SB
#undef PG8_STAGE
#undef PG8_LDA
#undef PG8_LDB
#undef PG8_MMA
#undef PG8_WAIT_V
#undef PG8_WAIT_L
#undef PG8_BAR
#undef PG8_SCHED
}
}
using pg8::bf16_t; using pg8::bf16x8; using pg8::f32x4; using pg8::u32x4;

constexpr int S_ROWS = 16384, NMETA = 16, DM = 2048, WID = 1024, CIN = 7176, NPROJ = 7168;
constexpr int KPAD = 16416;
constexpr float EPS = 1e-6f;
constexpr float LOG2E = 1.4426950408889634f;
constexpr float QSCALE2 = 0.08838834764831845f * 1.4426950408889634f;
constexpr int LDS_BYTES = 155648;
constexpr int NPH = 10;
constexpr float PRUNE_LOG2 = -64.0f;

constexpr size_t al256(size_t x) { return (x + 255) & ~(size_t)255; }
constexpr size_t PROJ_T   = (size_t)S_ROWS * WID * 2;
constexpr size_t WS_CTL   = 0;
constexpr size_t CTL_BYTES = 65536;
constexpr size_t WS_WTIN  = CTL_BYTES;
constexpr size_t WS_WTOUT = WS_WTIN + (size_t)NPROJ * DM * 2;
constexpr size_t WS_WTQ   = WS_WTOUT + (size_t)DM * DM * 2;
constexpr size_t WS_SUBK  = WS_WTQ + (size_t)DM * DM * 2;
constexpr size_t WS_XN    = WS_SUBK + (size_t)16 * 128 * 128 * 2;
constexpr size_t WS_PROJ  = WS_XN + (size_t)KPAD * DM * 2;
constexpr size_t WS_METAKV= WS_PROJ + 7 * PROJ_T;
constexpr size_t WS_LCUM  = WS_METAKV + (size_t)4 * 32 * 1024 * 2;
constexpr size_t WS_CHT   = WS_LCUM + (size_t)KPAD * 8 * 4;
constexpr size_t WS_CK2   = al256(WS_CHT + 257 * 8 * 4);
constexpr size_t WS_AK    = WS_CK2 + (size_t)8 * KPAD * 4;
constexpr size_t WS_ATT   = al256(WS_AK + (size_t)8 * KPAD * 4);
constexpr size_t WS_SQ    = WS_ATT + 2 * PROJ_T;
constexpr size_t WS_ROWSQ = WS_SQ + 2 * (size_t)S_ROWS * 8 * 4;
constexpr size_t WS_U8    = WS_ROWSQ + (size_t)S_ROWS * 32 * 4;
constexpr size_t WS_SU4   = WS_U8 + (size_t)16384 * 1024;
constexpr size_t WS_V8    = WS_U8 + (size_t)16384 * DM;
constexpr size_t WS_SU    = WS_V8 + (size_t)16384 * DM;
constexpr size_t WS_SV    = WS_SU + (size_t)16384 * 4;
constexpr size_t WS_SA    = WS_SV + (size_t)16384 * 4;
constexpr size_t WS_SBIN  = WS_SA + (size_t)KPAD * 4;
constexpr size_t WS_SBOUT = WS_SBIN + (size_t)NPROJ * 4;
constexpr size_t WS_SM    = WS_SBOUT + (size_t)DM * 4;
constexpr size_t WS_END   = WS_SM + (size_t)S_ROWS * 4;
constexpr size_t WS_MERGED= WS_XN;
constexpr size_t WS_PQ    = WS_XN;
constexpr size_t WS_H1G   = WS_PROJ;
constexpr size_t WS_IDX   = WS_PROJ + 2 * PROJ_T;
constexpr size_t WS_G     = WS_IDX + (size_t)S_ROWS * 128 * 4;
constexpr size_t WS_HN8   = WS_PROJ + 3 * PROJ_T;
constexpr size_t WS_COEF  = WS_PROJ + 4 * PROJ_T;
constexpr size_t WS_XS    = WS_COEF + (size_t)S_ROWS * 128 * 4;
constexpr int QCTR_WORD = 4096;
constexpr int UQ_WORD = 4096 + 64;
constexpr int VQ_WORD = 4096 + 64 * 17;
static_assert((VQ_WORD + 64 * 16) * 4 <= (int)CTL_BYTES, "control words");
static_assert(WS_END <= ((size_t)512 << 20), "workspace");

struct Args {
    const float *x, *meta, *norm_mix, *w_in, *b_forget, *gq, *gk, *g_sb, *g_fox, *w_out, *norm_ffn, *w_query, *sub_keys, *pu, *pv;
    float* out; unsigned char* ws;
    int ph_lo, ph_hi;
    int sub, pad_;
};

__device__ __forceinline__ float bf2f(unsigned short b) { return __uint_as_float((unsigned)b << 16); }
__device__ __forceinline__ float bflo(unsigned w) { return __uint_as_float(w << 16); }
__device__ __forceinline__ float bfhi(unsigned w) { return __uint_as_float(w & 0xffff0000u); }
__device__ __forceinline__ unsigned pk_bf16(float lo, float hi) { return pg8::cvt_pk_bf16(lo, hi); }
__device__ __forceinline__ float wave_sum(float v) {
    v += __uint_as_float((unsigned)__builtin_amdgcn_update_dpp(0, (int)__float_as_uint(v), 0xB1, 0xF, 0xF, true));
    v += __uint_as_float((unsigned)__builtin_amdgcn_update_dpp(0, (int)__float_as_uint(v), 0x4E, 0xF, 0xF, true));
    v += __uint_as_float((unsigned)__builtin_amdgcn_update_dpp(0, (int)__float_as_uint(v), 0x141, 0xF, 0xF, true));
    v += __uint_as_float((unsigned)__builtin_amdgcn_update_dpp(0, (int)__float_as_uint(v), 0x140, 0xF, 0xF, true));
    v += __uint_as_float((unsigned)__builtin_amdgcn_update_dpp(0, (int)__float_as_uint(v), 0x142, 0xA, 0xF, true));
    v += __uint_as_float((unsigned)__builtin_amdgcn_update_dpp(0, (int)__float_as_uint(v), 0x143, 0xC, 0xF, true));
    return __uint_as_float((unsigned)__builtin_amdgcn_readlane((int)__float_as_uint(v), 63));
}
__device__ __forceinline__ float wave_max(float v) {
    v = fmaxf(v, __uint_as_float((unsigned)__builtin_amdgcn_update_dpp((int)__float_as_uint(v), (int)__float_as_uint(v), 0xB1, 0xF, 0xF, false)));
    v = fmaxf(v, __uint_as_float((unsigned)__builtin_amdgcn_update_dpp((int)__float_as_uint(v), (int)__float_as_uint(v), 0x4E, 0xF, 0xF, false)));
    v = fmaxf(v, __uint_as_float((unsigned)__builtin_amdgcn_update_dpp((int)__float_as_uint(v), (int)__float_as_uint(v), 0x141, 0xF, 0xF, false)));
    v = fmaxf(v, __uint_as_float((unsigned)__builtin_amdgcn_update_dpp((int)__float_as_uint(v), (int)__float_as_uint(v), 0x140, 0xF, 0xF, false)));
    v = fmaxf(v, __uint_as_float((unsigned)__builtin_amdgcn_update_dpp((int)__float_as_uint(v), (int)__float_as_uint(v), 0x142, 0xA, 0xF, false)));
    v = fmaxf(v, __uint_as_float((unsigned)__builtin_amdgcn_update_dpp((int)__float_as_uint(v), (int)__float_as_uint(v), 0x143, 0xC, 0xF, false)));
    return __uint_as_float((unsigned)__builtin_amdgcn_readlane((int)__float_as_uint(v), 63));
}
__device__ __forceinline__ int wave_isum(int v) {
    v += __builtin_amdgcn_update_dpp(0, v, 0xB1, 0xF, 0xF, true);
    v += __builtin_amdgcn_update_dpp(0, v, 0x4E, 0xF, 0xF, true);
    v += __builtin_amdgcn_update_dpp(0, v, 0x141, 0xF, 0xF, true);
    v += __builtin_amdgcn_update_dpp(0, v, 0x140, 0xF, 0xF, true);
    v += __builtin_amdgcn_update_dpp(0, v, 0x142, 0xA, 0xF, true);
    v += __builtin_amdgcn_update_dpp(0, v, 0x143, 0xC, 0xF, true);
    return __builtin_amdgcn_readlane(v, 63);
}
__device__ __forceinline__ float xhalf(float v) { const auto rr = __builtin_amdgcn_permlane32_swap(__float_as_uint(v), __float_as_uint(v), false, false); return (threadIdx.x & 32) ? __uint_as_float(rr[0]) : __uint_as_float(rr[1]); }
__device__ __forceinline__ float pair_max(float v) { const auto rr = __builtin_amdgcn_permlane32_swap(__float_as_uint(v), __float_as_uint(v), false, false); return fmaxf(__uint_as_float(rr[0]), __uint_as_float(rr[1])); }
__device__ __forceinline__ float pair_sum(float v) { const auto rr = __builtin_amdgcn_permlane32_swap(__float_as_uint(v), __float_as_uint(v), false, false); return __uint_as_float(rr[0]) + __uint_as_float(rr[1]); }
__device__ __forceinline__ float ex2(float x) { return __builtin_amdgcn_exp2f(x); }
__device__ __forceinline__ float lg2(float x) { return __builtin_amdgcn_logf(x); }

__device__ __forceinline__ void quant_rows(const Args& a, const int row_lo, const int row_hi) {
    const int tid = threadIdx.x, wid = tid >> 6, lane = tid & 63;
    {
        signed char* U8 = (signed char*)(a.ws + WS_U8); unsigned char* V8 = (unsigned char*)(a.ws + WS_V8);
        float* SU = (float*)(a.ws + WS_SU); float* SV = (float*)(a.ws + WS_SV);
        f32x4 qn[8];
        const int rstep = 8, rr0 = row_lo + wid;
        if (rr0 < row_hi) {
            const float* s0 = (rr0 >= 16384 ? a.pv + (size_t)(rr0 - 16384) * DM : a.pu + (size_t)rr0 * DM);
#pragma unroll
            for (int k = 0; k < 8; ++k) qn[k] = *(const f32x4*)(s0 + k * 256 + lane * 4);
        }
        for (int rr = rr0; rr < row_hi; rr += rstep) {
            const bool isv = rr >= 16384; const int e = isv ? rr - 16384 : rr;
            f32x4 v[8]; float am = 0.f;
#pragma unroll
            for (int k = 0; k < 8; ++k) v[k] = qn[k];
            if (rr + rstep < row_hi) {
                const int r1 = rr + rstep;
                const float* s1 = (r1 >= 16384 ? a.pv + (size_t)(r1 - 16384) * DM : a.pu + (size_t)r1 * DM);
#pragma unroll
                for (int k = 0; k < 8; ++k) qn[k] = *(const f32x4*)(s1 + k * 256 + lane * 4);
            }
#pragma unroll
            for (int k = 0; k < 8; ++k) am = fmaxf(fmaxf(am, fmaxf(fabsf(v[k][0]), fabsf(v[k][1]))), fmaxf(fabsf(v[k][2]), fabsf(v[k][3])));
            if (!isv) {
                unsigned char* U4 = (unsigned char*)(a.ws + WS_U8); unsigned char* SUE = (unsigned char*)(a.ws + WS_SU4);
#pragma unroll
                for (int k = 0; k < 8; ++k) {
                    float gm = fmaxf(fmaxf(fabsf(v[k][0]), fabsf(v[k][1])), fmaxf(fabsf(v[k][2]), fabsf(v[k][3])));
                    gm = fmaxf(gm, __shfl_xor(gm, 1)); gm = fmaxf(gm, __shfl_xor(gm, 2)); gm = fmaxf(gm, __shfl_xor(gm, 4));
                    const unsigned gb = __float_as_uint(gm);
                    int sbyte = (int)((gb >> 23) & 255u) - 2 + (((gb & 0x7fffffu) > 0x600000u) ? 1 : 0);
                    sbyte = gm > 0.f ? (sbyte < 1 ? 1 : sbyte) : 127;
                    const float gs = __uint_as_float((unsigned)sbyte << 23);
                    unsigned w = 0u;
                    w = (unsigned)__builtin_amdgcn_cvt_scalef32_pk_fp4_f32(w, v[k][0], v[k][1], gs, 0);
                    w = (unsigned)__builtin_amdgcn_cvt_scalef32_pk_fp4_f32(w, v[k][2], v[k][3], gs, 1);
                    *(unsigned short*)(U4 + (size_t)e * 1024 + 128 * k + 2 * lane) = (unsigned short)w;
                    if ((lane & 7) == 0) SUE[(size_t)e * 64 + ((((2 * k + (lane >> 5)) & 3) * 4 + ((lane >> 3) & 3)) * 4) + (k >> 1)] = (unsigned char)sbyte;
                }
                continue;
            }
            am = wave_max(am);
            float ssq = 0.f;
#pragma unroll
            for (int k = 0; k < 8; ++k) ssq += (v[k][0] * v[k][0] + v[k][1] * v[k][1]) + (v[k][2] * v[k][2] + v[k][3] * v[k][3]);
            ssq = wave_sum(ssq);
            const float sc4 = fminf(am, 2.5f * sqrtf(ssq * (1.0f / DM))) * (1.0f / 7.0f);
            const float inv = sc4 > 0.f ? 1.0f / sc4 : 0.f;
#pragma unroll
            for (int k = 0; k < 8; ++k) {
                unsigned w = 0u;
#pragma unroll
                for (int b = 0; b < 4; ++b) { int q = (int)rintf(v[k][b] * inv); q = q > 7 ? 7 : (q < -7 ? -7 : q); w |= (unsigned)((b & 1) ? (q & 15) : (q + 8)) << (4 * b); }
                *(unsigned short*)((unsigned char*)V8 + ((size_t)k * 16384 + e) * 128 + lane * 2) = (unsigned short)w;
            }
            if (lane == 0) SV[e] = sc4;
        }
    }
}

__device__ __forceinline__ void phase_prep(const Args& a, LAS unsigned char* lds) {
    const int tid = threadIdx.x, wid = tid >> 6, lane = tid & 63;
    LAS float* WF = (LAS float*)lds;
    LAS float* LF = (LAS float*)(lds + 65536);
    LAS float* TT = (LAS float*)(lds + 69632);
    unsigned char* XN8 = (unsigned char*)(a.ws + WS_XN); float* SA = (float*)(a.ws + WS_SA);
    float* LCUM = (float*)(a.ws + WS_LCUM); float* CHT = (float*)(a.ws + WS_CHT);
    for (int i = tid; i < 2048 * 2; i += 512) {
        const int d = i >> 1, part = i & 1;
        const f32x4 v = *(const f32x4*)(a.w_in + (size_t)d * CIN + NPROJ + part * 4);
        *(LAS f32x4*)(WF + ((((d & 3) * 2 + part) * 512) + (d >> 2)) * 4) = v;
    }
    __syncthreads();
    if (a.sub & 1)
    for (int g = (int)(gridDim.x - 1 - blockIdx.x); g < 257; g += gridDim.x) {
        const int nrows = g < 256 ? 64 : NMETA;
        const int rbase = g < 256 ? g * 64 : S_ROWS;
        f32x4 vn[8];
        if (wid < nrows) {
            const float* src0 = g < 256 ? a.x + (size_t)(rbase + wid) * DM : a.meta + (size_t)wid * DM;
#pragma unroll
            for (int c = 0; c < 8; ++c) vn[c] = *(const f32x4*)(src0 + c * 256 + lane * 4);
        }
        for (int r = wid; r < nrows; r += 8) {
            f32x4 v[8]; float ss = 0.f;
#pragma unroll
            for (int c = 0; c < 8; ++c) v[c] = vn[c];
            if (r + 8 < nrows) {
                const float* src1 = g < 256 ? a.x + (size_t)(rbase + r + 8) * DM : a.meta + (size_t)(r + 8) * DM;
#pragma unroll
                for (int c = 0; c < 8; ++c) vn[c] = *(const f32x4*)(src1 + c * 256 + lane * 4);
            }
            float amx = 0.f;
#pragma unroll
            for (int c = 0; c < 8; ++c) {
                const f32x4 gn = *(const f32x4*)(a.norm_mix + c * 256 + lane * 4);
                ss += v[c][0] * v[c][0] + v[c][1] * v[c][1] + v[c][2] * v[c][2] + v[c][3] * v[c][3];
                amx = fmaxf(fmaxf(amx, fmaxf(fabsf(v[c][0] * gn[0]), fabsf(v[c][1] * gn[1]))), fmaxf(fabsf(v[c][2] * gn[2]), fabsf(v[c][3] * gn[3])));
            }
            ss = wave_sum(ss); amx = wave_max(amx);
            const float rstd = rsqrtf(ss * (1.0f / DM) + EPS);
            const float am = amx * rstd * 1.000001f;
            const float qi = am > 0.f ? 127.0f / am : 0.f;
            if (lane == 0) SA[rbase + r] = am * (1.0f / 127.0f);
            float fl[8];
#pragma unroll
            for (int h = 0; h < 8; ++h) fl[h] = 0.f;
#pragma unroll
            for (int c = 0; c < 8; ++c) {
                const f32x4 gn = *(const f32x4*)(a.norm_mix + c * 256 + lane * 4);
                f32x4 y;
#pragma unroll
                for (int e = 0; e < 4; ++e) y[e] = (v[c][e] * rstd) * gn[e];
                unsigned w = 0u;
#pragma unroll
                for (int e = 0; e < 4; ++e) w |= ((unsigned)(int)rintf(y[e] * qi) & 0xffu) << (8 * e);
                *(unsigned*)(XN8 + (size_t)(rbase + r) * DM + c * 256 + lane * 4) = w;
                f32x4 wq[8];
#pragma unroll
                for (int q = 0; q < 8; ++q) wq[q] = *(const LAS f32x4*)(WF + ((q * 512) + c * 64 + lane) * 4);
#pragma unroll
                for (int e = 0; e < 4; ++e) {
                    const f32x4 w0 = wq[2 * e], w1 = wq[2 * e + 1];
                    fl[0] += y[e] * w0[0]; fl[1] += y[e] * w0[1]; fl[2] += y[e] * w0[2]; fl[3] += y[e] * w0[3];
                    fl[4] += y[e] * w1[0]; fl[5] += y[e] * w1[1]; fl[6] += y[e] * w1[2]; fl[7] += y[e] * w1[3];
                }
            }
#pragma unroll
            for (int o = 32; o >= 1; o >>= 1) {
                float t8[8];
#pragma unroll
                for (int h = 0; h < 8; ++h) t8[h] = __shfl_xor(fl[h], o);
#pragma unroll
                for (int h = 0; h < 8; ++h) fl[h] += t8[h];
            }
            float mine = 0.f;
#pragma unroll
            for (int h = 0; h < 8; ++h) mine = (lane == h) ? fl[h] : mine;
            if (lane < 8) { const float z = mine + a.b_forget[lane]; LF[r * 8 + lane] = fminf(z, 0.f) - log1pf(expf(-fabsf(z))); }
        }
        __syncthreads();
        if (tid < 8) {
            float run = 0.f;
            for (int r = 0; r < nrows; ++r) { run += LF[r * 8 + tid]; LCUM[(size_t)(rbase + r) * 8 + tid] = run; }
            CHT[g * 8 + tid] = run;
        }
        __syncthreads();
    }
    if (a.sub & 2) {
        LAS float* CM = (LAS float*)(lds + 69632);
        LAS unsigned char* TB = lds + 69632 + 8192 + 256;
        const int kr = tid >> 3, c4 = tid & 7;
        for (int u = blockIdx.x; u < 224 + 64; u += gridDim.x) {
            const bool isin = u < 224;
            const float* src = isin ? a.w_in : a.w_out; const int ld = isin ? CIN : DM; const int n0 = (isin ? u : u - 224) * 32;
            unsigned char* dst = (unsigned char*)(a.ws + (isin ? WS_WTIN : WS_WTOUT)); float* SB = (float*)(a.ws + (isin ? WS_SBIN : WS_SBOUT));
            f32x4 w[32]; f32x4 m4 = (f32x4){0.f, 0.f, 0.f, 0.f};
            const unsigned loffb = (unsigned)(4 * kr * ld + c4 * 4) * 4u;
#pragma unroll
            for (int q = 0; q < 32; ++q) {
                const float* sq = src + (size_t)((q >> 2) * 256 + (q & 3)) * ld + n0;
                w[q] = *(const f32x4*)((const char*)sq + loffb);
            }
#pragma unroll
            for (int q = 0; q < 32; ++q)
#pragma unroll
                for (int e = 0; e < 4; ++e) m4[e] = fmaxf(m4[e], fabsf(w[q][e]));
            *(LAS f32x4*)(CM + kr * 32 + c4 * 4) = m4;
            __syncthreads();
            if (tid < 32) { float m = 0.f; for (int i = 0; i < 64; ++i) m = fmaxf(m, CM[i * 32 + tid]); CM[2048 + tid] = m; SB[n0 + tid] = m * (1.0f / 127.0f); }
            __syncthreads();
            const f32x4 cm4 = *(const LAS f32x4*)(CM + 2048 + c4 * 4);
            f32x4 qi;
#pragma unroll
            for (int e = 0; e < 4; ++e) qi[e] = cm4[e] > 0.f ? 127.0f / cm4[e] : 0.f;
#pragma unroll
            for (int bb = 0; bb < 8; ++bb) {
#pragma unroll
                for (int e = 0; e < 4; ++e) {
                    unsigned pk = 0u;
#pragma unroll
                    for (int q = 0; q < 4; ++q) pk |= ((unsigned)(int)rintf(w[4 * bb + q][e] * qi[e]) & 0xffu) << (8 * q);
                    *(LAS unsigned*)(TB + (c4 * 4 + e) * 272 + 4 * kr) = pk;
                }
                __syncthreads();
                {
                    const int n = tid >> 4, k16 = (tid & 15) * 16;
                    const u32x4 o = *(const LAS u32x4*)(TB + n * 272 + k16);
                    *(u32x4*)(dst + (size_t)(n0 + n) * DM + bb * 256 + k16) = o;
                }
                __syncthreads();
            }
        }
    }
    if (a.sub & 4) {
        const int r = tid >> 4, c4 = tid & 15;
        f32x4 pv0, pv1;
        bf16_t* dst = (bf16_t*)(a.ws + WS_WTQ);
#define TR_LOAD(t_) do { const int kt_ = (t_) & 31, nt_ = (t_) >> 5; \
            pv0 = *(const f32x4*)(a.w_query + (size_t)(kt_ * 64 + r) * DM + nt_ * 64 + c4 * 4); pv1 = *(const f32x4*)(a.w_query + (size_t)(kt_ * 64 + r + 32) * DM + nt_ * 64 + c4 * 4); } while (0)
        const int NTILE = 1024;
        const int nskip = (int)gridDim.x > 64 ? (288 - (int)gridDim.x > 0 ? 288 - (int)gridDim.x : 0) : 0;
        const int tstart = (int)blockIdx.x - nskip, tstep = (int)gridDim.x - nskip;
        if (tstart >= 0 && tstart < NTILE) TR_LOAD(tstart);
        for (int t = tstart >= 0 ? tstart : NTILE; t < NTILE; t += tstep) {
            const int kt = t & 31, nt = t >> 5;
#pragma unroll
            for (int e = 0; e < 4; ++e) { TT[r * 65 + c4 * 4 + e] = pv0[e]; TT[(r + 32) * 65 + c4 * 4 + e] = pv1[e]; }
            __syncthreads();
            if (t + tstep < NTILE) TR_LOAD(t + tstep);
            {
                const int n = tid >> 3, k8 = (tid & 7) * 8;
                float f[8];
#pragma unroll
                for (int j = 0; j < 8; ++j) f[j] = TT[(k8 + j) * 65 + n];
                u32x4 w; w.x = pk_bf16(f[0], f[1]); w.y = pk_bf16(f[2], f[3]); w.z = pk_bf16(f[4], f[5]); w.w = pk_bf16(f[6], f[7]);
                *(u32x4*)(dst + (size_t)(nt * 64 + n) * DM + kt * 64 + k8) = w;
            }
            __syncthreads();
        }
#undef TR_LOAD
    }
    const int gt = blockIdx.x * 512 + tid, ngt = gridDim.x * 512;
    bf16_t* SUBK = (bf16_t*)(a.ws + WS_SUBK);
    for (int i = gt; i < 16 * 128 * 128 / 4; i += ngt) {
        const f32x4 v = *(const f32x4*)(a.sub_keys + (size_t)i * 4);
        u32x2 pk; pk.x = pk_bf16(v[0], v[1]); pk.y = pk_bf16(v[2], v[3]);
        const int c = (i * 4) & 127, n = ((i * 4) >> 7) & 127, hp = (i * 4) >> 14;
        *(u32x2*)(SUBK + ((size_t)(((hp * 4 + (n >> 5)) * 8 + (c >> 4)) * 64 + (n & 31) + 32 * ((c >> 3) & 1))) * 8 + (c & 7)) = pk;
    }
    bf16_t* MKV = (bf16_t*)(a.ws + WS_METAKV);
    for (int i = gt; i < 4 * 16 * 1024 / 8; i += ngt) {
        const int tsel = i / (16 * 1024 / 8), rem = i % (16 * 1024 / 8);
        *(u32x4*)(MKV + (size_t)tsel * 32 * 1024 + 16 * 1024 + (size_t)rem * 8) = (u32x4){0u, 0u, 0u, 0u};
    }
}

__device__ __forceinline__ void phase_cumf_meta(const Args& a, LAS unsigned char* lds) {
    const int tid = threadIdx.x, wid = tid >> 6, lane = tid & 63;
    const float* LCUM = (const float*)(a.ws + WS_LCUM); const float* CHT = (const float*)(a.ws + WS_CHT);
    float* CK2 = (float*)(a.ws + WS_CK2);
    for (int g = blockIdx.x; g < 256; g += gridDim.x) {
        if (wid == 0) {
            float pre[8];
#pragma unroll
            for (int h = 0; h < 8; ++h) { float p = 0.f; for (int c = lane; c < g; c += 64) p += CHT[c * 8 + h]; pre[h] = wave_sum(p) + CHT[256 * 8 + h]; }
            const int row = g * 64 + lane;
            const f32x4 l0 = *(const f32x4*)(LCUM + (size_t)row * 8), l1 = *(const f32x4*)(LCUM + (size_t)row * 8 + 4);
#pragma unroll
            for (int h = 0; h < 4; ++h) { CK2[(size_t)h * KPAD + row] = (pre[h] + l0[h]) * LOG2E; CK2[(size_t)(h + 4) * KPAD + row] = (pre[h + 4] + l1[h]) * LOG2E; }
        }
    }
    if (blockIdx.x == 0 && wid == 1 && lane < 32) {
#pragma unroll
        for (int h = 0; h < 8; ++h)
            CK2[(size_t)h * KPAD + S_ROWS + lane] = lane < NMETA ? LCUM[(size_t)(S_ROWS + lane) * 8 + h] * LOG2E : 1e30f;
    }
    const unsigned char* XN8 = (const unsigned char*)(a.ws + WS_XN); const unsigned char* WT8 = (const unsigned char*)(a.ws + WS_WTIN);
    const float* SA = (const float*)(a.ws + WS_SA); const float* SBI = (const float*)(a.ws + WS_SBIN);
    bf16_t* MKV = (bf16_t*)(a.ws + WS_METAKV);
    LAS int* PART = (LAS int*)lds;
    for (int cg = blockIdx.x; cg < 256; cg += gridDim.x) {
        const int tsel = cg >> 6, col = (cg & 63) * 16;
        const int nsrc = (tsel == 0 ? 1024 : tsel == 1 ? 2048 : tsel == 2 ? 4096 : 5120) + col;
        const int m = lane & 15, kq = lane >> 4;
        pg8::i32x4 acc = (pg8::i32x4){0, 0, 0, 0};
        const unsigned char* ap = XN8 + (size_t)(S_ROWS + m) * DM + wid * 256 + 16 * kq;
        const unsigned char* bp = WT8 + (size_t)(nsrc + m) * DM + wid * 256 + 16 * kq;
#pragma unroll
        for (int ks = 0; ks < 4; ++ks) {
            const pg8::i32x4 av = *(const pg8::i32x4*)(ap + 64 * ks), bv = *(const pg8::i32x4*)(bp + 64 * ks);
            acc = __builtin_amdgcn_mfma_i32_16x16x64_i8(av, bv, acc, 0, 0, 0);
        }
#pragma unroll
        for (int rg = 0; rg < 4; ++rg) PART[wid * 256 + (4 * kq + rg) * 16 + m] = acc[rg];
        __syncthreads();
        if (tid < 256) {
            int sI = 0;
#pragma unroll
            for (int w = 0; w < 8; ++w) sI += PART[w * 256 + tid];
            const int mm = tid >> 4, nn = tid & 15;
            const float val = (float)sI * SA[S_ROWS + mm] * SBI[nsrc + nn];
            MKV[(size_t)tsel * 32 * 1024 + (size_t)mm * 1024 + col + nn] = (bf16_t)(pk_bf16(val, 0.f) & 0xffffu);
        }
        __syncthreads();
    }
}

__device__ __forceinline__ void phase_ak(const Args& a) {
    const int tid = threadIdx.x, wid = tid >> 6, lane = tid & 63;
    bf16_t* FK = (bf16_t*)(a.ws + WS_PROJ + 4 * PROJ_T); bf16_t* MFK = (bf16_t*)(a.ws + WS_METAKV) + 2 * 32 * 1024;
    const int dcol = (lane & 7) * 16;
    f32x4 gk4[4];
#pragma unroll
    for (int q = 0; q < 4; ++q) gk4[q] = *(const f32x4*)(a.gk + dcol + 4 * q);
    for (int row = blockIdx.x * 8 + wid; row < S_ROWS + NMETA; row += gridDim.x * 8) {
        bf16_t* src = row < S_ROWS ? FK + (size_t)row * WID : MFK + (size_t)(row - S_ROWS) * WID;
        const u32x4 w0 = *(const u32x4*)(src + lane * 16), w1 = *(const u32x4*)(src + lane * 16 + 8);
        float f[16]; float ss = 0.f;
#pragma unroll
        for (int e = 0; e < 4; ++e) { f[2 * e] = bflo(w0[e]); f[2 * e + 1] = bfhi(w0[e]); f[8 + 2 * e] = bflo(w1[e]); f[9 + 2 * e] = bfhi(w1[e]); }
#pragma unroll
        for (int j = 0; j < 16; ++j) ss += f[j] * f[j];
        ss += __shfl_xor(ss, 1); ss += __shfl_xor(ss, 2); ss += __shfl_xor(ss, 4);
        const float rstd = rsqrtf(ss * (1.0f / 128.0f) + EPS);
        u32x4 o0, o1;
#pragma unroll
        for (int e = 0; e < 4; ++e) {
            o0[e] = pk_bf16((f[2 * e] * rstd) * gk4[e >> 1][(2 * e) & 3], (f[2 * e + 1] * rstd) * gk4[e >> 1][(2 * e + 1) & 3]);
            o1[e] = pk_bf16((f[8 + 2 * e] * rstd) * gk4[2 + (e >> 1)][(2 * e) & 3], (f[9 + 2 * e] * rstd) * gk4[2 + (e >> 1)][(2 * e + 1) & 3]);
        }
        *(u32x4*)(src + lane * 16) = o0; *(u32x4*)(src + lane * 16 + 8) = o1;
    }
}

__device__ __forceinline__ unsigned vimg_off(unsigned row, unsigned ch) { return 256u * row + 16u * (ch ^ (((row & 3u) << 2) | ((row >> 2) & 3u))); }
constexpr int AT_TILE = 16384 + 256;
constexpr int AT_STAGE = 2 * AT_TILE;
constexpr int AT_FLAGS = 2 * AT_STAGE;
constexpr int AT_TASK  = AT_FLAGS + 64;
constexpr int AT_RANK  = AT_TASK + 64;

template <bool FOX>
__device__ __forceinline__ void attn_unit(const Args& a, const int head, const int qb, LAS unsigned char* lds, const float zb2) {
    const int tid = threadIdx.x, wid = tid >> 6, lane = tid & 63;
    const int r = lane & 31, hh = lane >> 5;
    const int qt = 8 * qb + wid, q0 = qt * 32;
    const bf16_t* Qt = (const bf16_t*)(a.ws + WS_PROJ + (FOX ? 3 : 0) * PROJ_T);
    const bf16_t* Kt = (const bf16_t*)(a.ws + WS_PROJ + (FOX ? 4 : 1) * PROJ_T) + head * 128;
    const bf16_t* Vt = (const bf16_t*)(a.ws + WS_PROJ + (FOX ? 5 : 2) * PROJ_T) + head * 128;
    const bf16_t* MK = (const bf16_t*)(a.ws + WS_METAKV) + (FOX ? 2 : 0) * 32 * 1024 + head * 128;
    const bf16_t* MV = (const bf16_t*)(a.ws + WS_METAKV) + (FOX ? 3 : 1) * 32 * 1024 + head * 128;
    const float* CK2 = (const float*)(a.ws + WS_CK2) + (size_t)head * KPAD;
    volatile LAS int* flags = (volatile LAS int*)(lds + AT_FLAGS);
    bf16x8 qf[8];
    {
        const bf16_t* qp = Qt + (size_t)(q0 + r) * WID + head * 128 + 8 * hh;
        if (FOX) {
            bf16x8 raw[8]; float ss = 0.f;
#pragma unroll
            for (int k = 0; k < 8; ++k) {
                raw[k] = *(const bf16x8*)(qp + 16 * k);
#pragma unroll
                for (int j = 0; j < 8; ++j) { const float f = bf2f((unsigned short)raw[k][j]); ss += f * f; }
            }
            ss = pair_sum(ss);
            const float rstd = rsqrtf(ss * (1.0f / 128.0f) + EPS);
#pragma unroll
            for (int k = 0; k < 8; ++k) {
                const f32x4 g0 = *(const f32x4*)(a.gq + 16 * k + 8 * hh), g1 = *(const f32x4*)(a.gq + 16 * k + 8 * hh + 4);
                float y[8];
#pragma unroll
                for (int j = 0; j < 4; ++j) { y[j] = ((bf2f((unsigned short)raw[k][j]) * rstd) * g0[j]) * QSCALE2; y[4 + j] = ((bf2f((unsigned short)raw[k][4 + j]) * rstd) * g1[j]) * QSCALE2; }
                u32x4 w; w.x = pk_bf16(y[0], y[1]); w.y = pk_bf16(y[2], y[3]); w.z = pk_bf16(y[4], y[5]); w.w = pk_bf16(y[6], y[7]);
                qf[k] = __builtin_bit_cast(bf16x8, w);
            }
        } else {
#pragma unroll
            for (int k = 0; k < 8; ++k) {
                const bf16x8 raw = *(const bf16x8*)(qp + 16 * k);
                float y[8];
#pragma unroll
                for (int j = 0; j < 8; ++j) y[j] = bf2f((unsigned short)raw[j]) * QSCALE2;
                u32x4 w; w.x = pk_bf16(y[0], y[1]); w.y = pk_bf16(y[2], y[3]); w.z = pk_bf16(y[4], y[5]); w.w = pk_bf16(y[6], y[7]);
                qf[k] = __builtin_bit_cast(bf16x8, w);
            }
        }
    }
    f32x16 o[4];
#pragma unroll
    for (int dt = 0; dt < 4; ++dt)
#pragma unroll
        for (int i = 0; i < 16; ++i) o[dt][i] = 0.f;
    float lsum = 0.f, carry = FOX ? 0.f : 1.0f, mxrun = -1e30f;
    const float cq2 = FOX ? CK2[q0 + r] : 0.f;
    float sh = cq2;
    unsigned kra[8], trb[2], trx[4];
#pragma unroll
    for (int k = 0; k < 8; ++k) kra[k] = vimg_off((unsigned)r, (unsigned)(2 * k + hh));
    {
        const unsigned tq = (lane & 15) >> 2, tp = lane & 3, tblk = (lane >> 4) & 1;
#pragma unroll
        for (int jj = 0; jj < 2; ++jj) trb[jj] = 8192u + 256u * (8u * jj + 4u * hh + tq) + 16u * ((2u * tblk + (tp >> 1)) ^ (hh + 2u * jj)) + 8u * (tp & 1u);
#pragma unroll
        for (int dt = 0; dt < 4; ++dt) trx[dt] = 64u * ((unsigned)dt ^ tq);
    }
    const int lrow = 4 * wid + (lane >> 4);
    const unsigned goff = (unsigned)(lrow * WID + (lane & 15) * 8) * 2u;
    const unsigned soff = vimg_off((unsigned)lrow, (unsigned)(lane & 15));
    const int it_top = 8 * qb + 7;
    u32x4 rk0, rv0, rk1, rv1; float rc0 = 0.f, rc1 = 0.f;
#define AT_LOAD(pp_) do { const int pp__ = (pp_); \
        const bf16_t* kp_ = pp__ >= 0 ? Kt + (size_t)(2 * pp__ + 1) * 32 * WID : MK; const bf16_t* vp_ = pp__ >= 0 ? Vt + (size_t)(2 * pp__ + 1) * 32 * WID : MV; \
        rk0 = *(const u32x4*)((const char*)kp_ + goff); rv0 = *(const u32x4*)((const char*)vp_ + goff); \
        if (pp__ >= 0) { rk1 = *(const u32x4*)((const char*)(Kt + (size_t)(2 * pp__) * 32 * WID) + goff); rv1 = *(const u32x4*)((const char*)(Vt + (size_t)(2 * pp__) * 32 * WID) + goff); } \
        if (FOX && tid < 33) {     \
            const int i0_ = pp__ >= 0 ? (2 * pp__ + 1) * 32 : S_ROWS, i1_ = 2 * pp__ * 32; \
            rc0 = tid < 32 ? CK2[i0_ + tid] : (pp__ >= 0 ? CK2[i0_ - 1] : 0.f); \
            if (pp__ >= 0) rc1 = tid < 32 ? CK2[i1_ + tid] : (pp__ >= 1 ? CK2[i1_ - 1] : CK2[S_ROWS + NMETA - 1]); } } while (0)
#define AT_STORE(st_) do { LAS unsigned char* b_ = lds + (st_) * AT_STAGE + soff; \
        *(LAS u32x4*)b_ = rk0; *(LAS u32x4*)(b_ + 8192) = rv0; *(LAS u32x4*)(b_ + AT_TILE) = rk1; *(LAS u32x4*)(b_ + AT_TILE + 8192) = rv1; \
        if (FOX && tid < 33) { LAS float* c_ = (LAS float*)(lds + (st_) * AT_STAGE + 16384) + tid; c_[0] = rc0; c_[AT_TILE / 4] = rc1; } } while (0)
    if (lane == 0) flags[wid] = 0x7fffffff;
    const int pp_top = (it_top - 1) >> 1;
    rk1 = (u32x4){0u, 0u, 0u, 0u}; rv1 = rk1;
    AT_LOAD(pp_top); AT_STORE(0);
    AT_LOAD(pp_top - 1);
    bool done = false;
    int iter = 0;
    for (int pp = pp_top; pp >= -1; --pp, ++iter) {
        __syncthreads();
        {
            const int f0 = flags[0], f1 = flags[1], f2 = flags[2], f3 = flags[3], f4 = flags[4], f5 = flags[5], f6 = flags[6], f7 = flags[7];
            const int fm = max(max(max(f0, f1), max(f2, f3)), max(max(f4, f5), max(f6, f7)));
            if (fm < iter) break;
        }
        if (pp >= 0) AT_STORE((iter + 1) & 1);
        if (pp >= 1) AT_LOAD(pp - 2);
      if (FOX && !done && pp >= 0 && (2 * pp + 1) < qt) {
          LAS unsigned char* sb0 = lds + (iter & 1) * AT_STAGE; LAS unsigned char* sb1 = sb0 + AT_TILE;
          f32x16 st0, st1;
          {
              bf16x8 kf[8];
#pragma unroll
              for (int k = 0; k < 8; ++k) kf[k] = *(const LAS bf16x8*)(sb0 + kra[k]);
#pragma unroll
              for (int aa = 0; aa < 4; ++aa) { const f32x4 ck4 = *(const LAS f32x4*)(sb0 + 16384 + (8 * aa + 4 * hh) * 4);
#pragma unroll
                  for (int e = 0; e < 4; ++e) st0[4 * aa + e] = sh - ck4[e]; }
#pragma unroll
              for (int k = 0; k < 8; ++k) st0 = __builtin_amdgcn_mfma_f32_32x32x16_bf16(kf[k], qf[k], st0, 0, 0, 0);
          }
          {
              bf16x8 kg[8];
#pragma unroll
              for (int k = 0; k < 8; ++k) kg[k] = *(const LAS bf16x8*)(sb1 + kra[k]);
#pragma unroll
              for (int aa = 0; aa < 4; ++aa) { const f32x4 ck4 = *(const LAS f32x4*)(sb1 + 16384 + (8 * aa + 4 * hh) * 4);
#pragma unroll
                  for (int e = 0; e < 4; ++e) st1[4 * aa + e] = sh - ck4[e]; }
#pragma unroll
              for (int k = 0; k < 8; ++k) st1 = __builtin_amdgcn_mfma_f32_32x32x16_bf16(kg[k], qf[k], st1, 0, 0, 0);
          }
          __builtin_amdgcn_sched_barrier(0);
#pragma unroll
          for (int tl = 0; tl < 2; ++tl) {
              LAS unsigned char* sb = tl ? sb1 : sb0;
              float t[16];
#pragma unroll
              for (int i = 0; i < 16; ++i) t[i] = tl ? st1[i] : st0[i];
              float mx = t[0];
#pragma unroll
              for (int i = 1; i < 16; ++i) mx = fmaxf(mx, t[i]);
              mx = pair_max(mx);
              if (__any(mx > 8.0f)) {
                  const float shift = mx > 8.0f ? mx : 0.f;
                  const float alpha = ex2(-shift);
                  lsum *= alpha; sh -= shift; mxrun -= shift; mx -= shift;
#pragma unroll
                  for (int dt = 0; dt < 4; ++dt)
#pragma unroll
                      for (int i = 0; i < 16; ++i) o[dt][i] *= alpha;
#pragma unroll
                  for (int i = 0; i < 16; ++i) t[i] -= shift;
                  if (tl == 0) {
#pragma unroll
                      for (int i = 0; i < 16; ++i) st1[i] -= shift;
                  }
              }
              mxrun = fmaxf(mxrun, mx);
              float p[16]; float ps = 0.f;
#pragma unroll
              for (int i = 0; i < 16; ++i) { p[i] = ex2(t[i]); ps += p[i]; }
              lsum += ps;
              bf16x8 pb[2];
#pragma unroll
              for (int s2 = 0; s2 < 2; ++s2) {
                  u32x4 w; w.x = pk_bf16(p[8 * s2 + 0], p[8 * s2 + 1]); w.y = pk_bf16(p[8 * s2 + 2], p[8 * s2 + 3]); w.z = pk_bf16(p[8 * s2 + 4], p[8 * s2 + 5]); w.w = pk_bf16(p[8 * s2 + 6], p[8 * s2 + 7]);
                  pb[s2] = __builtin_bit_cast(bf16x8, w);
              }
              s16x4 tv[4][2][2];
#pragma unroll
              for (int dt = 0; dt < 4; ++dt)
#pragma unroll
                  for (int s2 = 0; s2 < 2; ++s2) {
                      tv[dt][s2][0] = __builtin_amdgcn_ds_read_tr16_b64_v4i16((LAS s16x4*)(sb + (trb[0] + trx[dt]) + 4096u * s2));
                      tv[dt][s2][1] = __builtin_amdgcn_ds_read_tr16_b64_v4i16((LAS s16x4*)(sb + (trb[1] + trx[dt]) + 4096u * s2));
                  }
#pragma unroll
              for (int dt = 0; dt < 4; ++dt)
#pragma unroll
                  for (int s2 = 0; s2 < 2; ++s2) {
                      const s16x4 t0 = tv[dt][s2][0], t1 = tv[dt][s2][1];
                      bf16x8 vf; vf[0] = t0[0]; vf[1] = t0[1]; vf[2] = t0[2]; vf[3] = t0[3]; vf[4] = t1[0]; vf[5] = t1[1]; vf[6] = t1[2]; vf[7] = t1[3];
                      o[dt] = __builtin_amdgcn_mfma_f32_32x32x16_bf16(vf, pb[s2], o[dt], 0, 0, 0);
                  }
          }
          {
              const float cnext = *(const LAS float*)(sb1 + 16384 + 128);
              if (__all((zb2 + sh - cnext - mxrun) < PRUNE_LOG2)) { done = true; if (lane == 0) flags[wid] = iter; }
          }
          continue;
      }
      for (int sub = 0; sub < 2; ++sub) {
        const int it = pp >= 0 ? 2 * pp + 1 - sub : -1;
        if (pp < 0 && sub == 1) break;
        const bool meta = it < 0, diag = it == qt;
        if (!done && (meta || it <= qt)) {
            LAS unsigned char* sb = lds + (iter & 1) * AT_STAGE + sub * AT_TILE;
            bf16x8 kf[8];
#pragma unroll
            for (int k = 0; k < 8; ++k) kf[k] = *(const LAS bf16x8*)(sb + kra[k]);
            f32x16 st;
            if (FOX) {
#pragma unroll
                for (int aa = 0; aa < 4; ++aa) {
                    const f32x4 ck4 = *(const LAS f32x4*)(sb + 16384 + (8 * aa + 4 * hh) * 4);
#pragma unroll
                    for (int e = 0; e < 4; ++e) st[4 * aa + e] = sh - ck4[e];
                }
            } else {
#pragma unroll
                for (int i = 0; i < 16; ++i) st[i] = 0.f;
            }
#pragma unroll
            for (int k = 0; k < 8; ++k) st = __builtin_amdgcn_mfma_f32_32x32x16_bf16(kf[k], qf[k], st, 0, 0, 0);
            float p[16];
            if (FOX) {
                float t[16];
#pragma unroll
                for (int i = 0; i < 16; ++i) t[i] = st[i];
                if (diag) {
#pragma unroll
                    for (int i = 0; i < 16; ++i) { const int kl = (i & 3) + 8 * (i >> 2) + 4 * hh; t[i] = kl > r ? -1e30f : t[i]; }
                }
                if (meta) {
#pragma unroll
                    for (int i = 0; i < 16; ++i) { const int kl = (i & 3) + 8 * (i >> 2) + 4 * hh; t[i] = kl >= NMETA ? -1e30f : t[i]; }
                }
                float mx = t[0];
#pragma unroll
                for (int i = 1; i < 16; ++i) mx = fmaxf(mx, t[i]);
                mx = pair_max(mx);
                if (__any(mx > 8.0f)) {
                    const float shift = mx > 8.0f ? mx : 0.f;
                    const float alpha = ex2(-shift);
                    lsum *= alpha; sh -= shift; mxrun -= shift; mx -= shift;
#pragma unroll
                    for (int dt = 0; dt < 4; ++dt)
#pragma unroll
                        for (int i = 0; i < 16; ++i) o[dt][i] *= alpha;
#pragma unroll
                    for (int i = 0; i < 16; ++i) t[i] -= shift;
                }
                mxrun = fmaxf(mxrun, mx);
                float ps = 0.f;
#pragma unroll
                for (int i = 0; i < 16; ++i) { p[i] = ex2(t[i]); ps += p[i]; }
                lsum += ps;
            } else {
                float be[16], om[16];
#pragma unroll
                for (int i = 0; i < 16; ++i) {
                    const float z = st[i];
                    const float u = ex2(-fabsf(z)), inv = __builtin_amdgcn_rcpf(1.0f + u), ui = u * inv;
                    be[i] = z >= 0.f ? inv : ui; om[i] = z >= 0.f ? ui : inv;
                }
                if (diag) {
#pragma unroll
                    for (int i = 0; i < 16; ++i) { const int kl = (i & 3) + 8 * (i >> 2) + 4 * hh; const bool vis = kl < r; be[i] = vis ? be[i] : 0.f; om[i] = vis ? om[i] : 1.0f; }
                }
                if (meta) {
#pragma unroll
                    for (int i = 0; i < 16; ++i) { const int kl = (i & 3) + 8 * (i >> 2) + 4 * hh; const bool vis = kl < NMETA; be[i] = vis ? be[i] : 0.f; om[i] = vis ? om[i] : 1.0f; }
                }
                float g[4], pg[4];
#pragma unroll
                for (int aa = 0; aa < 4; ++aa) g[aa] = (om[4 * aa + 3] * om[4 * aa + 2]) * (om[4 * aa + 1] * om[4 * aa]);
#pragma unroll
                for (int aa = 0; aa < 4; ++aa) pg[aa] = xhalf(g[aa]);
                float run = carry;
#pragma unroll
                for (int aa = 3; aa >= 0; --aa) {
                    const float gh1 = hh ? g[aa] : pg[aa];
                    const float off = hh ? run : run * gh1;
                    const float e3 = off, e2 = off * om[4 * aa + 3], e1 = e2 * om[4 * aa + 2], e0 = e1 * om[4 * aa + 1];
                    p[4 * aa + 3] = be[4 * aa + 3] * e3; p[4 * aa + 2] = be[4 * aa + 2] * e2;
                    p[4 * aa + 1] = be[4 * aa + 1] * e1; p[4 * aa + 0] = be[4 * aa + 0] * e0;
                    run *= g[aa] * pg[aa];
                }
                carry = run;
            }
            bf16x8 pb[2];
#pragma unroll
            for (int s = 0; s < 2; ++s) {
                u32x4 w; w.x = pk_bf16(p[8 * s + 0], p[8 * s + 1]); w.y = pk_bf16(p[8 * s + 2], p[8 * s + 3]); w.z = pk_bf16(p[8 * s + 4], p[8 * s + 5]); w.w = pk_bf16(p[8 * s + 6], p[8 * s + 7]);
                pb[s] = __builtin_bit_cast(bf16x8, w);
            }
            s16x4 tv[4][2][2];
#pragma unroll
            for (int dt = 0; dt < 4; ++dt)
#pragma unroll
                for (int s = 0; s < 2; ++s) {
                    tv[dt][s][0] = __builtin_amdgcn_ds_read_tr16_b64_v4i16((LAS s16x4*)(sb + (trb[0] + trx[dt]) + 4096u * s));
                    tv[dt][s][1] = __builtin_amdgcn_ds_read_tr16_b64_v4i16((LAS s16x4*)(sb + (trb[1] + trx[dt]) + 4096u * s));
                }
#pragma unroll
            for (int dt = 0; dt < 4; ++dt) {
#pragma unroll
                for (int s = 0; s < 2; ++s) {
                    const s16x4 t0 = tv[dt][s][0], t1 = tv[dt][s][1];
                    bf16x8 vf; vf[0] = t0[0]; vf[1] = t0[1]; vf[2] = t0[2]; vf[3] = t0[3]; vf[4] = t1[0]; vf[5] = t1[1]; vf[6] = t1[2]; vf[7] = t1[3];
                    o[dt] = __builtin_amdgcn_mfma_f32_32x32x16_bf16(vf, pb[s], o[dt], 0, 0, 0);
                }
            }
            bool fin = meta;
            if (!meta) {
                if (FOX) {
                    const float cnext = *(const LAS float*)(sb + 16384 + 128);
                    fin = __all((zb2 + sh - cnext - mxrun) < PRUNE_LOG2);
                } else {
                    fin = __all(carry < 5.421010862427522e-20f);
                }
            }
            if (fin) { done = true; if (lane == 0) flags[wid] = iter; }
        }
      }
    }
#undef AT_LOAD
#undef AT_STORE
    if (FOX) {
        lsum = pair_sum(lsum);
        const float inv = 1.0f / lsum;
#pragma unroll
        for (int dt = 0; dt < 4; ++dt)
#pragma unroll
            for (int i = 0; i < 16; ++i) o[dt][i] *= inv;
    }
    float sq = 0.f;
#pragma unroll
    for (int dt = 0; dt < 4; ++dt)
#pragma unroll
        for (int i = 0; i < 16; ++i) sq += o[dt][i] * o[dt][i];
    sq = pair_sum(sq);
    float* SQ = (float*)(a.ws + WS_SQ) + (FOX ? (size_t)S_ROWS * 8 : 0);
    if (hh == 0) SQ[(size_t)(q0 + r) * 8 + head] = sq;
    bf16_t* Ot = (bf16_t*)(a.ws + WS_ATT + (FOX ? PROJ_T : 0)) + (size_t)(q0 + r) * WID + head * 128 + 4 * hh;
#pragma unroll
    for (int dt = 0; dt < 4; ++dt)
#pragma unroll
        for (int aa = 0; aa < 4; ++aa) {
            u32x2 w; w.x = pk_bf16(o[dt][4 * aa], o[dt][4 * aa + 1]); w.y = pk_bf16(o[dt][4 * aa + 2], o[dt][4 * aa + 3]);
            *(u32x2*)(Ot + 32 * dt + 8 * aa) = w;
        }
    __syncthreads();
}

__device__ __forceinline__ void phase_attn(const Args& a, LAS unsigned char* lds) {
    const int tid = threadIdx.x, lane = tid & 63;
    unsigned* qctr = (unsigned*)(a.ws + WS_CTL) + QCTR_WORD;
    volatile LAS int* taskw = (volatile LAS int*)(lds + AT_TASK);
    volatile LAS int* rankw = (volatile LAS int*)(lds + AT_RANK);
    float gmq = wave_max(fmaxf(fabsf(a.gq[lane]), fabsf(a.gq[lane + 64])));
    float gmk = wave_max(fmaxf(fabsf(a.gk[lane]), fabsf(a.gk[lane + 64])));
    const float zb2 = 128.0f * gmq * gmk * QSCALE2 * 1.02f;
    if (tid < 8) {
        const float bh = a.b_forget[tid]; int rank = 0;
#pragma unroll
        for (int j = 0; j < 8; ++j) { const float bj = a.b_forget[j]; rank += (bj > bh || (bj == bh && j < tid)) ? 1 : 0; }
        rankw[rank] = tid;
    }
    for (;;) {
        __syncthreads();
        if (tid == 0) taskw[0] = (int)__hip_atomic_fetch_add(qctr, 1u, __ATOMIC_RELAXED, __HIP_MEMORY_SCOPE_AGENT);
        __syncthreads();
        const int T = taskw[0];
        if (T >= 1024) break;
        if (T < 512) attn_unit<true>(a, rankw[T >> 6], 63 - (T & 63), lds, zb2);
        else { const int U = T - 512; attn_unit<false>(a, U & 7, 63 - (U >> 3), lds, zb2); }
        if ((T & 1) == 0) quant_rows(a, (T >> 1) * 64, (T >> 1) * 64 + 64);
    }
}

__device__ __forceinline__ void phase_merge(const Args& a) {
    const int tid = threadIdx.x, wid = tid >> 6, lane = tid & 63;
    const bf16_t* SBO = (const bf16_t*)(a.ws + WS_ATT); const bf16_t* FOXO = (const bf16_t*)(a.ws + WS_ATT + PROJ_T);
    const bf16_t* FG = (const bf16_t*)(a.ws + WS_PROJ + 6 * PROJ_T);
    const float* SBSQ = (const float*)(a.ws + WS_SQ); const float* FOXSQ = SBSQ + (size_t)S_ROWS * 8;
    unsigned char* MG8 = (unsigned char*)(a.ws + WS_MERGED); float* SM = (float*)(a.ws + WS_SM);
    const bool fox = lane >= 32; const int c0 = (lane & 31) * 32;
    f32x4 gn[8];
#pragma unroll
    for (int q = 0; q < 8; ++q) gn[q] = *(const f32x4*)((fox ? a.g_fox : a.g_sb) + c0 + 4 * q);
    for (int row = blockIdx.x * 8 + wid; row < S_ROWS; row += gridDim.x * 8) {
        const float* sqp = (fox ? FOXSQ : SBSQ) + (size_t)row * 8;
        const f32x4 s0 = *(const f32x4*)sqp, s1 = *(const f32x4*)(sqp + 4);
        const float rstd = rsqrtf(((s0[0] + s0[1]) + (s0[2] + s0[3]) + (s1[0] + s1[1]) + (s1[2] + s1[3])) * (1.0f / WID) + EPS);
        const bf16_t* op = (fox ? FOXO : SBO) + (size_t)row * WID + c0;
        u32x4 ov[4], gv[4];
#pragma unroll
        for (int q = 0; q < 4; ++q) ov[q] = *(const u32x4*)(op + 8 * q);
        if (fox) {
#pragma unroll
            for (int q = 0; q < 4; ++q) gv[q] = *(const u32x4*)(FG + (size_t)row * WID + c0 + 8 * q);
        }
        float y[32]; float am = 0.f;
#pragma unroll
        for (int q = 0; q < 4; ++q)
#pragma unroll
            for (int e = 0; e < 4; ++e) {
                const int j = 8 * q + 2 * e;
                y[j] = (bflo(ov[q][e]) * rstd) * gn[j >> 2][j & 3]; y[j + 1] = (bfhi(ov[q][e]) * rstd) * gn[(j + 1) >> 2][(j + 1) & 3];
                if (fox) { y[j] *= 1.0f / (1.0f + __expf(-bflo(gv[q][e]))); y[j + 1] *= 1.0f / (1.0f + __expf(-bfhi(gv[q][e]))); }
                am = fmaxf(am, fmaxf(fabsf(y[j]), fabsf(y[j + 1])));
            }
        am = wave_max(am);
        const float qi = am > 0.f ? 127.0f / am : 0.f;
        u32x4 o0, o1;
#pragma unroll
        for (int w = 0; w < 4; ++w) {
            unsigned p0 = 0u, p1 = 0u;
#pragma unroll
            for (int b = 0; b < 4; ++b) { p0 |= ((unsigned)(int)rintf(y[4 * w + b] * qi) & 0xffu) << (8 * b); p1 |= ((unsigned)(int)rintf(y[16 + 4 * w + b] * qi) & 0xffu) << (8 * b); }
            o0[w] = p0; o1[w] = p1;
        }
        unsigned char* dp = MG8 + (size_t)row * DM + (fox ? WID : 0) + c0;
        *(u32x4*)dp = o0; *(u32x4*)(dp + 16) = o1;
        if (lane == 0) SM[row] = am * (1.0f / 127.0f);
    }
}

struct EpiInI8 {
    static constexpr bool PERM = true, AFTER_DRAIN = false; typedef pg8::i32x4 AccT;
    bf16_t* O; const float* sa; const float* sb;
    __device__ __forceinline__ void operator()(const pg8::i32x4 (&acc)[2][2][4][2], const pg8::Unit& u, int wr, int wc, int fr, int fq) const {
        const int row0 = u.pm * 256 + wr * 64 + fr; const int ctile = u.pn * 256;
        const int t = ctile >> 10; bf16_t* base = O + (size_t)t * S_ROWS * WID; const int colt = ctile - (t << 10);
        const int col0 = colt + wc * 32 + 8 * fq, gcol0 = ctile + wc * 32 + 8 * fq;
        f32x4 sb0[2], sb1[2];
#pragma unroll
        for (int bj = 0; bj < 2; ++bj) { sb0[bj] = *(const f32x4*)(sb + gcol0 + bj * 128); sb1[bj] = *(const f32x4*)(sb + gcol0 + bj * 128 + 4); }
#pragma unroll
        for (int ai = 0; ai < 2; ++ai)
#pragma unroll
            for (int m = 0; m < 4; ++m) {
                const int row = row0 + ai * 128 + m * 16; const float rs = sa[row];
                bf16_t* rowp = base + (size_t)row * WID + col0;
#pragma unroll
                for (int bj = 0; bj < 2; ++bj) {
                    const pg8::i32x4 v0 = acc[ai][bj][m][0], v1 = acc[ai][bj][m][1];
                    u32x4 w;
                    w.x = pk_bf16((float)v0[0] * rs * sb0[bj][0], (float)v0[1] * rs * sb0[bj][1]); w.y = pk_bf16((float)v0[2] * rs * sb0[bj][2], (float)v0[3] * rs * sb0[bj][3]);
                    w.z = pk_bf16((float)v1[0] * rs * sb1[bj][0], (float)v1[1] * rs * sb1[bj][1]); w.w = pk_bf16((float)v1[2] * rs * sb1[bj][2], (float)v1[3] * rs * sb1[bj][3]);
                    *(u32x4*)(rowp + bj * 128) = w;
                }
            }
    }
};
constexpr int EPI_LDS = pg8::STAGE_BYTES, EPI_WAVE = 16 * 144;
struct EpiOut {
    static constexpr bool PERM = true, AFTER_DRAIN = false; typedef pg8::i32x4 AccT;
    const float* X; bf16_t* H1G; const float* gffn; float* rowsq; const float* sm; const float* sb; LAS unsigned char* eb;
    __device__ __forceinline__ void operator()(const pg8::i32x4 (&acc)[2][2][4][2], const pg8::Unit& u, int wr, int wc, int fr, int fq) const {
        const int lane = threadIdx.x & 63; LAS unsigned char* ws_ = eb + (threadIdx.x >> 6) * EPI_WAVE;
        const int row0 = u.pm * 256 + wr * 64 + fr, col0 = u.pn * 256 + wc * 32 + 8 * fq;
        const float* xq = X + (size_t)(u.pm * 256 + wr * 64 + (lane >> 2)) * DM + u.pn * 256 + wc * 32 + (lane & 3) * 4;
        LAS unsigned char* wp_ = ws_ + (lane >> 2) * 144 + (lane & 3) * 16; const LAS unsigned char* rp_ = ws_ + fr * 144 + fq * 32;
        f32x4 xa[4];
#pragma unroll
        for (int q = 0; q < 4; ++q) xa[q] = *(const f32x4*)(xq + (q >> 1) * 128 + (q & 1) * 16);
#pragma unroll
        for (int ai = 0; ai < 2; ++ai)
#pragma unroll
            for (int m = 0; m < 4; ++m) {
                const int row = row0 + ai * 128 + m * 16; float ss = 0.f; const float rs = sm[row];
                f32x4 xc[4];
#pragma unroll
                for (int q = 0; q < 4; ++q) xc[q] = xa[q];
                if (ai * 4 + m < 7) { const int nx = ai * 4 + m + 1; const float* xn = xq + (size_t)((nx >> 2) * 128 + (nx & 3) * 16) * DM;
#pragma unroll
                    for (int q = 0; q < 4; ++q) xa[q] = *(const f32x4*)(xn + (q >> 1) * 128 + (q & 1) * 16); }
#pragma unroll
                for (int bj = 0; bj < 2; ++bj) {
                    const int c = col0 + bj * 128;
                    *(LAS f32x4*)(wp_) = xc[2 * bj]; *(LAS f32x4*)(wp_ + 64) = xc[2 * bj + 1];
                    const f32x4 x0 = *(const LAS f32x4*)(rp_), x1 = *(const LAS f32x4*)(rp_ + 16);
                    const f32x4 g0 = *(const f32x4*)(gffn + c), g1 = *(const f32x4*)(gffn + c + 4);
                    const f32x4 b0 = *(const f32x4*)(sb + c), b1 = *(const f32x4*)(sb + c + 4);
                    const pg8::i32x4 a0 = acc[ai][bj][m][0], a1 = acc[ai][bj][m][1];
                    f32x4 h0, h1;
#pragma unroll
                    for (int e = 0; e < 4; ++e) { h0[e] = (float)a0[e] * rs * b0[e] + x0[e]; h1[e] = (float)a1[e] * rs * b1[e] + x1[e]; }
                    ss += (h0[0] * h0[0] + h0[1] * h0[1]) + (h0[2] * h0[2] + h0[3] * h0[3]) + (h1[0] * h1[0] + h1[1] * h1[1]) + (h1[2] * h1[2] + h1[3] * h1[3]);
                    u32x4 w; w.x = pk_bf16(h0[0] * g0[0], h0[1] * g0[1]); w.y = pk_bf16(h0[2] * g0[2], h0[3] * g0[3]);
                    w.z = pk_bf16(h1[0] * g1[0], h1[1] * g1[1]); w.w = pk_bf16(h1[2] * g1[2], h1[3] * g1[3]);
                    *(u32x4*)(H1G + (size_t)row * DM + c) = w;
                }
                ss += __shfl_xor(ss, 16); ss += __shfl_xor(ss, 32);
                if (fq == 0) rowsq[(size_t)row * 32 + u.pn * 4 + wc] = ss;
            }
    }
};

__device__ __forceinline__ float row_rstd2(const float* ROWSQ, int row) {
    const float* p = ROWSQ + (size_t)row * 32; float s = 0.f;
#pragma unroll
    for (int j = 0; j < 8; ++j) { const f32x4 v = *(const f32x4*)(p + 4 * j); s += (v[0] + v[1]) + (v[2] + v[3]); }
    return rsqrtf(s * (1.0f / DM) + EPS);
}

__device__ __forceinline__ float gelu1(float v) {
    const float av = fabsf(v), t = __builtin_amdgcn_rcpf(av * 0.2316418882f + 1.0f);
    float q = t * 0.5307027145f + (-0.7265760135f); q = q * t + 0.7107068705f; q = q * t + (-0.142248368f); q = q * t + 0.127414796f; q = q * t;
    const float m = v * (q * __builtin_amdgcn_exp2f((v * v) * (-0.72134752044f)));
    return v < 0.f ? m : v - m;
}
__device__ __forceinline__ float wave_fsum(float v) {
    v += __uint_as_float((unsigned)__builtin_amdgcn_update_dpp(0, (int)__float_as_uint(v), 0xB1, 0xF, 0xF, true));
    v += __uint_as_float((unsigned)__builtin_amdgcn_update_dpp(0, (int)__float_as_uint(v), 0x4E, 0xF, 0xF, true));
    v += __uint_as_float((unsigned)__builtin_amdgcn_update_dpp(0, (int)__float_as_uint(v), 0x141, 0xF, 0xF, true));
    v += __uint_as_float((unsigned)__builtin_amdgcn_update_dpp(0, (int)__float_as_uint(v), 0x140, 0xF, 0xF, true));
    v += __uint_as_float((unsigned)__builtin_amdgcn_update_dpp(0, (int)__float_as_uint(v), 0x142, 0xA, 0xF, true));
    v += __uint_as_float((unsigned)__builtin_amdgcn_update_dpp(0, (int)__float_as_uint(v), 0x143, 0xC, 0xF, true));
    return __uint_as_float((unsigned)__builtin_amdgcn_readlane((int)__float_as_uint(v), 63));
}
constexpr int UP_RSH = 10, UP_NR = 16384 >> UP_RSH;
#ifndef UP_AUX
#define UP_AUX 0
#endif
constexpr int UP_HQW = 8448;
constexpr int L7_IB = 0, L7_EID = 16384, L7_GL = L7_EID + 2 * 8192, L7_HQ = L7_GL + 2 * 16384, L7_LIST = L7_HQ + 8 * UP_HQW;
constexpr int L7_HIST = L7_LIST + 16384, L7_BASE = L7_HIST + 2048, L7_XS = L7_BASE + 2048, L7_END = L7_XS + 128;
static_assert(L7_END <= LDS_BYTES - 16 && UP_NR <= 64, "phase 7 LDS map");
static_assert(EPI_LDS + 8 * EPI_WAVE <= LDS_BYTES - 16, "epilogue scratch");
typedef int i32x8 __attribute__((ext_vector_type(8)));
#define WFENCE() asm volatile("s_waitcnt lgkmcnt(0)" ::: "memory")
__device__ __forceinline__ int up_tokoff(int t) { return t * 2048 + (t & 1) * 16 + (t >> 1) * 128; }
template <int OPS> __device__ __forceinline__ f32x4 mx_step(const u32x4 av4, const u32x4 b0, const u32x4 b1, const f32x4 c, const unsigned sc) {
    const i32x8 av = {(int)av4[0], (int)av4[1], (int)av4[2], (int)av4[3], 0, 0, 0, 0};
    const i32x8 bv = {(int)b0[0], (int)b0[1], (int)b0[2], (int)b0[3], (int)b1[0], (int)b1[1], (int)b1[2], (int)b1[3]};
    return __builtin_amdgcn_mfma_scale_f32_16x16x128_f8f6f4(av, bv, c, 4, 0, OPS, (int)sc, 0, 0x7f7f7f7f);
}
__device__ __forceinline__ float quad_sum(float v) {
    v += __uint_as_float((unsigned)__builtin_amdgcn_update_dpp(0, (int)__float_as_uint(v), 0xB1, 0xF, 0xF, true));
    v += __uint_as_float((unsigned)__builtin_amdgcn_update_dpp(0, (int)__float_as_uint(v), 0x4E, 0xF, 0xF, true));
    return v;
}
__device__ __forceinline__ void gather_u_tile(const Args& a, LAS unsigned char* lds, const int tok0, const int tg, const int set) {
    const int tid = threadIdx.x, wid = __builtin_amdgcn_readfirstlane(tid >> 6), lane = tid & 63;
    const int li = lane & 15, lb = lane >> 4;
    const bf16_t* H1G = (const bf16_t*)(a.ws + WS_H1G); const float* ROWSQ = (const float*)(a.ws + WS_ROWSQ);
    const unsigned char* U4 = (const unsigned char*)(a.ws + WS_U8); const unsigned char* SUE = (const unsigned char*)(a.ws + WS_SU4);
    const float* SV = (const float*)(a.ws + WS_SV);
    float* COEF = (float*)(a.ws + WS_COEF); float* CSUMP = (float*)(a.ws + WS_XS);
    LAS unsigned char* hqw = lds + L7_HQ + wid * UP_HQW;
    LAS float* glw = (LAS float*)(lds + L7_GL + set * 16384 + tg * 2048);
    LAS const unsigned short* eidw = (LAS const unsigned short*)(lds + L7_EID + set * 8192 + tg * 1024);
    LAS unsigned* listw = (LAS unsigned*)(lds + L7_LIST + wid * 2048);
    LAS unsigned* histw = (LAS unsigned*)(lds + L7_HIST + wid * 256);
    LAS unsigned* basew = (LAS unsigned*)(lds + L7_BASE + wid * 256);
    LAS float* xsw = (LAS float*)(lds + L7_XS + wid * 16);
    {
        u32x4 hr[4][4];
#pragma unroll
        for (int tl = 0; tl < 4; ++tl)
#pragma unroll
            for (int q = 0; q < 4; ++q) hr[tl][q] = *(const u32x4*)(H1G + (size_t)(tok0 + 4 * tg + tl) * DM + lane * 32 + 8 * q);
#pragma unroll
        for (int tl = 0; tl < 4; ++tl) {
            const int tok = tok0 + 4 * tg + tl;
            float f[32]; float am = 0.f;
#pragma unroll
            for (int q = 0; q < 4; ++q)
#pragma unroll
                for (int e = 0; e < 4; ++e) { f[8 * q + 2 * e] = bflo(hr[tl][q][e]); f[8 * q + 2 * e + 1] = bfhi(hr[tl][q][e]); }
#pragma unroll
            for (int j = 0; j < 32; ++j) am = fmaxf(am, fabsf(f[j]));
            am = wave_max(am);
            const float inv = am > 0.f ? 256.0f / am : 0.f;
            u32x4 h0, h1;
#pragma unroll
            for (int w = 0; w < 8; ++w) {
                int pk = 0;
                pk = __builtin_amdgcn_cvt_pk_fp8_f32(f[4 * w] * inv, f[4 * w + 1] * inv, pk, false);
                pk = __builtin_amdgcn_cvt_pk_fp8_f32(f[4 * w + 2] * inv, f[4 * w + 3] * inv, pk, true);
                if (w < 4) h0[w] = (unsigned)pk; else h1[w - 4] = (unsigned)pk;
            }
            *(LAS u32x4*)(hqw + up_tokoff(tl) + lane * 32) = h0; *(LAS u32x4*)(hqw + up_tokoff(tl) + lane * 32 + 16) = h1;
            const float xs = row_rstd2(ROWSQ, tok) * (am * (1.0f / 256.0f));
            if (lane == 0) xsw[tl] = xs;
        }
    }
    if (lane < UP_NR) histw[lane] = 0u;
    WFENCE();
    {
        const int tl_l = lane >> 4, s0 = 8 * (lane & 15);
        const u32x4 ev = *(LAS const u32x4*)(eidw + tl_l * 128 + s0);
        unsigned it[8], pos[8];
#pragma unroll
        for (int i = 0; i < 8; ++i) {
            const unsigned e = (ev[i >> 1] >> (16 * (i & 1))) & 0xffffu;
            it[i] = e | ((unsigned)tl_l << 14) | ((unsigned)(s0 + i) << 16);
            pos[i] = __hip_atomic_fetch_add(histw + (e >> UP_RSH), 1u, __ATOMIC_RELAXED, __HIP_MEMORY_SCOPE_WORKGROUP);
        }
        WFENCE();
        const unsigned c = lane < UP_NR ? histw[lane] : 0u; unsigned inc = c;
#pragma unroll
        for (int d = 1; d < UP_NR; d <<= 1) { const unsigned t = (unsigned)__shfl_up((int)inc, d); inc += (lane >= d) ? t : 0u; }
        if (lane < UP_NR) basew[lane] = inc - c;
        WFENCE();
#pragma unroll
        for (int i = 0; i < 8; ++i) listw[basew[(it[i] & 0x3fffu) >> UP_RSH] + pos[i]] = it[i];
        WFENCE();
    }
    {
        LAS const unsigned char* hb = hqw + up_tokoff(li >> 2) + (lb >> 1) * 128 + (li & 3) * 32 + (lb & 1) * 16;
        LAS float* zbuf = (LAS float*)basew;
        LAS float* dummyw = (LAS float*)histw + lane;
        const int emask = (a.sub & 512) ? 1023 : 0x3fff;
        const unsigned rowoff = (unsigned)lb * 64u + (unsigned)(li & 3) * 16u;
        const unsigned scoff = ((unsigned)lb * 4u + (unsigned)(li & 3)) * 4u;
        const int gq = li >> 2;
        const bool wlane = (lane & 3) == 0; const int rtok = (lane >> 2) & 3;
        const __amdgpu_buffer_rsrc_t urs = __builtin_amdgcn_make_buffer_rsrc((void*)U4, 0, 16384 * 1024, 0x00020000);
        u32x4 aA[16], aB[16]; unsigned scA[4], scB[4];
#define PU_LOAD(AA, SC, t_) do { \
            _Pragma("unroll") for (int T = 0; T < 4; ++T) { const int e_ = (int)(listw[16 * (t_) + 4 * T + gq] & 0x3fffu) & emask; \
                const unsigned ro_ = (unsigned)e_ * 1024u + rowoff; \
                SC[T] = *(const unsigned*)(SUE + (size_t)e_ * 64 + scoff); \
                _Pragma("unroll") for (int m = 0; m < 4; ++m) AA[4 * T + m] = __builtin_amdgcn_raw_buffer_load_b128(urs, ro_ + m * 256, 0, UP_AUX); } } while (0)
#define PU_STEP(m_, bx0, bx1, nx0, nx1, AA, SC) do { \
            nx0 = *(LAS const u32x4*)(hb + (((m_) + 1) & 3) * 512); nx1 = *(LAS const u32x4*)(hb + (((m_) + 1) & 3) * 512 + 256); \
            c0 = mx_step<m_>(AA[(m_)], bx0, bx1, c0, SC[0]); c1 = mx_step<m_>(AA[4 + (m_)], bx0, bx1, c1, SC[1]); \
            c2 = mx_step<m_>(AA[8 + (m_)], bx0, bx1, c2, SC[2]); c3 = mx_step<m_>(AA[12 + (m_)], bx0, bx1, c3, SC[3]); } while (0)
#define PU_COMPUTE(AA, SC, t_) do { \
            f32x4 c0 = {0.f, 0.f, 0.f, 0.f}, c1 = c0, c2 = c0, c3 = c0; \
            u32x4 p0 = *(LAS const u32x4*)(hb), p1 = *(LAS const u32x4*)(hb + 256), q0, q1; \
            PU_STEP(0, p0, p1, q0, q1, AA, SC); PU_STEP(1, q0, q1, p0, p1, AA, SC); PU_STEP(2, p0, p1, q0, q1, AA, SC); PU_STEP(3, q0, q1, p0, p1, AA, SC); \
            const unsigned wq_ = listw[16 * (t_) + lb], wq1_ = listw[16 * (t_) + 4 + lb], wq2_ = listw[16 * (t_) + 8 + lb], wq3_ = listw[16 * (t_) + 12 + lb];     \
            const unsigned wi_ = listw[16 * (t_) + li]; \
            _Pragma("unroll") for (int T = 0; T < 4; ++T) { \
                const f32x4 cc = T == 0 ? c0 : T == 1 ? c1 : T == 2 ? c2 : c3; const unsigned w_ = T == 0 ? wq_ : T == 1 ? wq1_ : T == 2 ? wq2_ : wq3_; \
                const float d_ = (lane & 2) ? ((lane & 1) ? cc[3] : cc[2]) : ((lane & 1) ? cc[1] : cc[0]);                   \
                const float x_ = quad_sum(d_); \
                LAS float* dst_ = (wlane && rtok == (int)((w_ >> 14) & 3u)) ? (zbuf + 4 * T + lb) : dummyw; \
                *dst_ = x_; } \
            { const int tl_ = (int)(wi_ >> 14) & 3, sl_ = (int)(wi_ >> 16) & 127; \
              const float cf = glw[tl_ * 128 + sl_] * gelu1(xsw[tl_] * zbuf[li]); \
              glw[tl_ * 128 + sl_] = cf; } } while (0)
        PU_LOAD(aA, scA, 0);
        __builtin_amdgcn_sched_barrier(0);
#pragma unroll 1
        for (int t = 0; t < 30; t += 2) {
            PU_LOAD(aB, scB, t + 1);
            __builtin_amdgcn_sched_barrier(0);
            PU_COMPUTE(aA, scA, t);
            __builtin_amdgcn_sched_barrier(0);
            PU_LOAD(aA, scA, t + 2);
            __builtin_amdgcn_sched_barrier(0);
            PU_COMPUTE(aB, scB, t + 1);
            __builtin_amdgcn_sched_barrier(0);
        }
        PU_LOAD(aB, scB, 31);
        __builtin_amdgcn_sched_barrier(0);
        PU_COMPUTE(aA, scA, 30);
        __builtin_amdgcn_sched_barrier(0);
        PU_COMPUTE(aB, scB, 31);
#undef PU_LOAD
#undef PU_COMPUTE
#undef PU_STEP
    }
    WFENCE();
    {
        float sv0[4], sv1[4];
#pragma unroll
        for (int tl = 0; tl < 4; ++tl) { sv0[tl] = SV[eidw[tl * 128 + lane]]; sv1[tl] = SV[eidw[tl * 128 + 64 + lane]]; }
#pragma unroll
        for (int tl = 0; tl < 4; ++tl) {
            const int tok = tok0 + 4 * tg + tl;
            const float cv0 = glw[tl * 128 + lane] * sv0[tl], cv1 = glw[tl * 128 + 64 + lane] * sv1[tl];
            const float cm = wave_max(fmaxf(fabsf(cv0), fabsf(cv1)));
            const float inv = cm > 0.f ? 127.0f / cm : 0.f;
            signed char* cq = (signed char*)COEF + (size_t)tok * 128;
            if (a.sub & 256) continue;
            const int q0 = (int)rintf(cv0 * inv), q1 = (int)rintf(cv1 * inv);
            cq[lane] = (signed char)q0; cq[64 + lane] = (signed char)q1;
            const int qs = wave_isum(q0 + q1);
            if (lane == 0) { CSUMP[2 * tok] = cm * (1.0f / 127.0f); CSUMP[2 * tok + 1] = (float)(8 * qs); }
        }
    }
}

__device__ __forceinline__ unsigned fkey(float s) { const unsigned u = __float_as_uint(s); return u ^ ((unsigned)((int)u >> 31) | 0x80000000u); }
__device__ __forceinline__ float fval(unsigned k) { const unsigned u = (k & 0x80000000u) ? (k & 0x7fffffffu) : ~k; return __uint_as_float(u); }
#define CE(x_, y_) do { const unsigned hi_ = (x_) > (y_) ? (x_) : (y_); const unsigned lo_ = (x_) > (y_) ? (y_) : (x_); (x_) = hi_; (y_) = lo_; } while (0)
#define S16_NET(v) do { CE(v[0], v[1]); CE(v[2], v[3]); CE(v[0], v[2]); CE(v[1], v[3]); CE(v[1], v[2]); CE(v[4], v[5]); CE(v[6], v[7]); CE(v[4], v[6]); CE(v[5], v[7]); CE(v[5], v[6]); CE(v[0], v[4]); CE(v[2], v[6]); CE(v[2], v[4]); CE(v[1], v[5]); CE(v[3], v[7]); CE(v[3], v[5]); CE(v[1], v[2]); CE(v[3], v[4]); CE(v[5], v[6]); CE(v[8], v[9]); CE(v[10], v[11]); CE(v[8], v[10]); CE(v[9], v[11]); CE(v[9], v[10]); CE(v[12], v[13]); CE(v[14], v[15]); CE(v[12], v[14]); CE(v[13], v[15]); CE(v[13], v[14]); CE(v[8], v[12]); CE(v[10], v[14]); CE(v[10], v[12]); CE(v[9], v[13]); CE(v[11], v[15]); CE(v[11], v[13]); CE(v[9], v[10]); CE(v[11], v[12]); CE(v[13], v[14]); CE(v[0], v[8]); CE(v[4], v[12]); CE(v[4], v[8]); CE(v[2], v[10]); CE(v[6], v[14]); CE(v[6], v[10]); CE(v[2], v[4]); CE(v[6], v[8]); CE(v[10], v[12]); CE(v[1], v[9]); CE(v[5], v[13]); CE(v[5], v[9]); CE(v[3], v[11]); CE(v[7], v[15]); CE(v[7], v[11]); CE(v[3], v[5]); CE(v[7], v[9]); CE(v[11], v[13]); CE(v[1], v[2]); CE(v[3], v[4]); CE(v[5], v[6]); CE(v[7], v[8]); CE(v[9], v[10]); CE(v[11], v[12]); CE(v[13], v[14]); } while (0)

__device__ __forceinline__ void sort16(unsigned (&v)[16]) { S16_NET(v); }
__device__ __forceinline__ void bitonic16(unsigned (&v)[16]) {
#pragma unroll
    for (int k = 8; k >= 1; k >>= 1)
#pragma unroll
        for (int i = 0; i < 16; ++i) if ((i & k) == 0) CE(v[i], v[i + k]);
}
__device__ __forceinline__ void merge_top16(unsigned (&m)[16], const unsigned (&b)[16]) {
#pragma unroll
    for (int i = 0; i < 16; ++i) m[i] = m[i] > b[15 - i] ? m[i] : b[15 - i];
    bitonic16(m);
}
__device__ __forceinline__ void insert16(unsigned (&L)[16], unsigned x) {
#pragma unroll
    for (int j = 0; j < 16; ++j) { const unsigned hi = L[j] > x ? L[j] : x; x = L[j] > x ? x : L[j]; L[j] = hi; }
}

__device__ __forceinline__ void phase_topk(const Args& a, LAS unsigned char* lds) {
    const int tid = threadIdx.x, wid = tid >> 6, lane = tid & 63, r = lane & 31, hh = lane >> 5;
    const bf16_t* PQ = (const bf16_t*)(a.ws + WS_PQ); const bf16_t* SUBK = (const bf16_t*)(a.ws + WS_SUBK);
    const float* ROWSQ = (const float*)(a.ws + WS_ROWSQ);
    int* IDX = (int*)(a.ws + WS_IDX);
    LAS unsigned* ib = (LAS unsigned*)(lds + wid * 2048 + lane * 32);
    const int ntile = ((int)blockIdx.x < 512) ? (512 - 1 - (int)blockIdx.x) / (int)gridDim.x + 1 : 0;
    for (int round = 0; round <= ntile; ++round) {
      const bool sel = round < ntile && (round == 0 || wid >= 4);
      const int nh = round == 0 ? 1 : 2, h0 = round == 0 ? wid : wid - 4, set = round & 1;
      if (sel)
      for (int hi = 0; hi < nh; ++hi) {
        const int tt = (int)blockIdx.x + round * (int)gridDim.x, hd = h0 + 4 * hi, token = tt * 32 + r;
        unsigned LA[16], LB[16];
#pragma unroll
        for (int j = 0; j < 16; ++j) { LA[j] = 0u; LB[j] = 0u; }
#pragma unroll 1
        for (int p = 0; p < 2; ++p) {
            bf16x8 bq[8];
            const bf16_t* qp = PQ + (size_t)token * DM + hd * 256 + p * 128 + 8 * hh;
#pragma unroll
            for (int k = 0; k < 8; ++k) bq[k] = *(const bf16x8*)(qp + 16 * k);
            unsigned M[16];
#pragma unroll
            for (int j = 0; j < 16; ++j) M[j] = 0u;
#pragma unroll 1
            for (int mt = 0; mt < 4; ++mt) {
                f32x16 acc;
#pragma unroll
                for (int i = 0; i < 16; ++i) acc[i] = 0.f;
                const bf16_t* sp = SUBK + ((size_t)((hd * 2 + p) * 4 + mt) * 8 * 64 + lane) * 8;
#pragma unroll
                for (int k = 0; k < 8; ++k) { const bf16x8 ak = *(const bf16x8*)(sp + 512 * k); acc = __builtin_amdgcn_mfma_f32_32x32x16_bf16(ak, bq[k], acc, 0, 0, 0); }
                unsigned K16[16];
#pragma unroll
                for (int i = 0; i < 16; ++i) { const unsigned n = 32u * mt + (i & 3) + 8u * (i >> 2) + 4u * hh; K16[i] = (fkey(acc[i]) & ~127u) | n; }
                sort16(K16);
                merge_top16(M, K16);
            }
            unsigned P[16];
#pragma unroll
            for (int j = 0; j < 16; ++j) { const auto rr = __builtin_amdgcn_permlane32_swap(M[j], M[j], false, false); P[j] = hh ? rr[0] : rr[1]; }
            merge_top16(M, P);
#pragma unroll
            for (int j = 0; j < 16; ++j) { if (p == 0) LA[j] = M[j]; else LB[j] = M[j]; }
        }
#pragma unroll
        for (int w = 0; w < 4; ++w) {
            ib[w] = (LA[4 * w] & 127u) | ((LA[4 * w + 1] & 127u) << 8) | ((LA[4 * w + 2] & 127u) << 16) | ((LA[4 * w + 3] & 127u) << 24);
            ib[4 + w] = (LB[4 * w] & 127u) | ((LB[4 * w + 1] & 127u) << 8) | ((LB[4 * w + 2] & 127u) << 16) | ((LB[4 * w + 3] & 127u) << 24);
        }
        float va[16], vb[16];
#pragma unroll
        for (int j = 0; j < 16; ++j) { va[j] = fval(LA[j] & ~127u); vb[j] = fval(LB[j] & ~127u); }
#define CKEY(i_, j_) ((fkey(va[i_] + vb[j_]) & ~255u) | (unsigned)(255 - (16 * (i_) + (j_))))
        unsigned T[16], S1[16], S2[16];
#pragma unroll
        for (int j = 0; j < 16; ++j) T[j] = CKEY(0, j);
#pragma unroll
        for (int j = 0; j < 8; ++j) { S1[j] = CKEY(1, j); S1[15 - j] = CKEY(8 + j, 0); }
        bitonic16(S1);
        merge_top16(T, S1);
        S2[0] = CKEY(2, 0); S2[1] = CKEY(2, 1); S2[2] = CKEY(2, 2); S2[3] = CKEY(2, 3); S2[4] = CKEY(2, 4);
        S2[5] = CKEY(3, 0); S2[6] = CKEY(3, 1); S2[7] = CKEY(3, 2); S2[8] = CKEY(3, 3);
        S2[9] = CKEY(4, 0); S2[10] = CKEY(4, 1); S2[11] = CKEY(4, 2);
        S2[12] = CKEY(5, 0); S2[13] = CKEY(5, 1); S2[14] = CKEY(6, 0); S2[15] = CKEY(6, 1);
        sort16(S2);
        merge_top16(T, S2);
        insert16(T, CKEY(7, 0)); insert16(T, CKEY(7, 1));
#undef CKEY
        const float rstd = row_rstd2(ROWSQ, token);
        const float s0 = fval(T[0] & ~255u);
        float ex[16], den = 0.f; int eid[16];
        const LAS unsigned char* ibb = (const LAS unsigned char*)ib;
#pragma unroll
        for (int k = 0; k < 16; ++k) {
            const unsigned cid = 255u - (T[k] & 255u);
            const unsigned ia = ibb[cid >> 4], ibv = ibb[16 + (cid & 15u)];
            eid[k] = (int)(ia * 128u + ibv);
            ex[k] = __expf((fval(T[k] & ~255u) - s0) * rstd); den += ex[k];
        }
        const float inv = 1.0f / den;
        if (hh == 0) {
#pragma unroll
            for (int k = 0; k < 16; k += 4) { int4 v; v.x = eid[k]; v.y = eid[k + 1]; v.z = eid[k + 2]; v.w = eid[k + 3]; *(int4*)(IDX + (size_t)token * 128 + hd * 16 + k) = v; }
#pragma unroll
            for (int k = 0; k < 16; k += 8) { u32x4 v; v.x = (unsigned)eid[k] | ((unsigned)eid[k + 1] << 16); v.y = (unsigned)eid[k + 2] | ((unsigned)eid[k + 3] << 16);
                v.z = (unsigned)eid[k + 4] | ((unsigned)eid[k + 5] << 16); v.w = (unsigned)eid[k + 6] | ((unsigned)eid[k + 7] << 16);
                *(LAS u32x4*)(lds + L7_EID + set * 8192 + (r * 128 + hd * 16 + k) * 2) = v; }
        } else {
#pragma unroll
            for (int k = 0; k < 16; k += 4) { f32x4 v; v[0] = ex[k] * inv; v[1] = ex[k + 1] * inv; v[2] = ex[k + 2] * inv; v[3] = ex[k + 3] * inv; *(LAS f32x4*)(lds + L7_GL + set * 16384 + (r * 128 + hd * 16 + k) * 4) = v; }
        }
      }
      if (round >= 1 && wid < 4 && !(a.sub & 1024)) {
          const int tp = ((int)blockIdx.x + (round - 1) * (int)gridDim.x) * 32;
          gather_u_tile(a, lds, tp, 2 * wid, set ^ 1); gather_u_tile(a, lds, tp, 2 * wid + 1, set ^ 1);
      }
      asm volatile("s_waitcnt vmcnt(0) lgkmcnt(0)" ::: "memory");
      __syncthreads();
    }
}
#undef CE

constexpr int GCHUNK = 32;
__device__ __forceinline__ int swap32_isum(int x, int y) { const auto rr = __builtin_amdgcn_permlane32_swap((unsigned)x, (unsigned)y, false, false); return (int)rr[0] + (int)rr[1]; }
__device__ __forceinline__ int swap16_isum(int x, int y) { const auto rr = __builtin_amdgcn_permlane16_swap((unsigned)x, (unsigned)y, false, false); return (int)rr[0] + (int)rr[1]; }
__device__ __forceinline__ int ror8_isum(int x) { return x + __builtin_amdgcn_update_dpp(0, x, 0x128, 0xF, 0xF, true); }
__device__ __forceinline__ void phase_gather_v(const Args& a) {
    const int lane = threadIdx.x & 63;
    const int* IDX = (const int*)(a.ws + WS_IDX); const unsigned char* COEFQ = (const unsigned char*)(a.ws + WS_COEF); const float* CSC = (const float*)(a.ws + WS_XS);
    const unsigned char* V4 = (const unsigned char*)(a.ws + WS_V8); const bf16_t* H1G = (const bf16_t*)(a.ws + WS_H1G);
    unsigned* vq = (unsigned*)(a.ws + WS_CTL) + VQ_WORD;
    const unsigned xcc = xb_xcc_id() & 7u;
    const int grp = lane >> 3;
    const unsigned poff = (unsigned)(lane & 7) * 16u;
    const int ocol = 32 * (lane & 7) + 16 * (lane >> 5) + 8 * ((lane >> 4) & 1);
    const bool writer = (lane & 8) == 0;
    for (int j = 0; j < 8; ++j) {
        const int sl = (int)((xcc + (unsigned)j) & 7u);
        const unsigned char* Vs = V4 + (size_t)sl * 16384 * 128;
        f32x4 gi0, gi1; { const f32x4 g0 = *(const f32x4*)(a.norm_ffn + sl * 256 + ocol), g1 = *(const f32x4*)(a.norm_ffn + sl * 256 + ocol + 4);
#pragma unroll
            for (int e = 0; e < 4; ++e) { gi0[e] = 1.0f / g0[e]; gi1[e] = 1.0f / g1[e]; } }
        for (;;) {
            unsigned ch = 0;
            if (lane == 0) ch = __hip_atomic_fetch_add(vq + 64 * sl, 1u, __ATOMIC_RELAXED, __HIP_MEMORY_SCOPE_AGENT);
            ch = __builtin_amdgcn_readfirstlane(ch);
            if (ch >= (unsigned)(S_ROWS / GCHUNK)) break;
            const int t0 = (int)ch * GCHUNK;
            int4 inx[4]; u32x4 cA, cB; u32x4 vA[16], vB[16]; u32x4 hA, hB; pg8::f32x2 scA, scB;
#define PV_IDX(tok_) do { const int* ip_ = IDX + (size_t)(tok_) * 128 + 16 * grp; _Pragma("unroll") for (int w = 0; w < 4; ++w) inx[w] = *(const int4*)(ip_ + 4 * w); } while (0)
#define PV_ISSUE(VV, CC, HH, SCC, tok_) do { \
                HH = *(const u32x4*)(H1G + (size_t)(tok_) * DM + sl * 256 + ocol); SCC = *(const pg8::f32x2*)(CSC + 2 * (size_t)(tok_)); \
                _Pragma("unroll") for (int w = 0; w < 4; ++w) { \
                    VV[4 * w + 0] = *(const u32x4*)(Vs + (size_t)inx[w].x * 128 + poff); VV[4 * w + 1] = *(const u32x4*)(Vs + (size_t)inx[w].y * 128 + poff); \
                    VV[4 * w + 2] = *(const u32x4*)(Vs + (size_t)inx[w].z * 128 + poff); VV[4 * w + 3] = *(const u32x4*)(Vs + (size_t)inx[w].w * 128 + poff); } \
                CC = *(const u32x4*)(COEFQ + (size_t)(tok_) * 128 + 16 * grp); } while (0)
#define PV_CONSUME(VV, CC, HH, SCC, tok_) do { \
                int acc[32]; _Pragma("unroll") for (int q = 0; q < 32; ++q) acc[q] = 0; \
                float* op_ = a.out + (size_t)(tok_) * DM + sl * 256 + ocol; \
                _Pragma("unroll") for (int gq = 0; gq < 4; ++gq) { const int cp_ = (int)CC[gq]; \
                    _Pragma("unroll") for (int w = 0; w < 4; ++w) { \
                        const unsigned x0 = VV[4 * gq + 0][w], x1 = VV[4 * gq + 1][w], x2 = VV[4 * gq + 2][w], x3 = VV[4 * gq + 3][w]; \
                        const unsigned l01 = __builtin_amdgcn_perm(x1, x0, 0x05010400u), h01 = __builtin_amdgcn_perm(x1, x0, 0x07030602u); \
                        const unsigned l23 = __builtin_amdgcn_perm(x3, x2, 0x05010400u), h23 = __builtin_amdgcn_perm(x3, x2, 0x07030602u); \
                        const unsigned t0_ = __builtin_amdgcn_perm(l23, l01, 0x05040100u), t1_ = __builtin_amdgcn_perm(l23, l01, 0x07060302u); \
                        const unsigned t2_ = __builtin_amdgcn_perm(h23, h01, 0x05040100u), t3_ = __builtin_amdgcn_perm(h23, h01, 0x07060302u); \
                        acc[8 * w + 0] = __builtin_amdgcn_sdot4((int)(t0_ & 0x0f0f0f0fu), cp_, acc[8 * w + 0], false); acc[8 * w + 1] = __builtin_amdgcn_sdot4((int)t0_, cp_, acc[8 * w + 1], false); \
                        acc[8 * w + 2] = __builtin_amdgcn_sdot4((int)(t1_ & 0x0f0f0f0fu), cp_, acc[8 * w + 2], false); acc[8 * w + 3] = __builtin_amdgcn_sdot4((int)t1_, cp_, acc[8 * w + 3], false); \
                        acc[8 * w + 4] = __builtin_amdgcn_sdot4((int)(t2_ & 0x0f0f0f0fu), cp_, acc[8 * w + 4], false); acc[8 * w + 5] = __builtin_amdgcn_sdot4((int)t2_, cp_, acc[8 * w + 5], false); \
                        acc[8 * w + 6] = __builtin_amdgcn_sdot4((int)(t3_ & 0x0f0f0f0fu), cp_, acc[8 * w + 6], false); acc[8 * w + 7] = __builtin_amdgcn_sdot4((int)t3_, cp_, acc[8 * w + 7], false); } } \
                int z16[16]; _Pragma("unroll") for (int q = 0; q < 16; ++q) z16[q] = swap32_isum(acc[q], acc[16 + q]);        \
                int z8[8]; _Pragma("unroll") for (int q = 0; q < 8; ++q) z8[q] = ror8_isum(swap16_isum(z16[q], z16[8 + q]));     \
                if (writer) { const float sc_ = SCC.x, cs_ = SCC.y; f32x4 o0, o1;     \
                    o0[0] = bflo(HH.x) * gi0[0] + ((float)z8[0] - cs_) * sc_; o0[1] = bfhi(HH.x) * gi0[1] + (float)((z8[1] - z8[0]) >> 4) * sc_; \
                    o0[2] = bflo(HH.y) * gi0[2] + ((float)z8[2] - cs_) * sc_; o0[3] = bfhi(HH.y) * gi0[3] + (float)((z8[3] - z8[2]) >> 4) * sc_; \
                    o1[0] = bflo(HH.z) * gi1[0] + ((float)z8[4] - cs_) * sc_; o1[1] = bfhi(HH.z) * gi1[1] + (float)((z8[5] - z8[4]) >> 4) * sc_; \
                    o1[2] = bflo(HH.w) * gi1[2] + ((float)z8[6] - cs_) * sc_; o1[3] = bfhi(HH.w) * gi1[3] + (float)((z8[7] - z8[6]) >> 4) * sc_; \
                    *(f32x4*)op_ = o0; *(f32x4*)(op_ + 4) = o1; } } while (0)
            int4 inxB[4];
#define PV_IDXB(tok_) do { const int* ip_ = IDX + (size_t)(tok_) * 128 + 16 * grp; _Pragma("unroll") for (int w = 0; w < 4; ++w) inxB[w] = *(const int4*)(ip_ + 4 * w); } while (0)
#define PV_SWAPIDX() do { _Pragma("unroll") for (int w = 0; w < 4; ++w) { const int4 t_ = inx[w]; inx[w] = inxB[w]; inxB[w] = t_; } } while (0)
#define SB() __builtin_amdgcn_sched_barrier(0)
            PV_IDX(t0); PV_IDXB(t0 + 1); SB();
            PV_ISSUE(vA, cA, hA, scA, t0); SB();
            for (int t = 0; t < GCHUNK - 2; t += 2) {
                PV_IDX(t0 + t + 2);
                SB();
                PV_SWAPIDX();
                PV_ISSUE(vB, cB, hB, scB, t0 + t + 1);
                SB();
                PV_CONSUME(vA, cA, hA, scA, t0 + t);
                SB();
                PV_SWAPIDX();
                PV_IDXB(t0 + t + 3);
                SB();
                PV_ISSUE(vA, cA, hA, scA, t0 + t + 2);
                SB();
                PV_CONSUME(vB, cB, hB, scB, t0 + t + 1);
                SB();
            }
            PV_SWAPIDX();
            PV_ISSUE(vB, cB, hB, scB, t0 + GCHUNK - 1);
            SB();
            PV_CONSUME(vA, cA, hA, scA, t0 + GCHUNK - 2);
            SB();
            PV_CONSUME(vB, cB, hB, scB, t0 + GCHUNK - 1);
            SB();
#undef SB
#undef PV_IDXB
#undef PV_SWAPIDX
#undef PV_IDX
#undef PV_ISSUE
#undef PV_CONSUME
        }
    }
}

__global__ void __launch_bounds__(512, 2) hymba_fwd(Args a) {
    extern __shared__ __attribute__((aligned(16))) unsigned char shm[];
    LAS unsigned char* lds = (LAS unsigned char*)shm;
    volatile LAS unsigned* xbw = (volatile LAS unsigned*)(lds + LDS_BYTES - 16);
    if (threadIdx.x == 0) { xbw[0] = 0u; xbw[1] = 0u; xbw[2] = 0u; xbw[3] = 0u; }
    __syncthreads();
    XcdBarrier bar = xcd_barrier_post((unsigned*)(a.ws + WS_CTL), xbw);
#ifndef PHMASK
#define PHMASK 0x3ff
#endif
#define RUN(p) ((((PHMASK) >> (p)) & 1) && a.ph_lo <= (p) && (p) < a.ph_hi)
#define SEAM(p) do { if (a.ph_lo <= (p) && (p) + 1 < a.ph_hi) xcd_barrier(bar); } while (0)
    if (RUN(0)) phase_prep(a, lds);
    SEAM(0);
    if (RUN(1)) {
        phase_cumf_meta(a, lds);
        pg8::Gemm g; g.A = (const bf16_t*)(a.ws + WS_XN); g.Bt = (const bf16_t*)(a.ws + WS_WTIN); g.M = S_ROWS; g.N = NPROJ; g.K = DM / 2;
        pg8::StaticOrder so; so.init(g.M, g.N, (int)gridDim.x, (int)blockIdx.x);
        EpiInI8 ep; ep.O = (bf16_t*)(a.ws + WS_PROJ); ep.sa = (const float*)(a.ws + WS_SA); ep.sb = (const float*)(a.ws + WS_SBIN);
        pg8::gemm_phase<EpiInI8, pg8::StaticOrder, false, true>(lds, g, so, ep, nullptr);
    }
    SEAM(1);
    if (RUN(2)) phase_ak(a);
    SEAM(2);
    if (RUN(3)) phase_attn(a, lds);
    SEAM(3);
    if (RUN(4)) phase_merge(a);
    SEAM(4);
    if (RUN(5)) {
        pg8::Gemm g; g.A = (const bf16_t*)(a.ws + WS_MERGED); g.Bt = (const bf16_t*)(a.ws + WS_WTOUT); g.M = S_ROWS; g.N = DM; g.K = DM / 2;
        pg8::StaticOrder so; so.init(g.M, g.N, (int)gridDim.x, (int)blockIdx.x);
        EpiOut ep; ep.X = a.x; ep.H1G = (bf16_t*)(a.ws + WS_H1G); ep.gffn = a.norm_ffn; ep.rowsq = (float*)(a.ws + WS_ROWSQ);
        ep.sm = (const float*)(a.ws + WS_SM); ep.sb = (const float*)(a.ws + WS_SBOUT); ep.eb = lds + EPI_LDS;
        pg8::gemm_phase<EpiOut, pg8::StaticOrder, false, true>(lds, g, so, ep, nullptr);
    }
    SEAM(5);
    if (RUN(6)) {
        pg8::Gemm g; g.A = (const bf16_t*)(a.ws + WS_H1G); g.Bt = (const bf16_t*)(a.ws + WS_WTQ); g.M = S_ROWS; g.N = DM; g.K = DM;
        pg8::StaticOrder so; so.init(g.M, g.N, (int)gridDim.x, (int)blockIdx.x);
        pg8::EpiBf16<0> ep; ep.O = (bf16_t*)(a.ws + WS_PQ); ep.ldc = DM; ep.bias = nullptr; ep.split_cols = 0; ep.split_stride = 0;
        pg8::gemm_phase<pg8::EpiBf16<0>, pg8::StaticOrder, false>(lds, g, so, ep, nullptr);
    }
    SEAM(6);
    if (RUN(7)) phase_topk(a, lds);
    SEAM(7);
    if (RUN(9)) phase_gather_v(a);
#undef RUN
#undef SEAM
}

#ifndef N_LAUNCHES
#define N_LAUNCHES 1
#endif
extern "C" void kernel_launch(void* const* d_in, const int* in_sizes, int n_in, void* d_out, int out_size, void* d_ws, size_t ws_size, hipStream_t stream) {
    static int grid = 0;
    if (grid == 0) {
        if (n_in != 15 || in_sizes[0] != S_ROWS * DM || out_size != S_ROWS * DM || ws_size < WS_END) {
            fprintf(stderr, "kernel_launch: unexpected shapes (n_in %d, in0 %d, out %d, ws %zu, need %zu)\n", n_in, n_in > 0 ? in_sizes[0] : -1, out_size, ws_size, (size_t)WS_END); grid = -1; return; }
        int dev = 0, cus = 0, per_cu = 0;
        if (hipGetDevice(&dev) != hipSuccess || hipDeviceGetAttribute(&cus, hipDeviceAttributeMultiprocessorCount, dev) != hipSuccess) { grid = -1; return; }
        if (hipFuncSetAttribute((const void*)hymba_fwd, hipFuncAttributeMaxDynamicSharedMemorySize, LDS_BYTES) != hipSuccess) { fprintf(stderr, "kernel_launch: hipFuncSetAttribute failed\n"); grid = -1; return; }
        if (hipOccupancyMaxActiveBlocksPerMultiprocessor(&per_cu, (const void*)hymba_fwd, 512, LDS_BYTES) != hipSuccess || per_cu < 1) { fprintf(stderr, "kernel_launch: occupancy query says %d\n", per_cu); }
        (void)hipGetLastError();
        grid = cus;
    }
    if (grid < 0) return;
    Args a{};
    a.x = (const float*)d_in[0]; a.meta = (const float*)d_in[1]; a.norm_mix = (const float*)d_in[2]; a.w_in = (const float*)d_in[3]; a.b_forget = (const float*)d_in[4];
    a.gq = (const float*)d_in[5]; a.gk = (const float*)d_in[6]; a.g_sb = (const float*)d_in[7]; a.g_fox = (const float*)d_in[8]; a.w_out = (const float*)d_in[9];
    a.norm_ffn = (const float*)d_in[10]; a.w_query = (const float*)d_in[11]; a.sub_keys = (const float*)d_in[12]; a.pu = (const float*)d_in[13]; a.pv = (const float*)d_in[14];
    a.out = (float*)d_out; a.ws = (unsigned char*)d_ws; a.sub = 7; a.pad_ = 0;
#ifdef PROBE_DUP
    const int lo[3] = {0, PROBE_DUP, PROBE_DUP + 1}, hi[3] = {PROBE_DUP + 1, PROBE_DUP + 1, NPH};
    for (int li = 0; li < 3; ++li) {
        if (lo[li] >= hi[li]) continue;
        a.ph_lo = lo[li]; a.ph_hi = hi[li];
#ifdef PROBE_SUB
        a.sub = (li == 1) ? PROBE_SUB : 7;
#endif
        (void)hipMemsetAsync((char*)d_ws + WS_CTL, 0, CTL_BYTES, stream);
        hipLaunchKernelGGL(hymba_fwd, dim3(grid), dim3(512), LDS_BYTES, stream, a);
    }
#else
    for (int li = 0; li < N_LAUNCHES; ++li) {
        if (N_LAUNCHES == 1) { a.ph_lo = 0; a.ph_hi = NPH; } else { a.ph_lo = li * NPH / N_LAUNCHES; a.ph_hi = (li + 1) * NPH / N_LAUNCHES; }
        (void)hipMemsetAsync((char*)d_ws + WS_CTL, 0, li == 0 ? CTL_BYTES : (size_t)XCD_BAR_WORDS * 4, stream);
        hipLaunchKernelGGL(hymba_fwd, dim3(grid), dim3(512), LDS_BYTES, stream, a);
    }
#endif
}
```
